# Optimizing an MI355X kernel written in HIP

```python
import math
import jax, jax.numpy as jnp
from jax import lax
import numpy as np

D_MODEL = 1024
BATCH = 8
SEQ = 2048
DEPTH = 2
DEC_BATCH = 128
DEC_SEQ = 1
PAST_LEN = 16384
PAGE_SIZE = 128

N_BR = 5
W_BR = D_MODEL // 2
N_HEADS = 4
HEAD_DIM = W_BR // N_HEADS
CONV_W = 4
N_MEM = 256
D_FF = -(-8 * D_MODEL // (3 * 256)) * 256
LRU_C = 8.0
GDN_CHUNK = 64
HGRN_CHUNK = 16
RET_CHUNK = 64
ROPE_BASE = 10000.0
LN_EPS = 1e-5
NORM_EPS = 1e-6
DEEPNORM_ALPHA = (2 * DEPTH) ** 0.25
DEEPNORM_BETA = (8 * DEPTH) ** -0.25
IN_SPLITS = (W_BR, 3 * W_BR, W_BR, N_HEADS, N_HEADS, W_BR, W_BR, W_BR, W_BR, W_BR, W_BR, W_BR, W_BR, W_BR)
N_IN = sum(IN_SPLITS)

kernel_name = "hybrid_gated_parallel_recurrent_decoder_step"


def _split(a, sizes):
    idx = np.cumsum(sizes)[:-1].tolist()
    return jnp.split(a, idx, axis=-1)


def _heads(a):
    return a.reshape(a.shape[:-1] + (N_HEADS, HEAD_DIM))


def _layernorm(x, g, b):
    xf = x.astype(jnp.float32)
    mu = jnp.mean(xf, -1, keepdims=True)
    var = jnp.mean(jnp.square(xf - mu), -1, keepdims=True)
    return ((xf - mu) * lax.rsqrt(var + LN_EPS) * g + b).astype(x.dtype)


def _head_rmsnorm(o, w):
    of = o.astype(jnp.float32)
    of = of * lax.rsqrt(jnp.mean(of * of, -1, keepdims=True) + NORM_EPS)
    return of.reshape(o.shape[:2] + (-1,)) * w


def _head_groupnorm(o, w, b):
    of = o.astype(jnp.float32)
    mu = jnp.mean(of, -1, keepdims=True)
    var = jnp.mean(jnp.square(of - mu), -1, keepdims=True)
    return ((of - mu) * lax.rsqrt(var + NORM_EPS)).reshape(o.shape[:2] + (-1,)) * w + b


def _l2norm(a):
    af = a.astype(jnp.float32)
    return af * lax.rsqrt(jnp.sum(af * af, -1, keepdims=True) + NORM_EPS)


def _causal_conv(x, buf, w, b=None):
    T = x.shape[1]
    xp = jnp.concatenate([buf.astype(x.dtype), x], axis=1)
    out = w[0] * xp[:, 0:T]
    for j in range(1, CONV_W):
        out = out + w[j] * xp[:, j:j + T]
    if b is not None:
        out = out + b
    return out, xp[:, T:]


def _rotary(x, pos):
    half = HEAD_DIM // 2
    inv = ROPE_BASE ** (-jnp.arange(half, dtype=jnp.float32) / half)
    ang = pos.astype(jnp.float32)[:, None] * inv
    cos, sin = jnp.cos(ang)[None, :, None, :], jnp.sin(ang)[None, :, None, :]
    xf = x.astype(jnp.float32)
    x1, x2 = xf[..., :half], xf[..., half:]
    return jnp.concatenate([x1 * cos - x2 * sin, x2 * cos + x1 * sin], axis=-1)


def _lin_comb(e1, e2):
    a1, b1 = e1
    a2, b2 = e2
    return a1 * a2, a2 * b1 + b2


def _rglru(xc, h0, wa, ba, wi, bi, lam):
    f32 = jnp.float32
    xh = _heads(xc)
    r = jax.nn.sigmoid((jnp.einsum("bthi,hij->bthj", xh, wa).reshape(xc.shape) + ba).astype(f32))
    ig = jax.nn.sigmoid((jnp.einsum("bthi,hij->bthj", xh, wi).reshape(xc.shape) + bi).astype(f32))
    log_a = -LRU_C * r * jax.nn.softplus(-lam.astype(f32))
    a = jnp.exp(log_a)
    b = jnp.sqrt(-jnp.expm1(2.0 * log_a)) * (ig * xc.astype(f32))
    b = b.at[:, 0].add(a[:, 0] * h0.astype(f32))
    _, h = lax.associative_scan(_lin_comb, (a, b), axis=1)
    return h, h[:, -1]


def _chunk_len(T, chunk):
    return chunk if T % chunk == 0 else T


def _to_chunks(a, N, C):
    B_, T, H, X = a.shape
    return a.reshape(B_, N, C, H, X).transpose(1, 0, 3, 2, 4)


def _from_chunks(o):
    N, B_, H, C, X = o.shape
    return o.transpose(1, 0, 3, 2, 4).reshape(B_, N * C, H, X)


def _chunked_gla(q, k, v, log_f, s0, chunk):
    f32 = jnp.float32
    T = q.shape[1]
    C = _chunk_len(T, chunk)
    N = T // C
    qc, kc, vc, gc = (_to_chunks(a.astype(f32), N, C) for a in (q, k, v, log_f))
    G = jnp.cumsum(gc, axis=3)
    q_g = qc * jnp.exp(G)
    k_g = kc * jnp.exp(-G)
    incl = jnp.tril(jnp.ones((C, C), bool))
    a_qk = jnp.where(incl, jnp.einsum("nbhik,nbhjk->nbhij", q_g, k_g), 0.0)
    o_intra = jnp.einsum("nbhij,nbhjv->nbhiv", a_qk, vc)
    g_last = G[:, :, :, -1]
    k_end = kc * jnp.exp(g_last[:, :, :, None] - G)

    def step(S, xs):
        qg, ke, vv, gl = xs
        o = jnp.einsum("bhck,bhkv->bhcv", qg, S)
        S = jnp.exp(gl)[..., None] * S + jnp.einsum("bhck,bhcv->bhkv", ke, vv)
        return S, o

    s_fin, o_inter = lax.scan(step, s0.astype(f32), (q_g, k_end, vc, g_last))
    return _from_chunks(o_intra + o_inter), s_fin


def _chunked_gdn(q, k, v, g, beta, s0, chunk):
    f32 = jnp.float32
    T = q.shape[1]
    V = v.shape[-1]
    C = _chunk_len(T, chunk)
    N = T // C
    qc, kc, vc = (_to_chunks(a.astype(f32), N, C) for a in (q, k, v))
    gc, bc = (_to_chunks(a.astype(f32)[..., None], N, C)[..., 0] for a in (g, beta))
    G = jnp.cumsum(gc, axis=-1)
    incl = jnp.tril(jnp.ones((C, C), bool))
    strict = jnp.tril(jnp.ones((C, C), bool), -1)
    decay = jnp.exp(jnp.where(incl, G[..., :, None] - G[..., None, :], -jnp.inf))
    kb = kc * bc[..., None]
    a_kk = jnp.where(strict, jnp.einsum("nbhik,nbhjk->nbhij", kb, kc) * decay, 0.0)
    rhs = jnp.concatenate([vc * bc[..., None], kb * jnp.exp(G)[..., None]], axis=-1)
    sol = lax.linalg.triangular_solve(a_kk + jnp.eye(C, dtype=f32), rhs, left_side=True, lower=True, unit_diagonal=True)
    u, w = sol[..., :V], sol[..., V:]
    a_qk = jnp.einsum("nbhik,nbhjk->nbhij", qc, kc) * decay
    q_g = qc * jnp.exp(G)[..., None]
    g_last = G[..., -1]
    k_end = kc * jnp.exp(g_last[..., None] - G)[..., None]

    def step(S, xs):
        qg, ke, uu, ww, aqk, gl = xs
        v_new = uu - jnp.einsum("bhck,bhkv->bhcv", ww, S)
        o = jnp.einsum("bhck,bhkv->bhcv", qg, S) + jnp.einsum("bhij,bhjv->bhiv", aqk, v_new)
        S = jnp.exp(gl)[..., None, None] * S + jnp.einsum("bhck,bhcv->bhkv", ke, v_new)
        return S, o

    s_fin, o = lax.scan(step, s0.astype(f32), (q_g, k_end, u, w, a_qk, g_last))
    return _from_chunks(o), s_fin


def _cross_attn(q, mem_k, mem_v):
    s = jnp.einsum("bthd,bmhd->bhtm", q, mem_k).astype(jnp.float32) * HEAD_DIM ** -0.5
    p = jax.nn.softmax(s, axis=-1)
    o = jnp.einsum("bhtm,bmhd->bthd", p.astype(mem_v.dtype), mem_v)
    return o.reshape(o.shape[:2] + (-1,))


def _layer(x, mem_k, mem_v, pos, lb, state, p):
    f32 = jnp.float32
    dt = x.dtype
    h_lru, conv_lru, conv_gdn, s_gdn, s_hgrn, s_ret = state
    (xa, gdn_qkv, gdn_z, gdn_b, gdn_a, hg_q, hg_f, hg_i, hg_g,
     rt_q, rt_k, rt_v, rt_g, xq) = _split(x @ p["w_in"], IN_SPLITS)

    xa_c, conv_lru_new = _causal_conv(xa, conv_lru, p["lru_conv_w"], p["lru_conv_b"])
    y_a, h_lru_new = _rglru(xa_c, h_lru, p["lru_wa"], p["lru_ba"], p["lru_wi"], p["lru_bi"], p["lru_lambda"])

    qkv_c, conv_gdn_new = _causal_conv(gdn_qkv, conv_gdn, p["gdn_conv_w"])
    gq, gk, gv = (_heads(t) for t in jnp.split(jax.nn.silu(qkv_c), 3, axis=-1))
    gq = _l2norm(gq) * HEAD_DIM ** -0.5
    gk = _l2norm(gk)
    beta = jax.nn.sigmoid(gdn_b.astype(f32))
    g_log = -jnp.exp(p["gdn_a_log"].astype(f32)) * jax.nn.softplus(gdn_a.astype(f32) + p["gdn_dt_bias"].astype(f32))
    o_b, s_gdn_new = _chunked_gdn(gq, gk, gv, g_log, beta, s_gdn, GDN_CHUNK)
    y_b = _head_rmsnorm(o_b, p["gdn_norm_w"]) * jax.nn.silu(gdn_z.astype(f32))

    fz = hg_f.astype(f32)
    log_f = jnp.logaddexp(jnp.log(lb), jnp.log1p(-lb) + jax.nn.log_sigmoid(fz))
    k_c = (1.0 - lb) * jax.nn.sigmoid(-fz)
    o_c, s_hgrn_new = _chunked_gla(_heads(jax.nn.silu(hg_q.astype(f32))), _heads(k_c), _heads(hg_i),
                                   _heads(log_f), s_hgrn, HGRN_CHUNK)
    y_c = _head_rmsnorm(o_c, p["hgrn_norm_w"]) * jax.nn.sigmoid(hg_g.astype(f32))

    rq = _rotary(_heads(rt_q), pos)
    rk = _rotary(_heads(rt_k), pos) * HEAD_DIM ** -0.5
    log_gamma = jnp.log1p(-jnp.exp2(-5.0 - jnp.arange(N_HEADS, dtype=f32)))
    log_f_d = jnp.broadcast_to(log_gamma[:, None], rq.shape)
    o_d, s_ret_new = _chunked_gla(rq, rk, _heads(rt_v), log_f_d, s_ret, RET_CHUNK)
    y_d = _head_groupnorm(o_d, p["ret_gn_w"], p["ret_gn_b"]) * jax.nn.silu(rt_g.astype(f32))

    y_e = _cross_attn(_heads(xq), mem_k, mem_v)

    merged = jnp.zeros(x.shape, f32)
    for n, y in enumerate((y_a, y_b, y_c, y_d, y_e)):
        gate = jax.nn.sigmoid((x @ p["w_merge_gate"][n] + p["b_merge_gate"][n]).astype(f32))
        merged = merged + gate * (y.astype(dt) @ p["w_branch"][n]).astype(f32)
    mix = merged.astype(dt) @ p["w_out"]
    x = _layernorm(DEEPNORM_ALPHA * x + mix, p["ln1_g"], p["ln1_b"])

    hg, hv = jnp.split(x @ p["w_ffn_up"], 2, axis=-1)
    ffn = (jax.nn.silu(hg) * hv) @ p["w_ffn_down"]
    x = _layernorm(DEEPNORM_ALPHA * x + ffn, p["ln2_g"], p["ln2_b"])
    return x, (h_lru_new, conv_lru_new, conv_gdn_new, s_gdn_new, s_hgrn_new, s_ret_new)


def setup_inputs(seed: int = 0) -> dict:
    key = jax.random.key(seed)
    ks = iter(jax.random.split(key, 48))
    f32 = jnp.float32

    def nrm(shape, scale):
        return jax.random.normal(next(ks), shape, f32) * scale

    def unif(shape, lo, hi):
        return jax.random.uniform(next(ks), shape, f32, lo, hi)

    L, D, W, H, HD = DEPTH, D_MODEL, W_BR, N_HEADS, HEAD_DIM
    log_s = jnp.log(unif((L, W), 0.9, 0.999)) / LRU_C
    lru_lambda = log_s - jnp.log(-jnp.expm1(log_s))
    dt = jnp.exp(unif((L, H), math.log(1e-3), math.log(1e-1)))
    gdn_dt_bias = dt + jnp.log(-jnp.expm1(-dt))
    gdn_a_log = jnp.log(unif((L, H), 1.0, 16.0))
    return {
        "x_prompt": nrm((BATCH, SEQ, D), 1.0),
        "x_sample": nrm((DEC_BATCH, DEC_SEQ, D), 1.0),
        "mem_prompt": nrm((BATCH, N_MEM, D), 1.0),
        "state_lru_h": nrm((L, DEC_BATCH, W), 0.5),
        "state_lru_conv": nrm((L, DEC_BATCH, CONV_W - 1, W), 1.0),
        "state_gdn_conv": nrm((L, DEC_BATCH, CONV_W - 1, 3 * W), 1.0),
        "state_gdn_s": nrm((L, DEC_BATCH, H, HD, HD), 0.1),
        "state_hgrn_s": nrm((L, DEC_BATCH, H, HD, HD), 0.3),
        "state_ret_s": nrm((L, DEC_BATCH, H, HD, HD), 1.0),
        "cache_mem_k": nrm((L, DEC_BATCH, N_MEM, H, HD), 1.0),
        "cache_mem_v": nrm((L, DEC_BATCH, N_MEM, H, HD), 1.0),
        "w_in": nrm((L, D, N_IN), D ** -0.5),
        "lru_conv_w": nrm((L, CONV_W, W), CONV_W ** -0.5),
        "lru_conv_b": nrm((L, W), 0.01),
        "lru_wa": nrm((L, H, HD, HD), HD ** -0.5),
        "lru_ba": nrm((L, W), 0.01),
        "lru_wi": nrm((L, H, HD, HD), HD ** -0.5),
        "lru_bi": nrm((L, W), 0.01),
        "lru_lambda": lru_lambda,
        "gdn_conv_w": nrm((L, CONV_W, 3 * W), CONV_W ** -0.5),
        "gdn_a_log": gdn_a_log,
        "gdn_dt_bias": gdn_dt_bias,
        "gdn_norm_w": 1.0 + nrm((L, W), 0.02),
        "hgrn_lb_raw": nrm((L, W), 0.1),
        "hgrn_norm_w": 1.0 + nrm((L, W), 0.02),
        "ret_gn_w": 1.0 + nrm((L, W), 0.02),
        "ret_gn_b": nrm((L, W), 0.01),
        "w_mem_k": nrm((L, D, W), D ** -0.5),
        "w_mem_v": nrm((L, D, W), D ** -0.5),
        "w_merge_gate": nrm((L, N_BR, D, D), D ** -0.5),
        "b_merge_gate": nrm((L, N_BR, D), 0.01),
        "w_branch": nrm((L, N_BR, W, D), W ** -0.5 * DEEPNORM_BETA),
        "w_out": nrm((L, D, D), D ** -0.5 * DEEPNORM_BETA),
        "ln1_g": 1.0 + nrm((L, D), 0.02),
        "ln1_b": nrm((L, D), 0.01),
        "w_ffn_up": nrm((L, D, 2 * D_FF), D ** -0.5),
        "w_ffn_down": nrm((L, D_FF, D), D_FF ** -0.5 * DEEPNORM_BETA),
        "ln2_g": 1.0 + nrm((L, D), 0.02),
        "ln2_b": nrm((L, D), 0.01),
    }


def reference(x_prompt, x_sample, mem_prompt,
              state_lru_h, state_lru_conv, state_gdn_conv, state_gdn_s, state_hgrn_s, state_ret_s,
              cache_mem_k, cache_mem_v,
              w_in, lru_conv_w, lru_conv_b, lru_wa, lru_ba, lru_wi, lru_bi, lru_lambda,
              gdn_conv_w, gdn_a_log, gdn_dt_bias, gdn_norm_w,
              hgrn_lb_raw, hgrn_norm_w, ret_gn_w, ret_gn_b,
              w_mem_k, w_mem_v, w_merge_gate, b_merge_gate, w_branch, w_out,
              ln1_g, ln1_b, w_ffn_up, w_ffn_down, ln2_g, ln2_b):
    f32 = jnp.float32
    B_p, T_p = x_prompt.shape[:2]
    T_s = x_sample.shape[1]
    n_mem = mem_prompt.shape[1]
    pos_p = jnp.arange(T_p)
    pos_s = PAST_LEN + jnp.arange(T_s)
    lb_cum = jnp.cumsum(jax.nn.softmax(hgrn_lb_raw.astype(f32), axis=0), axis=0)
    lb_all = lb_cum - lb_cum[0]
    zero_state = (jnp.zeros((B_p, W_BR), f32),
                  jnp.zeros((B_p, CONV_W - 1, W_BR), x_prompt.dtype),
                  jnp.zeros((B_p, CONV_W - 1, 3 * W_BR), x_prompt.dtype),
                  jnp.zeros((B_p, N_HEADS, HEAD_DIM, HEAD_DIM), f32),
                  jnp.zeros((B_p, N_HEADS, HEAD_DIM, HEAD_DIM), f32),
                  jnp.zeros((B_p, N_HEADS, HEAD_DIM, HEAD_DIM), f32))
    xp, xs = x_prompt, x_sample
    new_p, new_s, mem_k_p, mem_v_p = [], [], [], []
    for l in range(DEPTH):
        p = dict(w_in=w_in[l], lru_conv_w=lru_conv_w[l], lru_conv_b=lru_conv_b[l], lru_wa=lru_wa[l],
                 lru_ba=lru_ba[l], lru_wi=lru_wi[l], lru_bi=lru_bi[l], lru_lambda=lru_lambda[l],
                 gdn_conv_w=gdn_conv_w[l], gdn_a_log=gdn_a_log[l], gdn_dt_bias=gdn_dt_bias[l],
                 gdn_norm_w=gdn_norm_w[l], hgrn_norm_w=hgrn_norm_w[l], ret_gn_w=ret_gn_w[l],
                 ret_gn_b=ret_gn_b[l], w_merge_gate=w_merge_gate[l], b_merge_gate=b_merge_gate[l],
                 w_branch=w_branch[l], w_out=w_out[l], ln1_g=ln1_g[l], ln1_b=ln1_b[l],
                 w_ffn_up=w_ffn_up[l], w_ffn_down=w_ffn_down[l], ln2_g=ln2_g[l], ln2_b=ln2_b[l])
        mk = (mem_prompt @ w_mem_k[l]).reshape(B_p, n_mem, N_HEADS, HEAD_DIM)
        mv = (mem_prompt @ w_mem_v[l]).reshape(B_p, n_mem, N_HEADS, HEAD_DIM)
        xp, sp = _layer(xp, mk, mv, pos_p, lb_all[l], zero_state, p)
        st_s = (state_lru_h[l], state_lru_conv[l], state_gdn_conv[l], state_gdn_s[l], state_hgrn_s[l], state_ret_s[l])
        xs, ss = _layer(xs, cache_mem_k[l], cache_mem_v[l], pos_s, lb_all[l], st_s, p)
        new_p.append(sp)
        new_s.append(ss)
        mem_k_p.append(mk)
        mem_v_p.append(mv)
    return (xp, xs,
            jnp.stack([s[0] for s in new_p]), jnp.stack([s[1] for s in new_p]), jnp.stack([s[2] for s in new_p]),
            jnp.stack([s[3] for s in new_p]), jnp.stack([s[4] for s in new_p]), jnp.stack([s[5] for s in new_p]),
            jnp.stack(mem_k_p), jnp.stack(mem_v_p),
            jnp.stack([s[0] for s in new_s]), jnp.stack([s[1] for s in new_s]), jnp.stack([s[2] for s in new_s]),
            jnp.stack([s[3] for s in new_s]), jnp.stack([s[4] for s in new_s]), jnp.stack([s[5] for s in new_s]))
```

```cpp
#include <hip/hip_runtime.h>
#include <cstdio>
#include <cstdint>
namespace pg8 {
#define PG8_LAS __attribute__((address_space(3)))
typedef unsigned short bf16_t;
typedef short bf16x8 __attribute__((ext_vector_type(8)));
typedef float f32x4 __attribute__((ext_vector_type(4)));
typedef unsigned u32x4 __attribute__((ext_vector_type(4)));
constexpr int BM = 256, BK = 64, HALF = 128, HTB = HALF * BK * 2  , STAGE_BYTES = 8 * HTB, NXCD = 8, WGM = 8;

__host__ __device__ __forceinline__ int lds_byte(int r, int c) { const int st = (r >> 4) * 2 + (c >> 5), rr = r & 15, cc = c & 31, ob = rr * 64 + cc * 2; return st * 1024 + (ob ^ (((ob >> 9) & 1) << 5)); }
__host__ __device__ __forceinline__ void stage_rc(int b, int& R, int& C) { const int st = b / 1024, sb = b % 1024, swz = sb ^ (((sb >> 9) & 1) << 5); R = (st >> 1) * 16 + swz / 64; C = (st & 1) * 32 + (swz % 64) / 2; }
__host__ __device__ __forceinline__ int perm32(int rho) { const int n = rho >> 4, i = rho & 15; return 8 * (i >> 2) + 4 * n + (i & 3); }

struct Unit { int pm, pn; };
struct Gemm { const bf16_t* A; const bf16_t* Bt; int M, N, K; };

struct StaticOrder {
    int nM, nN, nwg, G, c;
    __host__ __device__ void init(int M, int N, int G_, int c_) { nM = M / BM; nN = N / BM; nwg = nM * nN; G = G_; c = c_; }
    __host__ __device__ bool next(int i, Unit& u) const {
        const long L = (long)i * G + c; if (L >= nwg) return false;
        int wgid = (int)L; { const int q = nwg / NXCD, r = nwg % NXCD, xcd = wgid % NXCD, off = wgid / NXCD; wgid = (xcd < r ? xcd * (q + 1) : r * (q + 1) + (xcd - r) * q) + off; }
        const int nig = WGM * nN, gid = wgid / nig, fm = gid * WGM, gsz = (nM - fm) < WGM ? (nM - fm) : WGM;
        u.pm = fm + ((wgid % nig) % gsz); u.pn = (wgid % nig) / gsz; return true;
    }
    __device__ __forceinline__ void a_ready(const Unit&) const {}
    __device__ __forceinline__ void done(const Unit&) const {}
};
__device__ __forceinline__ unsigned cvt_pk_bf16(float lo, float hi) { unsigned r; asm volatile("v_cvt_pk_bf16_f32 %0, %1, %2" : "=v"(r) : "v"(lo), "v"(hi)); return r; }
__device__ __forceinline__ float sigm(float x) { return 1.0f / (1.0f + __expf(-x)); }
struct EpiBf16 {
    static constexpr bool PERM = true, AFTER_DRAIN = false;
    bf16_t* O; int ldc;
    __device__ __forceinline__ void operator()(const f32x4 (&acc)[2][2][4][2], const Unit& u, int wr, int wc, int fr, int fq) const {
        const int row0 = u.pm * BM + wr * 64 + fr, col0 = u.pn * BM + wc * 32 + 8 * fq;
#pragma unroll
        for (int ai = 0; ai < 2; ++ai)
#pragma unroll
            for (int m = 0; m < 4; ++m) { bf16_t* rowp = O + (size_t)(row0 + ai * HALF + m * 16) * ldc + col0;
#pragma unroll
                for (int bj = 0; bj < 2; ++bj) { const f32x4 v0 = acc[ai][bj][m][0], v1 = acc[ai][bj][m][1];
                    u32x4 w; w.x = cvt_pk_bf16(v0[0], v0[1]); w.y = cvt_pk_bf16(v0[2], v0[3]); w.z = cvt_pk_bf16(v1[0], v1[1]); w.w = cvt_pk_bf16(v1[2], v1[3]);
                    *(u32x4*)(rowp + bj * HALF) = w; } }
    }
};
struct EpiMemKV {
    static constexpr bool PERM = false, AFTER_DRAIN = false;
    float* Kout; float* Vout;
    __device__ __forceinline__ void operator()(const f32x4 (&acc)[2][2][4][2], const Unit& u, int wr, int wc, int fr, int fq) const {
        const int row0 = u.pm * BM + wr * 64 + fr; int colt = u.pn * BM; float* base = colt < 512 ? Kout : Vout; colt &= 511;
        const int col0 = colt + wc * 32 + 4 * fq;
#pragma unroll
        for (int ai = 0; ai < 2; ++ai)
#pragma unroll
            for (int m = 0; m < 4; ++m) { float* rowp = base + (size_t)(row0 + ai * HALF + m * 16) * 512 + col0;
#pragma unroll
                for (int bj = 0; bj < 2; ++bj)
#pragma unroll
                    for (int n = 0; n < 2; ++n) *(f32x4*)(rowp + bj * HALF + n * 16) = acc[ai][bj][m][n]; }
    }
};
struct EpiLru {
    static constexpr bool PERM = false, AFTER_DRAIN = false;
    const float* ba; const float* bi; const float* lam; const bf16_t* XAC; float* LA; float* LB;
    __device__ __forceinline__ void operator()(const f32x4 (&acc)[2][2][4][2], const Unit& u, int wr, int wc, int fr, int fq) const {
        const int row0 = u.pm * BM + wr * 64 + fr, ch0 = u.pn * HALF + wc * 32 + 4 * fq;
        f32x4 bav[2], biv[2], spv[2];
#pragma unroll
        for (int n = 0; n < 2; ++n) { bav[n] = *(const f32x4*)(ba + ch0 + 16 * n); biv[n] = *(const f32x4*)(bi + ch0 + 16 * n);
            const f32x4 lv = *(const f32x4*)(lam + ch0 + 16 * n);
#pragma unroll
            for (int j = 0; j < 4; ++j) { const float z = -lv[j]; spv[n][j] = (z > 20.f) ? z : log1pf(__expf(z)); } }
#pragma unroll
        for (int ai = 0; ai < 2; ++ai)
#pragma unroll
            for (int m = 0; m < 4; ++m) { const size_t off = (size_t)(row0 + ai * HALF + m * 16) * 512 + ch0;
#pragma unroll
                for (int n = 0; n < 2; ++n) {
                    const f32x4 r = acc[ai][0][m][n] + bav[n], g = acc[ai][1][m][n] + biv[n];
                    const unsigned long long xw = *(const unsigned long long*)(XAC + off + 16 * n);
                    float xv[4]; xv[0] = __uint_as_float((unsigned)(xw & 0xffffu) << 16); xv[1] = __uint_as_float((unsigned)xw & 0xffff0000u);
                    xv[2] = __uint_as_float((unsigned)((xw >> 32) & 0xffffu) << 16); xv[3] = __uint_as_float((unsigned)(xw >> 32) & 0xffff0000u);
                    f32x4 av, bv;
#pragma unroll
                    for (int j = 0; j < 4; ++j) { const float la = -8.0f * sigm(r[j]) * spv[n][j]; av[j] = __expf(la); bv[j] = sqrtf(-expm1f(2.0f * la)) * (sigm(g[j]) * xv[j]); }
                    *(f32x4*)(LA + off + 16 * n) = av; *(f32x4*)(LB + off + 16 * n) = bv; } }
    }
};
struct EpiGate {
    static constexpr bool PERM = true, AFTER_DRAIN = false;
    const float* bias; const bf16_t* T; bf16_t* P;
    __device__ __forceinline__ void operator()(const f32x4 (&acc)[2][2][4][2], const Unit& u, int wr, int wc, int fr, int fq) const {
        const int row0 = u.pm * BM + wr * 64 + fr, col0 = u.pn * BM + wc * 32 + 8 * fq;
        f32x4 bv[2][2];
#pragma unroll
        for (int bj = 0; bj < 2; ++bj)
#pragma unroll
            for (int n = 0; n < 2; ++n) bv[bj][n] = *(const f32x4*)(bias + col0 + bj * HALF + 4 * n);
#pragma unroll
        for (int ai = 0; ai < 2; ++ai)
#pragma unroll
            for (int m = 0; m < 4; ++m) { const size_t off = (size_t)(row0 + ai * HALF + m * 16) * 5120 + col0;
#pragma unroll
                for (int bj = 0; bj < 2; ++bj) { const u32x4 t = *(const u32x4*)(T + off + bj * HALF);
                    const f32x4 v0 = acc[ai][bj][m][0] + bv[bj][0], v1 = acc[ai][bj][m][1] + bv[bj][1];
                    u32x4 w;
                    w.x = cvt_pk_bf16(sigm(v0[0]) * __uint_as_float(t.x << 16), sigm(v0[1]) * __uint_as_float(t.x & 0xffff0000u));
                    w.y = cvt_pk_bf16(sigm(v0[2]) * __uint_as_float(t.y << 16), sigm(v0[3]) * __uint_as_float(t.y & 0xffff0000u));
                    w.z = cvt_pk_bf16(sigm(v1[0]) * __uint_as_float(t.z << 16), sigm(v1[1]) * __uint_as_float(t.z & 0xffff0000u));
                    w.w = cvt_pk_bf16(sigm(v1[2]) * __uint_as_float(t.w << 16), sigm(v1[3]) * __uint_as_float(t.w & 0xffff0000u));
                    *(u32x4*)(P + off + bj * HALF) = w; }
                asm volatile("" ::: "memory"); }
    }
};
struct EpiRes {
    static constexpr bool PERM = false, AFTER_DRAIN = false;
    const float* X; float* Z; int nvalid; float alpha;
    __device__ __forceinline__ void operator()(const f32x4 (&acc)[2][2][4][2], const Unit& u, int wr, int wc, int fr, int fq) const {
        const int row0 = u.pm * BM + wr * 64 + fr, col0 = u.pn * BM + wc * 32 + 4 * fq;
#pragma unroll
        for (int ai = 0; ai < 2; ++ai)
#pragma unroll
            for (int m = 0; m < 4; ++m) { const int row = row0 + ai * HALF + m * 16; const size_t off = (size_t)row * 1024 + col0; const bool rv = row < nvalid;
#pragma unroll
                for (int bj = 0; bj < 2; ++bj)
#pragma unroll
                    for (int n = 0; n < 2; ++n) { f32x4 x = (f32x4){0.f, 0.f, 0.f, 0.f}; if (rv) x = *(const f32x4*)(X + off + bj * HALF + n * 16);
                        *(f32x4*)(Z + off + bj * HALF + n * 16) = x * alpha + acc[ai][bj][m][n]; }
                asm volatile("" ::: "memory"); }
    }
};
struct EpiSwiglu {
    static constexpr bool PERM = true, AFTER_DRAIN = false;
    bf16_t* H;
    __device__ __forceinline__ void operator()(const f32x4 (&acc)[2][2][4][2], const Unit& u, int wr, int wc, int fr, int fq) const {
        const int row0 = u.pm * BM + wr * 64 + fr, col0 = u.pn * HALF + wc * 32 + 8 * fq;
#pragma unroll
        for (int ai = 0; ai < 2; ++ai)
#pragma unroll
            for (int m = 0; m < 4; ++m) { bf16_t* rowp = H + (size_t)(row0 + ai * HALF + m * 16) * 2816 + col0;
                const f32x4 g0 = acc[ai][0][m][0], g1 = acc[ai][0][m][1], v0 = acc[ai][1][m][0], v1 = acc[ai][1][m][1];
                u32x4 w;
                w.x = cvt_pk_bf16(g0[0] * sigm(g0[0]) * v0[0], g0[1] * sigm(g0[1]) * v0[1]);
                w.y = cvt_pk_bf16(g0[2] * sigm(g0[2]) * v0[2], g0[3] * sigm(g0[3]) * v0[3]);
                w.z = cvt_pk_bf16(g1[0] * sigm(g1[0]) * v1[0], g1[1] * sigm(g1[1]) * v1[1]);
                w.w = cvt_pk_bf16(g1[2] * sigm(g1[2]) * v1[2], g1[3] * sigm(g1[3]) * v1[3]);
                *(u32x4*)rowp = w; }
    }
};

template <class Epi, class Sched, bool ALIGN_EPI = false, bool SP2 = false>
__device__ __forceinline__ void gemm_phase(PG8_LAS unsigned char* lds, const Gemm g, const Sched& S, const Epi& E) {
    int tid_ = threadIdx.x; asm volatile("" : "+v"(tid_));
    const int tid = tid_, wid = __builtin_amdgcn_readfirstlane(tid >> 6), lane = tid & 63, wr = wid >> 2, wc = wid & 3, fr = lane & 15, fq = lane >> 4;
    const int K = g.K, nt = K / BK;
    unsigned voffA[2], voffB[2];
#pragma unroll
    for (int i = 0; i < 2; ++i) { int R, C; stage_rc(tid * 16 + i * 8192, R, C); const int Rb = Epi::PERM ? ((R & ~31) + perm32(R & 31)) : R;
        voffA[i] = (unsigned)(R * K + C) * 2u; voffB[i] = (unsigned)(Rb * K + C) * 2u; }
    const size_t kstep = (size_t)(BK * 2);
    const size_t hstep = (size_t)HALF * K * 2;
    const size_t tstep = 2 * hstep;
    const unsigned ldsw = (unsigned)wid * 1024u;
    const int aoff = lds_byte(wr * 64 + fr, fq * 8), boff = lds_byte(wc * 32 + fr, fq * 8);
#define PG8_SA(b, h) (((b) * 2 + (h)) * HTB)
#define PG8_SB(b, h) ((4 + (b) * 2 + (h)) * HTB)
#define PG8_STAGE(bufoff, gbase, voff) do { _Pragma("unroll") for (int _i = 0; _i < 2; ++_i) \
        __builtin_amdgcn_global_load_lds((const unsigned*)((const char*)(gbase) + (voff)[_i]), (PG8_LAS unsigned*)(lds + (bufoff) + ldsw + _i * 8192), 16, 0, 0); } while (0)
#define PG8_LDA(dst, b, h) do { _Pragma("unroll") for (int m = 0; m < 4; ++m) _Pragma("unroll") for (int k = 0; k < 2; ++k) dst[m][k] = *(const PG8_LAS bf16x8*)(lds + PG8_SA(b, h) + aoff + m * 2048 + k * 1024); } while (0)
#define PG8_LDB(dst, b, h) do { _Pragma("unroll") for (int n = 0; n < 2; ++n) _Pragma("unroll") for (int k = 0; k < 2; ++k) dst[n][k] = *(const PG8_LAS bf16x8*)(lds + PG8_SB(b, h) + boff + n * 2048 + k * 1024); } while (0)
#define PG8_MMA(ai, bj, At, Bt) do { __builtin_amdgcn_s_setprio(1); _Pragma("unroll") for (int m = 0; m < 4; ++m) _Pragma("unroll") for (int n = 0; n < 2; ++n) _Pragma("unroll") for (int k = 0; k < 2; ++k) \
        acc[ai][bj][m][n] = __builtin_amdgcn_mfma_f32_16x16x32_bf16(Bt[n][k], At[m][k], acc[ai][bj][m][n], 0, 0, 0); __builtin_amdgcn_s_setprio(0); } while (0)
#define PG8_WAIT_V(n) asm volatile("s_waitcnt vmcnt(" #n ")" ::: "memory")
#define PG8_WAIT_L(n) asm volatile("s_waitcnt lgkmcnt(" #n ")" ::: "memory")
#define PG8_BAR __builtin_amdgcn_s_barrier()
#define PG8_SCHED __builtin_amdgcn_sched_barrier(0)
    Unit cur, nxt; int ui = 0;
    if (!S.next(0, cur)) return;
    f32x4 acc[2][2][4][2];
#pragma unroll
    for (int a = 0; a < 2; ++a)
#pragma unroll
        for (int b = 0; b < 2; ++b)
#pragma unroll
            for (int m = 0; m < 4; ++m)
#pragma unroll
                for (int n = 0; n < 2; ++n) acc[a][b][m][n] = (f32x4){0.f, 0.f, 0.f, 0.f};
    bf16x8 At[4][2], B0[2][2], B1[2][2];
    const char* cA = (const char*)g.A + (size_t)cur.pm * tstep; const char* cB = (const char*)g.Bt + (size_t)cur.pn * tstep;
    S.a_ready(cur);
    if constexpr (SP2) {
        PG8_STAGE(PG8_SB(0, 0), cB, voffB); PG8_STAGE(PG8_SB(0, 1), cB + hstep, voffB); PG8_STAGE(PG8_SA(0, 0), cA, voffA); PG8_STAGE(PG8_SA(0, 1), cA + hstep, voffA);
        if (wr == 1) PG8_BAR;
        PG8_WAIT_V(2); PG8_BAR;
        PG8_STAGE(PG8_SB(1, 0), cB + kstep, voffB); PG8_STAGE(PG8_SA(1, 0), cA + kstep, voffA); PG8_STAGE(PG8_SB(1, 1), cB + hstep + kstep, voffB);
        PG8_WAIT_V(6); PG8_BAR;
    } else {
        PG8_STAGE(PG8_SB(0, 0), cB, voffB); PG8_STAGE(PG8_SA(0, 0), cA, voffA); PG8_STAGE(PG8_SB(0, 1), cB + hstep, voffB); PG8_STAGE(PG8_SA(0, 1), cA + hstep, voffA);
        if (wr == 1) PG8_BAR;
        PG8_WAIT_V(4); PG8_BAR;
        PG8_STAGE(PG8_SB(1, 0), cB + kstep, voffB); PG8_STAGE(PG8_SA(1, 0), cA + kstep, voffA); PG8_STAGE(PG8_SB(1, 1), cB + hstep + kstep, voffB);
        PG8_WAIT_V(6); PG8_BAR;
    }
    for (;;) {
        const bool has_next = S.next(ui + 1, nxt);
        const char* nA = has_next ? (const char*)g.A + (size_t)nxt.pm * tstep : cA; const char* nB = has_next ? (const char*)g.Bt + (size_t)nxt.pn * tstep : cB;
        for (int t = 0; t < nt; t += 2) {
            const bool last = (t == nt - 2);
            const char* a1 = cA + (size_t)(t + 1) * kstep;
            const char* a2 = last ? nA : cA + (size_t)(t + 2) * kstep; const char* b2 = last ? nB : cB + (size_t)(t + 2) * kstep;
            const char* a3 = a2 + kstep; const char* b3 = b2 + kstep;
            if (last && has_next) S.a_ready(nxt);
            if constexpr (SP2) {
            PG8_LDB(B0, 0, 0); PG8_LDB(B1, 0, 1); PG8_SCHED; PG8_LDA(At, 0, 0); PG8_STAGE(PG8_SA(1, 1), a1 + hstep, voffA);
            PG8_WAIT_V(8); PG8_WAIT_L(0); PG8_BAR; PG8_MMA(0, 0, At, B0); PG8_MMA(0, 1, At, B1); PG8_BAR; PG8_SCHED;
            PG8_LDA(At, 0, 1); PG8_STAGE(PG8_SB(0, 0), b2, voffB); PG8_STAGE(PG8_SB(0, 1), b2 + hstep, voffB); PG8_STAGE(PG8_SA(0, 0), a2, voffA);
            PG8_WAIT_V(8); PG8_WAIT_L(0); PG8_BAR; PG8_MMA(1, 0, At, B0); PG8_MMA(1, 1, At, B1); PG8_BAR; PG8_SCHED;
            PG8_LDB(B0, 1, 0); PG8_LDB(B1, 1, 1); PG8_SCHED; PG8_LDA(At, 1, 0); PG8_STAGE(PG8_SA(0, 1), a2 + hstep, voffA);
            PG8_WAIT_V(8); PG8_WAIT_L(0); PG8_BAR; PG8_MMA(0, 0, At, B0); PG8_MMA(0, 1, At, B1); PG8_BAR; PG8_SCHED;
            PG8_LDA(At, 1, 1); PG8_STAGE(PG8_SB(1, 0), b3, voffB); PG8_STAGE(PG8_SB(1, 1), b3 + hstep, voffB); PG8_STAGE(PG8_SA(1, 0), a3, voffA);
            PG8_WAIT_V(8); PG8_WAIT_L(0); PG8_BAR; PG8_MMA(1, 0, At, B0); PG8_MMA(1, 1, At, B1); PG8_BAR; PG8_SCHED;
            } else {
            PG8_LDB(B0, 0, 0); PG8_SCHED; PG8_LDA(At, 0, 0); PG8_STAGE(PG8_SA(1, 1), a1 + hstep, voffA);
            PG8_WAIT_L(8); PG8_BAR; PG8_WAIT_L(0); PG8_MMA(0, 0, At, B0); PG8_BAR; PG8_SCHED;
            PG8_LDB(B1, 0, 1); PG8_STAGE(PG8_SB(0, 0), b2, voffB);
            PG8_BAR; PG8_WAIT_L(0); PG8_MMA(0, 1, At, B1); PG8_BAR;
            PG8_LDA(At, 0, 1); PG8_STAGE(PG8_SA(0, 0), a2, voffA);
            PG8_BAR; PG8_WAIT_L(0); PG8_MMA(1, 0, At, B0); PG8_BAR; PG8_SCHED;
            PG8_STAGE(PG8_SB(0, 1), b2 + hstep, voffB);
            PG8_WAIT_V(6); PG8_BAR; PG8_MMA(1, 1, At, B1); PG8_BAR;
            PG8_LDB(B0, 1, 0); PG8_SCHED; PG8_LDA(At, 1, 0); PG8_STAGE(PG8_SA(0, 1), a2 + hstep, voffA);
            PG8_WAIT_L(8); PG8_BAR; PG8_WAIT_L(0); PG8_MMA(0, 0, At, B0); PG8_BAR; PG8_SCHED;
            PG8_LDB(B1, 1, 1); PG8_STAGE(PG8_SB(1, 0), b3, voffB);
            PG8_BAR; PG8_WAIT_L(0); PG8_MMA(0, 1, At, B1); PG8_BAR;
            PG8_LDA(At, 1, 1); PG8_STAGE(PG8_SA(1, 0), a3, voffA);
            PG8_BAR; PG8_WAIT_L(0); PG8_MMA(1, 0, At, B0); PG8_BAR; PG8_SCHED;
            PG8_STAGE(PG8_SB(1, 1), b3 + hstep, voffB);
            PG8_WAIT_V(6); PG8_BAR; PG8_MMA(1, 1, At, B1); PG8_BAR;
            }
        }
        if constexpr (ALIGN_EPI) { if (wr == 0) PG8_BAR; }
        if constexpr (!Epi::AFTER_DRAIN) { E(acc, cur, wr, wc, fr, fq); S.done(cur); }
        if (!has_next) break;
#pragma unroll
        for (int a = 0; a < 2; ++a)
#pragma unroll
            for (int b = 0; b < 2; ++b)
#pragma unroll
                for (int m = 0; m < 4; ++m)
#pragma unroll
                    for (int n = 0; n < 2; ++n) acc[a][b][m][n] = (f32x4){0.f, 0.f, 0.f, 0.f};
        cur = nxt; cA = nA; cB = nB; ++ui;
        if constexpr (ALIGN_EPI) { if (wr == 1) PG8_BAR; }
    }
    PG8_WAIT_V(0);
    if constexpr (!ALIGN_EPI) { if (wr == 0) PG8_BAR; }
    PG8_BAR;
    if constexpr (Epi::AFTER_DRAIN) { E.fused(acc, cur, wr, wc, fr, fq, lds, wid, lane); S.done(cur); }
#undef PG8_SA
#undef PG8_SB
#undef PG8_STAGE
#undef PG8_LDA
#undef PG8_LDB
#undef PG8_MMA
#undef PG8_WAIT_V
#undef PG8_WAIT_L
#undef PG8_BAR
#undef PG8_SCHED
}
}
#define GAS __attribute__((address_space(1)))
#define LAS __attribute__((address_space(3)))
typedef unsigned short bf16;
typedef unsigned v4u __attribute__((ext_vector_type(4)));
typedef float f32x4 __attribute__((ext_vector_type(4)));
typedef short bf16x8 __attribute__((ext_vector_type(8)));
typedef GAS unsigned gu32;
typedef GAS unsigned long long gu64;
#define RLX_AGENT __ATOMIC_RELAXED, __HIP_MEMORY_SCOPE_AGENT
#define LDS_WAIT() asm volatile("s_waitcnt lgkmcnt(0)" ::: "memory")
#define VM_WAIT() asm volatile("s_waitcnt vmcnt(0)" ::: "memory")
__device__ __forceinline__ unsigned long long rt() { return __builtin_amdgcn_s_memrealtime(); }
__device__ __forceinline__ unsigned f2bf(float f) { unsigned u = __builtin_bit_cast(unsigned, f); return (u + 0x7fffu + ((u >> 16) & 1u)) >> 16; }
__device__ __forceinline__ unsigned pk2(float lo, float hi) { return f2bf(lo) | (f2bf(hi) << 16); }
#define XB_TMO      128
#define XB_XCNT(j)  (256  + 64 * (j))
#define XB_XSUB(j)  (1280 + 64 * (j))
#define XB_XGEN(j)  (2304 + 64 * (j))
#define XB_TOP      3328
#define XB_TOPGEN   3392
#define XCD_BAR_WORDS 3456
#define XB_SPIN_CAP (1u << 18)

__device__ __forceinline__ unsigned xb_ld(unsigned* p)              { return __hip_atomic_load(p, __ATOMIC_RELAXED, __HIP_MEMORY_SCOPE_AGENT); }
__device__ __forceinline__ unsigned xb_add(unsigned* p, unsigned v) { return __hip_atomic_fetch_add(p, v, __ATOMIC_RELAXED, __HIP_MEMORY_SCOPE_AGENT); }
__device__ __forceinline__ unsigned xb_xcc_id() { return (unsigned)__builtin_amdgcn_s_getreg((3 << 11) | 20) & 0xFu; }
#define XB_SPIN(cond, bar) do { unsigned _sp = 0; while (cond) { __builtin_amdgcn_s_sleep(1); \
    if ((++_sp & 255u) == 0u) { if (xb_ld(&(bar)[XB_TMO])) break; if (_sp > XB_SPIN_CAP) { atomicAdd(&(bar)[XB_TMO], 1u); break; } } } } while (0)

struct XcdBarrier {
    unsigned* bar; unsigned x;
    volatile LAS unsigned* st;
};

__device__ __forceinline__ XcdBarrier xcd_barrier_post(unsigned* bar, volatile LAS unsigned* st) {
    XcdBarrier b; b.bar = bar; b.x = xb_xcc_id(); b.st = st;
    if (threadIdx.x == 0) (void)xb_add(&bar[XB_XCNT(b.x)], 1u);
    return b;
}
__device__ __forceinline__ void xcd_barrier_complete(unsigned* bar, unsigned x, unsigned& nloc, unsigned& nx) {
    const unsigned G = gridDim.x * gridDim.y * gridDim.z;
    unsigned sum, cnt, mine, sp = 0u;
    for (;;) {
        sum = 0u; cnt = 0u; mine = 0u;
#pragma unroll
        for (unsigned j = 0; j < 16; ++j) { const unsigned c = xb_ld(&bar[XB_XCNT(j)]); sum += c; cnt += (c > 0u) ? 1u : 0u; mine = (j == x) ? c : mine; }
        if (sum == G) break;
        __builtin_amdgcn_s_sleep(1);
        if ((++sp & 255u) == 0u) { if (xb_ld(&bar[XB_TMO])) break; if (sp > XB_SPIN_CAP) { atomicAdd(&bar[XB_TMO], 1u); break; } }
    }
    nloc = mine > 0u ? mine : 1u; nx = cnt > 0u ? cnt : 1u;
}

__device__ __forceinline__ void xcd_barrier(const XcdBarrier& b) {
    asm volatile("s_waitcnt vmcnt(0)" ::: "memory");
    __syncthreads();
    if (threadIdx.x == 0) {
        unsigned* bar = b.bar;
        __builtin_amdgcn_s_waitcnt(0);
        unsigned nloc = b.st[0], nx = b.st[1];
        if (nloc == 0u) { xcd_barrier_complete(bar, b.x, nloc, nx); b.st[0] = nloc; b.st[1] = nx; }
        const unsigned old = xb_add(&bar[XB_XSUB(b.x)], 1u);
        const unsigned gen = old / nloc;
        if (old + 1u == (gen + 1u) * nloc) {
            __builtin_amdgcn_fence(__ATOMIC_RELEASE, "agent");
            asm volatile("s_waitcnt vmcnt(0)" ::: "memory");
            const unsigned og = xb_add(&bar[XB_TOP], 1u);
            const unsigned tg = og / nx;
            if (og + 1u == (tg + 1u) * nx) xb_add(&bar[XB_TOPGEN], 1u);
            else XB_SPIN(xb_ld(&bar[XB_TOPGEN]) == tg, bar);
            __builtin_amdgcn_fence(__ATOMIC_ACQUIRE, "agent");
            xb_add(&bar[XB_XGEN(b.x)], 1u);
            asm volatile("s_waitcnt vmcnt(0)" ::: "memory");
        } else {
            XB_SPIN(xb_ld(&bar[XB_XGEN(b.x)]) == gen, bar);
            __builtin_amdgcn_fence(__ATOMIC_ACQUIRE, "agent");
            asm volatile("s_waitcnt vmcnt(0)" ::: "memory");
        }
    }
    __syncthreads();
}
constexpr int NWAVES = 8, NTHR = 512;
constexpr int DM = 1024, BATCH = 8, SEQ = 2048, DEPTH = 2, DECB = 128, WBR = 512, NH = 4, HD = 128, NMEM = 256, DFF = 2816;
constexpr int MPR = BATCH * SEQ;
constexpr int MROWS = MPR + DECB;
constexpr int MP = 16640;
constexpr int NIN = 7176, NU = 7168;
constexpr float LN_EPS = 1e-5f, NORM_EPS = 1e-6f, ALPHA = 1.41421356237309515f;
constexpr int U_XA = 0, U_GQ = 512, U_GK = 1024, U_GV = 1536, U_GZ = 2048, U_HQ = 2560, U_HF = 3072, U_HI = 3584, U_HG = 4096, U_RQ = 4608, U_RK = 5120, U_RV = 5632, U_RG = 6144, U_XQ = 6656;
enum { I_XP = 0, I_XS, I_MEM, I_SLRUH, I_SLRUC, I_SGDNC, I_SGDNS, I_SHGRNS, I_SRETS, I_CK, I_CV, I_WIN, I_LCW, I_LCB, I_LWA, I_LBA, I_LWI, I_LBI, I_LLAM,
       I_GCW, I_GALOG, I_GDT, I_GNW, I_HLB, I_HNW, I_RGW, I_RGB, I_WMK, I_WMV, I_WMG, I_BMG, I_WBR, I_WOUT, I_LN1G, I_LN1B, I_WUP, I_WDN, I_LN2G, I_LN2B, N_INPUTS };
constexpr size_t O_YP = 0, O_YS = O_YP + (size_t)MPR * DM, O_PLH = O_YS + (size_t)DECB * DM, O_PLC = O_PLH + 2 * 8 * 512, O_PGC = O_PLC + 2 * 8 * 3 * 512,
    O_PGS = O_PGC + 2 * 8 * 3 * 1536, O_PHS = O_PGS + 2 * 8 * 4 * 16384, O_PRS = O_PHS + 2 * 8 * 4 * 16384, O_PMK = O_PRS + 2 * 8 * 4 * 16384, O_PMV = O_PMK + (size_t)2 * 8 * 256 * 512,
    O_SLH = O_PMV + (size_t)2 * 8 * 256 * 512, O_SLC = O_SLH + 2 * 128 * 512, O_SGC = O_SLC + 2 * 128 * 3 * 512, O_SGS = O_SGC + (size_t)2 * 128 * 3 * 1536,
    O_SHS = O_SGS + (size_t)2 * 128 * 4 * 16384, O_SRS = O_SHS + (size_t)2 * 128 * 4 * 16384, O_END = O_SRS + (size_t)2 * 128 * 4 * 16384;
constexpr size_t WS_CTL = 0, CTL_ZERO_BYTES = 1u << 20;
constexpr size_t SZ_WIN = (size_t)NU * DM * 2, SZ_WKV = (size_t)1024 * DM * 2, SZ_WLRU = (size_t)1024 * 512 * 2, SZ_WG = (size_t)5120 * DM * 2, SZ_WB = (size_t)5 * 1024 * 512 * 2,
    SZ_WO5 = (size_t)1024 * 5120 * 2, SZ_WUP = (size_t)5632 * DM * 2, SZ_WDN = (size_t)1024 * DFF * 2;
constexpr size_t WL_WIN = 0, WL_WKV = WL_WIN + SZ_WIN, WL_WLRU = WL_WKV + SZ_WKV, WL_WG = WL_WLRU + SZ_WLRU, WL_WB = WL_WG + SZ_WG, WL_WO5 = WL_WB + SZ_WB, WL_WUP = WL_WO5 + SZ_WO5,
    WL_WDN = WL_WUP + SZ_WUP, WL_SIZE = WL_WDN + SZ_WDN;
constexpr size_t WS_W = CTL_ZERO_BYTES;
constexpr size_t WS_WBA = WS_W + 2 * WL_SIZE;
constexpr size_t WS_LBV = WS_WBA + 2 * 8 * 1024 * 4;
constexpr size_t WS_ROPE = WS_LBV + 2 * 512 * 4;
constexpr size_t WS_XB = WS_ROPE + (size_t)2 * 2049 * 64 * 4 + 512;
constexpr size_t WS_MB = WS_XB + (size_t)MP * DM * 2;
constexpr size_t WS_KB = WS_MB + (size_t)2048 * DM * 2;
constexpr size_t WS_VT = WS_KB + (size_t)8 * 4 * 256 * 128 * 2;
constexpr size_t WS_BETA = WS_VT + (size_t)8 * 4 * 256 * 128 * 2;
constexpr size_t WS_EG = WS_BETA + (size_t)MP * 4 * 4;
constexpr size_t WS_U = WS_EG + (size_t)MP * 4 * 4;
constexpr size_t WS_R2 = WS_U + (size_t)MP * NU * 2;
constexpr size_t SZ_B512 = (size_t)MP * 512 * 2, SZ_F512 = (size_t)MP * 512 * 4;
constexpr size_t WS_XAC = WS_R2, WS_GQ = WS_XAC + SZ_B512, WS_GK = WS_GQ + SZ_B512, WS_GV = WS_GK + SZ_B512, WS_OG = WS_GV + SZ_B512, WS_OH = WS_OG + SZ_F512, WS_OR = WS_OH + SZ_F512;
static_assert(WS_OR + SZ_F512 == WS_R2 + (size_t)MP * 5120 * 2, "R2 map");
constexpr size_t WS_Z = WS_R2 + (size_t)MP * 5120 * 2;
constexpr size_t WS_LA = WS_Z, WS_LB = WS_Z + SZ_F512;
constexpr size_t WS_Y = WS_Z + (size_t)MP * DM * 4;
constexpr size_t WS_END = WS_Y + (size_t)5 * SZ_B512;
static_assert(WS_XB % 256 == 0 && WS_U % 256 == 0 && WS_R2 % 256 == 0 && WS_Z % 256 == 0 && WS_Y % 256 == 0, "alignment");
constexpr int CW_TMO = 0, CW_CODE = 1, CW_BAR = 4096, CW_QUEUE = 16384;
constexpr int SCR_BYTES = 143360;
constexpr int LDSCTL_OFF = SCR_BYTES, MISC_OFF = LDSCTL_OFF + 320, LDS_BYTES = 147456;
#ifndef PHMASK
#define PHMASK 0xFFFFFFFFu
#endif
#define EN(k) (((PHMASK) >> (k)) & 1u)
__device__ __forceinline__ float bflo(unsigned w) { return __uint_as_float(w << 16); }
__device__ __forceinline__ float bfhi(unsigned w) { return __uint_as_float(w & 0xffff0000u); }
__device__ __forceinline__ float sigm(float x) { return 1.0f / (1.0f + __expf(-x)); }
__device__ __forceinline__ float siluf(float x) { return x * sigm(x); }
__device__ __forceinline__ float softplusf(float x) { return (x > 20.f) ? x : log1pf(__expf(x)); }
__device__ __forceinline__ void unpack8(const v4u w, float (&o)[8]) { o[0] = bflo(w.x); o[1] = bfhi(w.x); o[2] = bflo(w.y); o[3] = bfhi(w.y); o[4] = bflo(w.z); o[5] = bfhi(w.z); o[6] = bflo(w.w); o[7] = bfhi(w.w); }
__device__ __forceinline__ v4u pack8(const float (&o)[8]) { v4u w; w.x = pk2(o[0], o[1]); w.y = pk2(o[2], o[3]); w.z = pk2(o[4], o[5]); w.w = pk2(o[6], o[7]); return w; }
__device__ __forceinline__ void ld8bf(const bf16* p, float (&o)[8]) { const v4u w = *(const v4u*)p; unpack8(w, o); }
__device__ __forceinline__ void ld8f(const float* p, float (&o)[8]) { const f32x4 a = *(const f32x4*)p, b = *(const f32x4*)(p + 4); o[0] = a.x; o[1] = a.y; o[2] = a.z; o[3] = a.w; o[4] = b.x; o[5] = b.y; o[6] = b.z; o[7] = b.w; }
__device__ __forceinline__ void st8f(float* p, const float (&o)[8]) { *(f32x4*)p = (f32x4){o[0], o[1], o[2], o[3]}; *(f32x4*)(p + 4) = (f32x4){o[4], o[5], o[6], o[7]}; }
template <int CTRL> __device__ __forceinline__ float dppf(float x) { return __builtin_bit_cast(float, __builtin_amdgcn_update_dpp(0, __builtin_bit_cast(int, x), CTRL, 0xf, 0xf, true)); }
__device__ __forceinline__ float row16_sum(float x) {
    x += dppf<0xB1>(x);
    x += dppf<0x4E>(x);
    x += dppf<0x141>(x);
    x += dppf<0x140>(x);
    return x;
}
__device__ __forceinline__ float wave_sum(float v) {
#pragma unroll
    for (int o = 1; o < 64; o <<= 1) v += __shfl_xor(v, o);
    return v;
}

typedef const float* cfp_t; typedef __attribute__((address_space(4))) const cfp_t* kin_t;
struct Frame {
    LAS unsigned char* lds;
    volatile LAS unsigned* MISC;
    gu32* ctl;
    int tid, lane, wave, vcu, G;
    kin_t in;
    float* out; unsigned char* ws;
};
#define WSP(T, off) ((T*)(F.ws + (off)))
#define INP(i) (F.in[i])

__device__ __forceinline__ void transpose_block(const float* src, int ld, bf16* dst, int ldt, LAS float* scr, int lane) {
#pragma unroll 8
    for (int i = 0; i < 32; ++i) { const int kk = 2 * i + (lane >> 5); scr[kk * 33 + (lane & 31)] = src[(size_t)kk * ld + (lane & 31)]; }
    LDS_WAIT(); asm volatile("" ::: "memory");
    const int c = lane & 7;
#pragma unroll
    for (int j = 0; j < 4; ++j) { const int n = (lane >> 3) + 8 * j; const LAS float* s = scr + (8 * c) * 33 + n;
        v4u o; o.x = pk2(s[0 * 33], s[1 * 33]); o.y = pk2(s[2 * 33], s[3 * 33]); o.z = pk2(s[4 * 33], s[5 * 33]); o.w = pk2(s[6 * 33], s[7 * 33]);
        *(GAS v4u*)(dst + (size_t)n * ldt + 8 * c) = o; }
    LDS_WAIT(); asm volatile("" ::: "memory");
}

__device__ __forceinline__ void p0_prologue(Frame& F) {
    LAS float* scr = (LAS float*)(F.lds + F.wave * 16384);
    const int gw = F.vcu * NWAVES + F.wave, NGW = F.G * NWAVES, lane = F.lane;
    constexpr int IT_IN = 16 * 224, IT_KV = 16 * 32, IT_G = 5 * 16 * 32, IT_B = 5 * 8 * 32, IT_O = 5 * 16 * 32, IT_UP = 16 * 176, IT_DN = 44 * 32, IT_LRU = 2 * 4 * 2 * 4;
    constexpr int IT_L = IT_IN + IT_KV + IT_G + IT_B + IT_O + IT_UP + IT_DN + IT_LRU;
#pragma clang loop unroll(disable)
    for (int it = gw; it < 2 * IT_L; it += NGW) {
        const int l = it / IT_L; int r = it % IT_L;
        unsigned char* wl = F.ws + WS_W + (size_t)l * WL_SIZE;
        if (r < IT_IN) { const int kb = r / 224, nb = r % 224, n0 = nb * 32, sc = n0 < 2560 ? n0 : n0 + 8;
            transpose_block(INP(I_WIN) + (size_t)l * DM * NIN + (size_t)(kb * 64) * NIN + sc, NIN, (bf16*)(wl + WL_WIN) + (size_t)n0 * DM + kb * 64, DM, scr, lane); continue; } r -= IT_IN;
        if (r < IT_KV) { const int kb = r / 32, nb = r % 32, n0 = nb * 32; const float* W = (n0 < 512 ? INP(I_WMK) : INP(I_WMV)) + (size_t)l * DM * 512;
            transpose_block(W + (size_t)(kb * 64) * 512 + (n0 & 511), 512, (bf16*)(wl + WL_WKV) + (size_t)n0 * DM + kb * 64, DM, scr, lane); continue; } r -= IT_KV;
        if (r < IT_G) { const int n = r / 512, q = r % 512, kb = q / 32, nb = q % 32;
            transpose_block(INP(I_WMG) + ((size_t)(l * 5 + n) * DM + kb * 64) * DM + nb * 32, DM, (bf16*)(wl + WL_WG) + (size_t)(n * 1024 + nb * 32) * DM + kb * 64, DM, scr, lane); continue; } r -= IT_G;
        if (r < IT_B) { const int n = r / 256, q = r % 256, kb = q / 32, nb = q % 32;
            transpose_block(INP(I_WBR) + ((size_t)(l * 5 + n) * 512 + kb * 64) * DM + nb * 32, DM, (bf16*)(wl + WL_WB) + ((size_t)n * 1024 + nb * 32) * 512 + kb * 64, 512, scr, lane); continue; } r -= IT_B;
        if (r < IT_O) { const int n = r / 512, q = r % 512, kb = q / 32, nb = q % 32;
            transpose_block(INP(I_WOUT) + ((size_t)l * DM + kb * 64) * DM + nb * 32, DM, (bf16*)(wl + WL_WO5) + (size_t)(nb * 32) * 5120 + n * 1024 + kb * 64, 5120, scr, lane); continue; } r -= IT_O;
        if (r < IT_UP) { const int kb = r / 176, nb = r % 176, c0 = nb * 32, half = c0 >= DFF ? 1 : 0, j0 = c0 - half * DFF, drow = (j0 >> 7) * 256 + half * 128 + (j0 & 127);
            transpose_block(INP(I_WUP) + ((size_t)l * DM + kb * 64) * 5632 + c0, 5632, (bf16*)(wl + WL_WUP) + (size_t)drow * DM + kb * 64, DM, scr, lane); continue; } r -= IT_UP;
        if (r < IT_DN) { const int kb = r / 32, nb = r % 32;
            transpose_block(INP(I_WDN) + ((size_t)l * DFF + kb * 64) * DM + nb * 32, DM, (bf16*)(wl + WL_WDN) + (size_t)(nb * 32) * DFF + kb * 64, DFF, scr, lane); continue; } r -= IT_DN;
        { const int which = r / 32, q = r % 32, h = q / 8, kb = (q % 8) / 4, nb = q % 4;
            const float* W = (which ? INP(I_LWI) : INP(I_LWA)) + ((size_t)(l * 4 + h) * 128 + kb * 64) * 128 + nb * 32;
            transpose_block(W, 128, (bf16*)(wl + WL_WLRU) + (size_t)(h * 256 + which * 128 + nb * 32) * 512 + h * 128 + kb * 64, 512, scr, lane); }
    }
    const size_t gt = (size_t)F.vcu * NTHR + F.tid, GT = (size_t)F.G * NTHR;
#pragma clang loop unroll(disable)
    for (size_t i = gt; i < (size_t)2 * 1024 * 64; i += GT) { const int l = (int)(i / (1024 * 64)), q = (int)(i % (1024 * 64)), row = q / 64, c8 = q % 64, h = row / 256;
        if ((c8 >> 4) != h) *(v4u*)((bf16*)(F.ws + WS_W + (size_t)l * WL_SIZE + WL_WLRU) + (size_t)row * 512 + c8 * 8) = (v4u){0u, 0u, 0u, 0u}; }
#pragma clang loop unroll(disable)
    for (size_t i = gt; i < (size_t)MP * 128; i += GT) { const size_t row = i / 128; const int c = (int)(i % 128) * 8; float v[8] = {0.f, 0.f, 0.f, 0.f, 0.f, 0.f, 0.f, 0.f};
        if (row < MROWS) { ld8f(row < MPR ? INP(I_XP) + row * DM + c : INP(I_XS) + (row - MPR) * DM + c, v); st8f(F.out + row * DM + c, v); }
        *(v4u*)(WSP(bf16, WS_XB) + row * DM + c) = pack8(v); }
#pragma clang loop unroll(disable)
    for (size_t i = gt; i < (size_t)2048 * 128; i += GT) { float v[8]; ld8f(INP(I_MEM) + i * 8, v); *(v4u*)(WSP(bf16, WS_MB) + i * 8) = pack8(v); }
#pragma clang loop unroll(disable)
    for (size_t i = gt; i < (size_t)2 * 8 * 1024; i += GT) { const int l = (int)(i / 8192), c = (int)(i / 1024) % 8, k = (int)(i % 1024); WSP(float, WS_WBA)[i] = INP(I_WIN)[((size_t)l * DM + k) * NIN + 2560 + c]; }
#pragma clang loop unroll(disable)
    for (size_t i = gt; i < 512; i += GT) { const float r0 = INP(I_HLB)[i], r1 = INP(I_HLB)[512 + i], mx = fmaxf(r0, r1), e0 = expf(r0 - mx), e1 = expf(r1 - mx);
        WSP(float, WS_LBV)[i] = 0.f; WSP(float, WS_LBV)[512 + i] = e1 / (e0 + e1); }
#pragma clang loop unroll(disable)
    for (size_t i = gt; i < (size_t)2049 * 64; i += GT) { const int p = (int)(i / 64), j = (int)(i % 64); const double pos = p < 2048 ? (double)p : 16384.0;
        const double inv = exp2(-(double)j * (13.287712379549449 / 64.0)); const double ang = pos * inv;
        WSP(float, WS_ROPE)[i] = (float)cos(ang); WSP(float, WS_ROPE)[(size_t)2049 * 64 + i] = (float)sin(ang); }
}
__device__ __forceinline__ void p2_prepass(Frame& F, int l) {
    const int gw = F.vcu * NWAVES + F.wave, NGW = F.G * NWAVES, lane = F.lane, c8 = lane * 8;
    bf16* U = WSP(bf16, WS_U);
    const float* ropec = WSP(float, WS_ROPE); const float* ropes = ropec + 2049 * 64;
#pragma clang loop unroll(disable)
    for (int m = gw; m < MROWS; m += NGW) {
        const bool prompt = m < MPR; const int b = m >> 11, t = m & 2047, s = m - MPR;
        bf16* urow = U + (size_t)m * NU;
        {   const float* xr = F.out + (size_t)m * DM; const float* wb = WSP(float, WS_WBA) + (size_t)l * 8 * 1024;
            float d[8];
#pragma unroll
            for (int c = 0; c < 8; ++c) d[c] = 0.f;
#pragma unroll
            for (int j = 0; j < 4; ++j) { const f32x4 xv = *(const f32x4*)(xr + 4 * lane + 256 * j);
#pragma unroll
                for (int c = 0; c < 8; ++c) { const f32x4 wv = *(const f32x4*)(wb + c * 1024 + 4 * lane + 256 * j); d[c] += (xv.x * wv.x + xv.y * wv.y) + (xv.z * wv.z + xv.w * wv.w); } }
#pragma unroll
            for (int c = 0; c < 8; ++c) d[c] = wave_sum(d[c]);
            if (lane < 4) { const float db = lane == 0 ? d[0] : lane == 1 ? d[1] : lane == 2 ? d[2] : d[3], da = lane == 0 ? d[4] : lane == 1 ? d[5] : lane == 2 ? d[6] : d[7];
                const float g = -expf(INP(I_GALOG)[l * 4 + lane]) * softplusf(da + INP(I_GDT)[l * 4 + lane]);
                WSP(float, WS_BETA)[(size_t)m * 4 + lane] = sigm(db); WSP(float, WS_EG)[(size_t)m * 4 + lane] = expf(g); } }
        {   float x0[8], x1[8], x2[8], x3[8];
            ld8bf(urow + U_XA + c8, x3);
            if (prompt) {
                if (t >= 1) ld8bf(urow - NU + U_XA + c8, x2); else { for (int e = 0; e < 8; ++e) x2[e] = 0.f; }
                if (t >= 2) ld8bf(urow - 2 * NU + U_XA + c8, x1); else { for (int e = 0; e < 8; ++e) x1[e] = 0.f; }
                if (t >= 3) ld8bf(urow - 3 * NU + U_XA + c8, x0); else { for (int e = 0; e < 8; ++e) x0[e] = 0.f; }
                if (t >= SEQ - 3) st8f(F.out + O_PLC + ((size_t)(l * 8 + b) * 3 + (t - (SEQ - 3))) * 512 + c8, x3);
            } else {
                const float* sb = INP(I_SLRUC) + ((size_t)(l * DECB + s) * 3) * 512 + c8;
                ld8f(sb, x0); ld8f(sb + 512, x1); ld8f(sb + 1024, x2);
                float* so = F.out + O_SLC + ((size_t)(l * DECB + s) * 3) * 512 + c8;
                st8f(so, x1); st8f(so + 512, x2); st8f(so + 1024, x3);
            }
            float w0[8], w1[8], w2[8], w3[8], bb[8], o[8];
            const float* cw = INP(I_LCW) + (size_t)l * 4 * 512 + c8;
            ld8f(cw, w0); ld8f(cw + 512, w1); ld8f(cw + 1024, w2); ld8f(cw + 1536, w3); ld8f(INP(I_LCB) + l * 512 + c8, bb);
#pragma unroll
            for (int e = 0; e < 8; ++e) o[e] = w0[e] * x0[e] + w1[e] * x1[e] + w2[e] * x2[e] + w3[e] * x3[e] + bb[e];
            *(v4u*)(WSP(bf16, WS_XAC) + (size_t)m * 512 + c8) = pack8(o); }
#pragma unroll 1
        for (int grp = 0; grp < 3; ++grp) {
            const int cu = U_GQ + grp * 512 + c8, cc = grp * 512 + c8;
            float x0[8], x1[8], x2[8], x3[8];
            ld8bf(urow + cu, x3);
            if (prompt) {
                if (t >= 1) ld8bf(urow - NU + cu, x2); else { for (int e = 0; e < 8; ++e) x2[e] = 0.f; }
                if (t >= 2) ld8bf(urow - 2 * NU + cu, x1); else { for (int e = 0; e < 8; ++e) x1[e] = 0.f; }
                if (t >= 3) ld8bf(urow - 3 * NU + cu, x0); else { for (int e = 0; e < 8; ++e) x0[e] = 0.f; }
                if (t >= SEQ - 3) st8f(F.out + O_PGC + ((size_t)(l * 8 + b) * 3 + (t - (SEQ - 3))) * 1536 + cc, x3);
            } else {
                const float* sb = INP(I_SGDNC) + ((size_t)(l * DECB + s) * 3) * 1536 + cc;
                ld8f(sb, x0); ld8f(sb + 1536, x1); ld8f(sb + 3072, x2);
                float* so = F.out + O_SGC + ((size_t)(l * DECB + s) * 3) * 1536 + cc;
                st8f(so, x1); st8f(so + 1536, x2); st8f(so + 3072, x3);
            }
            float w0[8], w1[8], w2[8], w3[8], o[8];
            const float* cw = INP(I_GCW) + (size_t)l * 4 * 1536 + cc;
            ld8f(cw, w0); ld8f(cw + 1536, w1); ld8f(cw + 3072, w2); ld8f(cw + 4608, w3);
            float ss = 0.f;
#pragma unroll
            for (int e = 0; e < 8; ++e) { const float v = w0[e] * x0[e] + w1[e] * x1[e] + w2[e] * x2[e] + w3[e] * x3[e]; o[e] = siluf(v); ss += o[e] * o[e]; }
            if (grp < 2) { ss = row16_sum(ss); const float sc = rsqrtf(ss + NORM_EPS) * (grp == 0 ? 0.08838834764831845f : 1.0f);
#pragma unroll
                for (int e = 0; e < 8; ++e) o[e] *= sc; }
            bf16* dst = grp == 0 ? WSP(bf16, WS_GQ) : grp == 1 ? WSP(bf16, WS_GK) : WSP(bf16, WS_GV);
            *(v4u*)(dst + (size_t)m * 512 + c8) = pack8(o);
        }
        {   float q[8], f[8], lb[8]; ld8bf(urow + U_HQ + c8, q); ld8bf(urow + U_HF + c8, f); ld8f(WSP(float, WS_LBV) + l * 512 + c8, lb);
#pragma unroll
            for (int e = 0; e < 8; ++e) { q[e] = siluf(q[e]); f[e] = lb[e] + (1.0f - lb[e]) * sigm(f[e]); }
            *(v4u*)(urow + U_HQ + c8) = pack8(q); *(v4u*)(urow + U_HF + c8) = pack8(f); }
        {   const int ti = prompt ? t : 2048, jj = (lane & 7) * 8; const bool hi = (lane & 8) != 0;
            float cs[8], sn[8]; ld8f(ropec + (size_t)ti * 64 + jj, cs); ld8f(ropes + (size_t)ti * 64 + jj, sn);
#pragma unroll 1
            for (int w = 0; w < 2; ++w) { const int cu = (w ? U_RK : U_RQ) + c8; const float sc = w ? 0.08838834764831845f : 1.0f;
                float x[8], o[8]; ld8bf(urow + cu, x);
#pragma unroll
                for (int e = 0; e < 8; ++e) { const float other = __shfl_xor(x[e], 8); o[e] = (hi ? (x[e] * cs[e] + other * sn[e]) : (x[e] * cs[e] - other * sn[e])) * sc; }
                *(v4u*)(urow + cu) = pack8(o); } }
    }
    {   const size_t gt = (size_t)F.vcu * NTHR + F.tid, GT = (size_t)F.G * NTHR;
        const float* mk = F.out + O_PMK + (size_t)l * 8 * 256 * 512; const float* mv = F.out + O_PMV + (size_t)l * 8 * 256 * 512;
#pragma clang loop unroll(disable)
        for (size_t i = gt; i < (size_t)8 * 4 * 256 * 16; i += GT) { const int d8 = (int)(i % 16), mm = (int)(i / 16) % 256, h = (int)(i / 4096) % 4, b = (int)(i / 16384);
            float v[8]; ld8f(mk + ((size_t)(b * 256 + mm) * 4 + h) * 128 + d8 * 8, v); *(v4u*)(WSP(bf16, WS_KB) + (((size_t)(b * 4 + h) * 256 + mm) * 128 + d8 * 8)) = pack8(v); }
#pragma clang loop unroll(disable)
        for (size_t i = gt; i < (size_t)8 * 4 * 128 * 32; i += GT) { const int m8 = (int)(i % 32), d = (int)(i / 32) % 128, h = (int)(i / 4096) % 4, b = (int)(i / 16384);
            float v[8];
#pragma unroll
            for (int e = 0; e < 8; ++e) v[e] = mv[((size_t)(b * 256 + m8 * 8 + e) * 4 + h) * 128 + d];
            *(v4u*)(WSP(bf16, WS_VT) + (((size_t)(b * 4 + h) * 128 + d) * 256 + m8 * 8)) = pack8(v); }
    }
}
constexpr int SQ_A = 0, SQ_Q = 16384, SQ_V = 32768, SQ_SC = 36864, SQ_BUF = 37376, SQ_O = 2 * SQ_BUF, SQ_OBYTES = 8192;
struct SeqArgs { const bf16* A; const bf16* Q; const bf16* V; int lda, ldq, ldv; const float* beta; const float* eg; float gamma; const float* S0; float* Sout; float* O; int T; int vs0, vs1; };
template <int TYPE>
__device__ __forceinline__ void seq_unit(Frame& F, const SeqArgs& a) {
    LAS unsigned char* lds = F.lds;
    const int tid = F.tid, lane = F.lane, kg = lane & 15, v = 4 * F.wave + (lane >> 4);
    const int nch = (a.T + 63) >> 6;
    for (int vs = a.vs0; vs < a.vs1; ++vs) {
        const int v0 = vs * 32;
        float S[8];
#pragma unroll
        for (int i = 0; i < 8; ++i) S[i] = a.S0 ? a.S0[(size_t)(8 * kg + i) * 128 + v0 + v] : 0.f;
        v4u ra0 = (v4u){0u,0u,0u,0u}, ra1 = ra0, rq0 = ra0, rq1 = ra0, rv = ra0; float rsb = 0.f, rse = 0.f;
#define SQ_GLOAD(c_) do { const int t0 = (c_) * 64; \
            { const int p = tid, row = p >> 4, cc = p & 15; const bool ok = t0 + row < a.T; \
              ra0 = ok ? *(const v4u*)(a.A + (size_t)(t0 + row) * a.lda + cc * 8) : (v4u){0u, 0u, 0u, 0u}; rq0 = ok ? *(const v4u*)(a.Q + (size_t)(t0 + row) * a.ldq + cc * 8) : (v4u){0u, 0u, 0u, 0u}; } \
            { const int p = tid + 512, row = p >> 4, cc = p & 15; const bool ok = t0 + row < a.T; \
              ra1 = ok ? *(const v4u*)(a.A + (size_t)(t0 + row) * a.lda + cc * 8) : (v4u){0u, 0u, 0u, 0u}; rq1 = ok ? *(const v4u*)(a.Q + (size_t)(t0 + row) * a.ldq + cc * 8) : (v4u){0u, 0u, 0u, 0u}; } \
            if (tid < 256) { const int row = tid >> 2, cc = tid & 3; rv = (t0 + row < a.T) ? *(const v4u*)(a.V + (size_t)(t0 + row) * a.ldv + v0 + cc * 8) : (v4u){0u, 0u, 0u, 0u}; } \
            if (TYPE == 0 && tid >= 256 && tid < 320) { const int row = tid - 256; if (t0 + row < a.T) { rsb = a.beta[(size_t)(t0 + row) * 4]; rse = a.eg[(size_t)(t0 + row) * 4]; } else { rsb = 0.f; rse = 1.f; } } } while (0)
#define SQ_LSTORE(buf_) do { LAS unsigned char* B_ = lds + (buf_) * SQ_BUF; \
            *(LAS v4u*)(B_ + SQ_A + tid * 16) = ra0; *(LAS v4u*)(B_ + SQ_A + (tid + 512) * 16) = ra1; \
            *(LAS v4u*)(B_ + SQ_Q + tid * 16) = rq0; *(LAS v4u*)(B_ + SQ_Q + (tid + 512) * 16) = rq1; \
            if (tid < 256) *(LAS v4u*)(B_ + SQ_V + tid * 16) = rv; \
            if (TYPE == 0 && tid >= 256 && tid < 320) { ((LAS float*)(B_ + SQ_SC))[(tid - 256) * 2] = rsb; ((LAS float*)(B_ + SQ_SC))[(tid - 256) * 2 + 1] = rse; } } while (0)
        SQ_GLOAD(0); SQ_LSTORE(0);
        __syncthreads();
        for (int c = 0; c < nch; ++c) {
            const int buf = c & 1;
            if (c + 1 < nch) SQ_GLOAD(c + 1);
            const LAS unsigned char* B = lds + buf * SQ_BUF;
            LAS float* Ob = (LAS float*)(lds + SQ_O + buf * SQ_OBYTES);
            const int n = (a.T - c * 64) < 64 ? (a.T - c * 64) : 64;
#pragma unroll 4
            for (int tt = 0; tt < n; ++tt) {
                float kk[8], qq[8];
                unpack8(*(const LAS v4u*)(B + SQ_A + tt * 256 + kg * 16), kk);
                unpack8(*(const LAS v4u*)(B + SQ_Q + tt * 256 + kg * 16), qq);
                const float vv = __uint_as_float((unsigned)(*(const LAS unsigned short*)(B + SQ_V + tt * 64 + v * 2)) << 16);
                if (TYPE == 0) {
                    const float be = ((const LAS float*)(B + SQ_SC))[tt * 2], eg = ((const LAS float*)(B + SQ_SC))[tt * 2 + 1];
                    float ks = (kk[0] * S[0] + kk[1] * S[1]) + (kk[2] * S[2] + kk[3] * S[3]) + ((kk[4] * S[4] + kk[5] * S[5]) + (kk[6] * S[6] + kk[7] * S[7]));
                    ks = row16_sum(ks);
                    const float uu = be * (vv - eg * ks);
#pragma unroll
                    for (int i = 0; i < 8; ++i) S[i] = eg * S[i] + kk[i] * uu;
                } else if (TYPE == 1) {
#pragma unroll
                    for (int i = 0; i < 8; ++i) S[i] = kk[i] * S[i] + (1.0f - kk[i]) * vv;
                } else {
#pragma unroll
                    for (int i = 0; i < 8; ++i) S[i] = a.gamma * S[i] + kk[i] * vv;
                }
                float o = (qq[0] * S[0] + qq[1] * S[1]) + (qq[2] * S[2] + qq[3] * S[3]) + ((qq[4] * S[4] + qq[5] * S[5]) + (qq[6] * S[6] + qq[7] * S[7]));
                o = row16_sum(o);
                if (kg == 0) Ob[tt * 32 + v] = o;
            }
            if (c + 1 < nch) SQ_LSTORE(buf ^ 1);
            __syncthreads();
            { const int row = tid >> 3, c4 = tid & 7; if (c * 64 + row < a.T) *(f32x4*)(a.O + (size_t)(c * 64 + row) * 512 + v0 + c4 * 4) = *(const LAS f32x4*)((const LAS unsigned char*)Ob + row * 128 + c4 * 16); }
        }
#pragma unroll
        for (int i = 0; i < 8; ++i) a.Sout[(size_t)(8 * kg + i) * 128 + v0 + v] = S[i];
        __syncthreads();
    }
}

__device__ __forceinline__ void lru_scan_unit(Frame& F, int l, int b, int cg) {
    const int tid = F.tid, seg = tid >> 5, ch = cg * 32 + (tid & 31);
    const float* LA = WSP(float, WS_LA) + ((size_t)(b * SEQ + seg * 128)) * 512 + ch; const float* LB = WSP(float, WS_LB) + ((size_t)(b * SEQ + seg * 128)) * 512 + ch;
    LAS float* car = (LAS float*)F.lds;
    float A = 1.f, Bc = 0.f;
#pragma unroll 8
    for (int t = 0; t < 128; ++t) { const float av = LA[(size_t)t * 512], bv = LB[(size_t)t * 512]; Bc = av * Bc + bv; A *= av; }
    car[(seg * 32 + (tid & 31)) * 2] = A; car[(seg * 32 + (tid & 31)) * 2 + 1] = Bc;
    __syncthreads();
    float h = 0.f;
    for (int s2 = 0; s2 < seg; ++s2) h = car[(s2 * 32 + (tid & 31)) * 2] * h + car[(s2 * 32 + (tid & 31)) * 2 + 1];
    bf16* Y = WSP(bf16, WS_Y) + ((size_t)(b * SEQ + seg * 128)) * 512 + ch;
#pragma unroll 8
    for (int t = 0; t < 128; ++t) { const float av = LA[(size_t)t * 512], bv = LB[(size_t)t * 512]; h = av * h + bv; Y[(size_t)t * 512] = (bf16)f2bf(h); }
    if (seg == 15) F.out[O_PLH + (size_t)(l * 8 + b) * 512 + ch] = h;
    __syncthreads();
}

constexpr int XK_STRIDE = 272, XV_STRIDE = 528, XV_OFF = 256 * XK_STRIDE;
static_assert(XV_OFF + 128 * XV_STRIDE <= SCR_BYTES, "cross-attention LDS");
__device__ __forceinline__ void cross_prompt_unit(Frame& F, int b, int h, int tb) {
    LAS unsigned char* lds = F.lds; const int tid = F.tid, lane = F.lane, g = lane >> 4, lr = lane & 15;
    const bf16* Kb = WSP(bf16, WS_KB) + (size_t)(b * 4 + h) * 256 * 128; const bf16* Vt = WSP(bf16, WS_VT) + (size_t)(b * 4 + h) * 128 * 256;
#pragma unroll
    for (int i = 0; i < 8; ++i) { const int p = tid + 512 * i, row = p >> 4, c = p & 15; *(LAS v4u*)(lds + row * XK_STRIDE + c * 16) = *(const v4u*)(Kb + (size_t)row * 128 + c * 8); }
#pragma unroll
    for (int i = 0; i < 8; ++i) { const int p = tid + 512 * i, row = p >> 5, c = p & 31; *(LAS v4u*)(lds + XV_OFF + row * XV_STRIDE + c * 16) = *(const v4u*)(Vt + (size_t)row * 256 + c * 8); }
    __syncthreads();
    const bf16* U = WSP(bf16, WS_U); bf16* Y4 = WSP(bf16, WS_Y) + (size_t)4 * MP * 512;
    typedef float f4 __attribute__((ext_vector_type(4)));
#pragma unroll 1
    for (int gi = 0; gi < 4; ++gi) {
        const int m0 = b * SEQ + tb * 512 + (F.wave + 8 * gi) * 16;
        bf16x8 qf[4];
#pragma unroll
        for (int ks = 0; ks < 4; ++ks) qf[ks] = *(const bf16x8*)(U + (size_t)(m0 + lr) * NU + U_XQ + h * 128 + 32 * ks + 8 * g);
        f4 st[16];
#pragma unroll
        for (int mt = 0; mt < 16; ++mt) { f4 acc = (f4){0.f, 0.f, 0.f, 0.f};
#pragma unroll
            for (int ks = 0; ks < 4; ++ks) { const bf16x8 af = *(const LAS bf16x8*)(lds + (16 * mt + lr) * XK_STRIDE + (32 * ks + 8 * g) * 2); acc = __builtin_amdgcn_mfma_f32_16x16x32_bf16(af, qf[ks], acc, 0, 0, 0); }
            st[mt] = acc; __builtin_amdgcn_sched_barrier(0); }
        float mx = -3.0e38f;
#pragma unroll
        for (int mt = 0; mt < 16; ++mt) mx = fmaxf(mx, fmaxf(fmaxf(st[mt][0], st[mt][1]), fmaxf(st[mt][2], st[mt][3])));
        mx = fmaxf(mx, __shfl_xor(mx, 16)); mx = fmaxf(mx, __shfl_xor(mx, 32));
        const float sc = 0.08838834764831845f; float sum = 0.f;
#pragma unroll
        for (int mt = 0; mt < 16; ++mt)
#pragma unroll
            for (int r = 0; r < 4; ++r) { const float p = __expf((st[mt][r] - mx) * sc); st[mt][r] = p; sum += p; }
        sum += __shfl_xor(sum, 16); sum += __shfl_xor(sum, 32);
        const float inv = 1.0f / sum;
        bf16x8 pf[8];
#pragma unroll
        for (int k2 = 0; k2 < 8; ++k2) { v4u w; w.x = pk2(st[2 * k2][0], st[2 * k2][1]); w.y = pk2(st[2 * k2][2], st[2 * k2][3]); w.z = pk2(st[2 * k2 + 1][0], st[2 * k2 + 1][1]); w.w = pk2(st[2 * k2 + 1][2], st[2 * k2 + 1][3]);
            pf[k2] = __builtin_bit_cast(bf16x8, w); }
#pragma unroll
        for (int dt = 0; dt < 8; ++dt) { f4 acc = (f4){0.f, 0.f, 0.f, 0.f};
#pragma unroll
            for (int k2 = 0; k2 < 8; ++k2) { const LAS unsigned char* vp = lds + XV_OFF + (16 * dt + lr) * XV_STRIDE + (32 * k2 + 4 * g) * 2;
                const unsigned long long lo = *(const LAS unsigned long long*)vp, hi = *(const LAS unsigned long long*)(vp + 32);
                v4u w; w.x = (unsigned)lo; w.y = (unsigned)(lo >> 32); w.z = (unsigned)hi; w.w = (unsigned)(hi >> 32);
                acc = __builtin_amdgcn_mfma_f32_16x16x32_bf16(__builtin_bit_cast(bf16x8, w), pf[k2], acc, 0, 0, 0); }
            unsigned long long o = (unsigned long long)pk2(acc[0] * inv, acc[1] * inv) | ((unsigned long long)pk2(acc[2] * inv, acc[3] * inv) << 32);
            *(unsigned long long*)(Y4 + (size_t)(m0 + lr) * 512 + h * 128 + 16 * dt + 4 * g) = o; __builtin_amdgcn_sched_barrier(0); }
    }
    __syncthreads();
}

__device__ __forceinline__ void cross_sample_unit(Frame& F, int l, int s, int h) {
    const int tid = F.tid; LAS float* sm = (LAS float*)F.lds;
    const bf16* U = WSP(bf16, WS_U);
    if (tid < 128) sm[tid] = bflo((unsigned)U[(size_t)(MPR + s) * NU + U_XQ + h * 128 + tid]);
    __syncthreads();
    const float* K = INP(I_CK) + (((size_t)(l * DECB + s) * 256) * 4 + h) * 128; const float* V = INP(I_CV) + (((size_t)(l * DECB + s) * 256) * 4 + h) * 128;
    { const int mm = tid >> 1, hf = tid & 1; const float* kr = K + (size_t)mm * 512 + hf * 64; float d = 0.f;
#pragma unroll
      for (int j = 0; j < 16; ++j) { const f32x4 kv = *(const f32x4*)(kr + 4 * j); const LAS float* q = sm + hf * 64 + 4 * j; d += (kv.x * q[0] + kv.y * q[1]) + (kv.z * q[2] + kv.w * q[3]); }
      d += __shfl_xor(d, 1);
      if (hf == 0) sm[128 + mm] = d * 0.08838834764831845f; }
    __syncthreads();
    float mx = -3.0e38f;
    for (int j = 0; j < 256; ++j) mx = fmaxf(mx, sm[128 + j]);
    float sum = 0.f;
    for (int j = 0; j < 256; ++j) sum += __expf(sm[128 + j] - mx);
    { const int d = tid & 127, q4 = tid >> 7; float o = 0.f;
#pragma unroll 8
      for (int j = 0; j < 64; ++j) { const int mm = q4 * 64 + j; o += __expf(sm[128 + mm] - mx) * V[(size_t)mm * 512 + d]; }
      sm[384 + q4 * 128 + d] = o; }
    __syncthreads();
    if (tid < 128) { const float o = (sm[384 + tid] + sm[512 + tid]) + (sm[640 + tid] + sm[768 + tid]);
        WSP(bf16, WS_Y)[(size_t)4 * MP * 512 + (size_t)(MPR + s) * 512 + h * 128 + tid] = (bf16)f2bf(o / sum); }
    __syncthreads();
}

__device__ __forceinline__ void p4_mixers(Frame& F, int l) {
    constexpr int N_SEQP = 128, Q_GDN = 0, Q_HGRN = 128, Q_RET = 256, Q_LRU = 384, Q_XP = 512, Q_SS = 640, Q_XS = Q_SS + 3 * 512, Q_END = Q_XS + 512;
    const bf16* U = WSP(bf16, WS_U);
    for (;;) {
        if (F.tid == 0) F.MISC[16] = __hip_atomic_fetch_add((unsigned*)(F.ctl + CW_QUEUE + 64 * l), 1u, __ATOMIC_RELAXED, __HIP_MEMORY_SCOPE_AGENT);
        __syncthreads();
        const int idx = (int)F.MISC[16];
        __syncthreads();
        if (idx >= Q_END) break;
        if (idx < Q_LRU) {
            const int type = idx / N_SEQP, j = idx % N_SEQP, b = j >> 4, h = (j >> 2) & 3, vs = j & 3; const size_t m0 = (size_t)b * SEQ;
            SeqArgs a; a.T = SEQ; a.vs0 = vs; a.vs1 = vs + 1; a.S0 = nullptr; a.gamma = 0.f; a.beta = nullptr; a.eg = nullptr;
            const size_t so = ((size_t)(l * 8 + b) * 4 + h) * 16384;
            if (type == 0) { a.A = WSP(bf16, WS_GK) + m0 * 512 + h * 128; a.Q = WSP(bf16, WS_GQ) + m0 * 512 + h * 128; a.V = WSP(bf16, WS_GV) + m0 * 512 + h * 128; a.lda = a.ldq = a.ldv = 512;
                a.beta = WSP(float, WS_BETA) + m0 * 4 + h; a.eg = WSP(float, WS_EG) + m0 * 4 + h; a.Sout = F.out + O_PGS + so; a.O = WSP(float, WS_OG) + m0 * 512 + h * 128; if (EN(16)) seq_unit<0>(F, a); }
            else if (type == 1) { a.A = U + m0 * NU + U_HF + h * 128; a.Q = U + m0 * NU + U_HQ + h * 128; a.V = U + m0 * NU + U_HI + h * 128; a.lda = a.ldq = a.ldv = NU;
                a.Sout = F.out + O_PHS + so; a.O = WSP(float, WS_OH) + m0 * 512 + h * 128; if (EN(17)) seq_unit<1>(F, a); }
            else { a.A = U + m0 * NU + U_RK + h * 128; a.Q = U + m0 * NU + U_RQ + h * 128; a.V = U + m0 * NU + U_RV + h * 128; a.lda = a.ldq = a.ldv = NU; a.gamma = 1.0f - exp2f(-5.0f - (float)h);
                a.Sout = F.out + O_PRS + so; a.O = WSP(float, WS_OR) + m0 * 512 + h * 128; if (EN(18)) seq_unit<2>(F, a); }
        } else if (idx < Q_XP) { const int j = idx - Q_LRU; if (EN(19)) lru_scan_unit(F, l, j >> 4, j & 15); }
        else if (idx < Q_SS) { const int j = idx - Q_XP; if (EN(20)) cross_prompt_unit(F, j >> 4, (j >> 2) & 3, j & 3); }
        else if (idx < Q_XS) {
            const int j = idx - Q_SS, type = j / 512, s = (j % 512) >> 2, h = j & 3; const size_t m0 = (size_t)MPR + s;
            SeqArgs a; a.T = 1; a.vs0 = 0; a.vs1 = 4; a.gamma = 0.f; a.beta = nullptr; a.eg = nullptr;
            const size_t so = ((size_t)(l * DECB + s) * 4 + h) * 16384;
            if (type == 0) { a.A = WSP(bf16, WS_GK) + m0 * 512 + h * 128; a.Q = WSP(bf16, WS_GQ) + m0 * 512 + h * 128; a.V = WSP(bf16, WS_GV) + m0 * 512 + h * 128; a.lda = a.ldq = a.ldv = 512;
                a.beta = WSP(float, WS_BETA) + m0 * 4 + h; a.eg = WSP(float, WS_EG) + m0 * 4 + h; a.S0 = INP(I_SGDNS) + so; a.Sout = F.out + O_SGS + so; a.O = WSP(float, WS_OG) + m0 * 512 + h * 128; if (EN(16)) seq_unit<0>(F, a); }
            else if (type == 1) { a.A = U + m0 * NU + U_HF + h * 128; a.Q = U + m0 * NU + U_HQ + h * 128; a.V = U + m0 * NU + U_HI + h * 128; a.lda = a.ldq = a.ldv = NU;
                a.S0 = INP(I_SHGRNS) + so; a.Sout = F.out + O_SHS + so; a.O = WSP(float, WS_OH) + m0 * 512 + h * 128; if (EN(17)) seq_unit<1>(F, a); }
            else { a.A = U + m0 * NU + U_RK + h * 128; a.Q = U + m0 * NU + U_RQ + h * 128; a.V = U + m0 * NU + U_RV + h * 128; a.lda = a.ldq = a.ldv = NU; a.gamma = 1.0f - exp2f(-5.0f - (float)h);
                a.S0 = INP(I_SRETS) + so; a.Sout = F.out + O_SRS + so; a.O = WSP(float, WS_OR) + m0 * 512 + h * 128; if (EN(18)) seq_unit<2>(F, a); }
        } else { const int j = idx - Q_XS; if (EN(21)) cross_sample_unit(F, l, j >> 2, j & 3); }
    }
}
__device__ __forceinline__ void p5_postpass(Frame& F, int l) {
    const int gw = F.vcu * NWAVES + F.wave, NGW = F.G * NWAVES, lane = F.lane, c8 = lane * 8;
    const bf16* U = WSP(bf16, WS_U); bf16* Y = WSP(bf16, WS_Y);
#pragma clang loop unroll(disable)
    for (int m = gw; m < MROWS; m += NGW) {
        const bf16* urow = U + (size_t)m * NU;
        {   float o[8], z[8], w[8], y[8]; ld8f(WSP(float, WS_OG) + (size_t)m * 512 + c8, o); ld8bf(urow + U_GZ + c8, z); ld8f(INP(I_GNW) + l * 512 + c8, w);
            float ss = 0.f;
#pragma unroll
            for (int e = 0; e < 8; ++e) ss += o[e] * o[e];
            const float rstd = rsqrtf(row16_sum(ss) * (1.0f / 128.0f) + NORM_EPS);
#pragma unroll
            for (int e = 0; e < 8; ++e) y[e] = o[e] * rstd * w[e] * siluf(z[e]);
            *(v4u*)(Y + ((size_t)1 * MP + m) * 512 + c8) = pack8(y); }
        {   float o[8], z[8], w[8], y[8]; ld8f(WSP(float, WS_OH) + (size_t)m * 512 + c8, o); ld8bf(urow + U_HG + c8, z); ld8f(INP(I_HNW) + l * 512 + c8, w);
            float ss = 0.f;
#pragma unroll
            for (int e = 0; e < 8; ++e) ss += o[e] * o[e];
            const float rstd = rsqrtf(row16_sum(ss) * (1.0f / 128.0f) + NORM_EPS);
#pragma unroll
            for (int e = 0; e < 8; ++e) y[e] = o[e] * rstd * w[e] * sigm(z[e]);
            *(v4u*)(Y + ((size_t)2 * MP + m) * 512 + c8) = pack8(y); }
        {   float o[8], z[8], w[8], bb[8], y[8]; ld8f(WSP(float, WS_OR) + (size_t)m * 512 + c8, o); ld8bf(urow + U_RG + c8, z); ld8f(INP(I_RGW) + l * 512 + c8, w); ld8f(INP(I_RGB) + l * 512 + c8, bb);
            float s1 = 0.f;
#pragma unroll
            for (int e = 0; e < 8; ++e) s1 += o[e];
            const float mu = row16_sum(s1) * (1.0f / 128.0f); float s2 = 0.f;
#pragma unroll
            for (int e = 0; e < 8; ++e) { o[e] -= mu; s2 += o[e] * o[e]; }
            const float rstd = rsqrtf(row16_sum(s2) * (1.0f / 128.0f) + NORM_EPS);
#pragma unroll
            for (int e = 0; e < 8; ++e) y[e] = (o[e] * rstd * w[e] + bb[e]) * siluf(z[e]);
            *(v4u*)(Y + ((size_t)3 * MP + m) * 512 + c8) = pack8(y); }
        if (m >= MPR) {
            const int s = m - MPR; float a[8], b[8], h0[8], h[8];
            ld8f(WSP(float, WS_LA) + (size_t)m * 512 + c8, a); ld8f(WSP(float, WS_LB) + (size_t)m * 512 + c8, b); ld8f(INP(I_SLRUH) + ((size_t)l * DECB + s) * 512 + c8, h0);
#pragma unroll
            for (int e = 0; e < 8; ++e) h[e] = a[e] * h0[e] + b[e];
            st8f(F.out + O_SLH + ((size_t)l * DECB + s) * 512 + c8, h);
            *(v4u*)(Y + (size_t)m * 512 + c8) = pack8(h); }
    }
}
__device__ __forceinline__ void ln_pass(Frame& F, const float* gam, const float* bet) {
    const int gw = F.vcu * NWAVES + F.wave, NGW = F.G * NWAVES, lane = F.lane;
#pragma clang loop unroll(disable)
    for (int m = gw; m < MROWS; m += NGW) {
        const f32x4* zr = (const f32x4*)(WSP(float, WS_Z) + (size_t)m * DM) + lane;
        f32x4 v[4]; float s = 0.f;
#pragma unroll
        for (int j = 0; j < 4; ++j) { v[j] = zr[64 * j]; s += (v[j].x + v[j].y) + (v[j].z + v[j].w); }
        const float mean = wave_sum(s) * (1.f / DM); float s2 = 0.f;
#pragma unroll
        for (int j = 0; j < 4; ++j) { v[j] = v[j] - mean; s2 += (v[j].x * v[j].x + v[j].y * v[j].y) + (v[j].z * v[j].z + v[j].w * v[j].w); }
        const float rstd = rsqrtf(wave_sum(s2) * (1.f / DM) + LN_EPS);
        f32x4* xo = (f32x4*)(F.out + (size_t)m * DM) + lane; unsigned long long* xb = (unsigned long long*)(WSP(bf16, WS_XB) + (size_t)m * DM) + lane;
#pragma unroll
        for (int j = 0; j < 4; ++j) { const f32x4 gv = *((const f32x4*)gam + lane + 64 * j), bv = *((const f32x4*)bet + lane + 64 * j); const f32x4 y = v[j] * rstd * gv + bv;
            xo[64 * j] = y; xb[64 * j] = (unsigned long long)pk2(y.x, y.y) | ((unsigned long long)pk2(y.z, y.w) << 32); }
    }
}

struct Args { const float* in[N_INPUTS]; float* out; unsigned char* ws; };
#ifndef MAXPHASE
#define MAXPHASE 1000
#endif
__global__ void __launch_bounds__(NTHR, 2) mega_fwd(Args args) {
    extern __shared__ __attribute__((aligned(16))) unsigned char lds[];
    Frame F;
    F.lds = (LAS unsigned char*)lds; F.MISC = (volatile LAS unsigned*)(F.lds + MISC_OFF);
    F.tid = threadIdx.x; F.lane = F.tid & 63; F.wave = __builtin_amdgcn_readfirstlane(F.tid >> 6);
    F.G = gridDim.x; { const int bx = blockIdx.x; F.vcu = (F.G % 8 == 0) ? (bx % 8) * (F.G / 8) + bx / 8 : bx; }
    F.in = (kin_t)__builtin_amdgcn_kernarg_segment_ptr(); F.out = args.out; F.ws = args.ws; F.ctl = (gu32*)(args.ws + WS_CTL);
    for (int u = F.tid; u < (LDS_BYTES - LDSCTL_OFF) / 4; u += NTHR) ((LAS unsigned*)(F.lds + LDSCTL_OFF))[u] = 0u;
    __syncthreads();
    XcdBarrier bar = xcd_barrier_post((unsigned*)(F.ctl + CW_BAR), F.MISC + 8);
    int phase = 0;
#define GRID_BAR() do { xcd_barrier(bar); if (++phase >= MAXPHASE) return; asm volatile("" : "+s"(F.ws), "+s"(F.out), "+s"(F.in)); F.tid = threadIdx.x; asm volatile("" : "+v"(F.tid)); F.lane = F.tid & 63; F.wave = __builtin_amdgcn_readfirstlane(F.tid >> 6); } while (0)
    LAS unsigned char* glds = F.lds;

    if (EN(0)) p0_prologue(F);
    GRID_BAR();
#pragma unroll 1
    for (int l = 0; l < DEPTH; ++l) {
        unsigned char* wl = F.ws + WS_W + (size_t)l * WL_SIZE;
        if (EN(1)) {   pg8::Gemm g{WSP(bf16, WS_XB), (const bf16*)(wl + WL_WIN), MP, NU, DM}; pg8::StaticOrder S; S.init(MP, NU, F.G, (int)blockIdx.x);
            pg8::EpiBf16 E{WSP(bf16, WS_U), NU};
            pg8::gemm_phase<pg8::EpiBf16, pg8::StaticOrder, true, true>(glds, g, S, E); }
        if (EN(2)) {   pg8::Gemm g{WSP(bf16, WS_MB), (const bf16*)(wl + WL_WKV), 2048, 1024, DM}; pg8::StaticOrder S; S.init(2048, 1024, F.G, (int)blockIdx.x);
            pg8::EpiMemKV E{F.out + O_PMK + (size_t)l * 2048 * 512, F.out + O_PMV + (size_t)l * 2048 * 512};
            pg8::gemm_phase<pg8::EpiMemKV, pg8::StaticOrder, true, true>(glds, g, S, E); }
        GRID_BAR();
        if (EN(3)) p2_prepass(F, l);
        GRID_BAR();
        if (EN(4)) {   pg8::Gemm g{WSP(bf16, WS_XAC), (const bf16*)(wl + WL_WLRU), MP, 1024, 512}; pg8::StaticOrder S; S.init(MP, 1024, F.G, (int)blockIdx.x);
            pg8::EpiLru E{INP(I_LBA) + l * 512, INP(I_LBI) + l * 512, INP(I_LLAM) + l * 512, WSP(bf16, WS_XAC), WSP(float, WS_LA), WSP(float, WS_LB)};
            pg8::gemm_phase<pg8::EpiLru, pg8::StaticOrder, true, true>(glds, g, S, E); }
        GRID_BAR();
        if (EN(5)) p4_mixers(F, l);
        GRID_BAR();
        if (EN(6)) p5_postpass(F, l);
        GRID_BAR();
#pragma unroll 1
        for (int n = 0; n < (EN(7) ? 5 : 0); ++n) {
            pg8::Gemm g{WSP(bf16, WS_Y) + (size_t)n * MP * 512, (const bf16*)(wl + WL_WB) + (size_t)n * 1024 * 512, MP, 1024, 512}; pg8::StaticOrder S; S.init(MP, 1024, F.G, (int)blockIdx.x);
            pg8::EpiBf16 E{WSP(bf16, WS_U) + n * 1024, 5120};
            pg8::gemm_phase<pg8::EpiBf16, pg8::StaticOrder, true, true>(glds, g, S, E); }
        GRID_BAR();
        if (EN(8)) {   pg8::Gemm g{WSP(bf16, WS_XB), (const bf16*)(wl + WL_WG), MP, 5120, DM}; pg8::StaticOrder S; S.init(MP, 5120, F.G, (int)blockIdx.x);
            pg8::EpiGate E{INP(I_BMG) + (size_t)l * 5120, WSP(bf16, WS_U), WSP(bf16, WS_R2)};
            pg8::gemm_phase<pg8::EpiGate, pg8::StaticOrder, true, true>(glds, g, S, E); }
        GRID_BAR();
        if (EN(9)) {   pg8::Gemm g{WSP(bf16, WS_R2), (const bf16*)(wl + WL_WO5), MP, 1024, 5120}; pg8::StaticOrder S; S.init(MP, 1024, F.G, (int)blockIdx.x);
            pg8::EpiRes E{F.out, WSP(float, WS_Z), MROWS, ALPHA};
            pg8::gemm_phase<pg8::EpiRes, pg8::StaticOrder, true, true>(glds, g, S, E); }
        GRID_BAR();
        if (EN(10)) ln_pass(F, INP(I_LN1G) + l * DM, INP(I_LN1B) + l * DM);
        GRID_BAR();
        if (EN(11)) {   pg8::Gemm g{WSP(bf16, WS_XB), (const bf16*)(wl + WL_WUP), MP, 5632, DM}; pg8::StaticOrder S; S.init(MP, 5632, F.G, (int)blockIdx.x);
            pg8::EpiSwiglu E{WSP(bf16, WS_U)};
            pg8::gemm_phase<pg8::EpiSwiglu, pg8::StaticOrder, true, true>(glds, g, S, E); }
        GRID_BAR();
        if (EN(12)) {   pg8::Gemm g{WSP(bf16, WS_U), (const bf16*)(wl + WL_WDN), MP, 1024, DFF}; pg8::StaticOrder S; S.init(MP, 1024, F.G, (int)blockIdx.x);
            pg8::EpiRes E{F.out, WSP(float, WS_Z), MROWS, ALPHA};
            pg8::gemm_phase<pg8::EpiRes, pg8::StaticOrder, true, true>(glds, g, S, E); }
        GRID_BAR();
        if (EN(13)) ln_pass(F, INP(I_LN2G) + l * DM, INP(I_LN2B) + l * DM);
        if (l + 1 < DEPTH) GRID_BAR();
    }
}

extern "C" void kernel_launch(void* const* d_in, const int* in_sizes, int n_in, void* d_out, int out_size, void* d_ws, size_t ws_size, hipStream_t stream) {
    static int grid = 0;
    if (grid == 0) {
        if (n_in != N_INPUTS || (size_t)out_size != O_END || ws_size < WS_END) { fprintf(stderr, "kernel_launch: expected %d inputs, %zu outputs, >= %zu bytes of workspace; got %d, %d, %zu\n", (int)N_INPUTS, (size_t)O_END, (size_t)WS_END, n_in, out_size, ws_size); grid = -1; return; }
        int dev = 0, cus = 0, per_cu = 0;
        if (hipGetDevice(&dev) != hipSuccess || hipDeviceGetAttribute(&cus, hipDeviceAttributeMultiprocessorCount, dev) != hipSuccess) { fprintf(stderr, "kernel_launch: device query failed\n"); grid = -1; return; }
        if (hipFuncSetAttribute((const void*)mega_fwd, hipFuncAttributeMaxDynamicSharedMemorySize, LDS_BYTES) != hipSuccess) { fprintf(stderr, "kernel_launch: hipFuncSetAttribute failed\n"); grid = -1; return; }
        if (hipOccupancyMaxActiveBlocksPerMultiprocessor(&per_cu, (const void*)mega_fwd, NTHR, LDS_BYTES) != hipSuccess || per_cu < 1) fprintf(stderr, "kernel_launch: note: occupancy query says %d blocks per CU\n", per_cu);
        (void)hipGetLastError();
        grid = cus;
    }
    if (grid < 0) return;
    if (hipMemsetAsync((char*)d_ws + WS_CTL, 0, CTL_ZERO_BYTES, stream) != hipSuccess) { fprintf(stderr, "kernel_launch: hipMemsetAsync failed\n"); return; }
    Args a{};
    for (int i = 0; i < N_INPUTS; ++i) a.in[i] = (const float*)d_in[i];
    a.out = (float*)d_out; a.ws = (unsigned char*)d_ws;
    hipLaunchKernelGGL(mega_fwd, dim3(grid), dim3(NTHR), LDS_BYTES, stream, a);
    const hipError_t le = hipPeekAtLastError();
    if (le != hipSuccess) fprintf(stderr, "kernel_launch: launch failed: %s\n", hipGetErrorName(le));
}
```

```cpp
#include <hip/hip_runtime.h>
#include <cstdio>
#include <cstdint>
namespace pg8 {
#define PG8_LAS __attribute__((address_space(3)))
typedef unsigned short bf16_t;
typedef short bf16x8 __attribute__((ext_vector_type(8)));
typedef float f32x4 __attribute__((ext_vector_type(4)));
typedef unsigned u32x4 __attribute__((ext_vector_type(4)));
constexpr int BM = 256, BK = 64, HALF = 128, HTB = HALF * BK * 2  , STAGE_BYTES = 8 * HTB, NXCD = 8, WGM = 8;

__host__ __device__ __forceinline__ int lds_byte(int r, int c) { const int st = (r >> 4) * 2 + (c >> 5), rr = r & 15, cc = c & 31, ob = rr * 64 + cc * 2; return st * 1024 + (ob ^ (((ob >> 9) & 1) << 5)); }
__host__ __device__ __forceinline__ void stage_rc(int b, int& R, int& C) { const int st = b / 1024, sb = b % 1024, swz = sb ^ (((sb >> 9) & 1) << 5); R = (st >> 1) * 16 + swz / 64; C = (st & 1) * 32 + (swz % 64) / 2; }
__host__ __device__ __forceinline__ int perm32(int rho) { const int n = rho >> 4, i = rho & 15; return 8 * (i >> 2) + 4 * n + (i & 3); }

struct Unit { int pm, pn; };
struct Gemm { const bf16_t* A; const bf16_t* Bt; int M, N, K; };

struct StaticOrder {
    int nM, nN, nwg, G, c;
    __host__ __device__ void init(int M, int N, int G_, int c_) { nM = M / BM; nN = N / BM; nwg = nM * nN; G = G_; c = c_; }
    __host__ __device__ bool next(int i, Unit& u) const {
        const long L = (long)i * G + c; if (L >= nwg) return false;
        int wgid = (int)L; { const int q = nwg / NXCD, r = nwg % NXCD, xcd = wgid % NXCD, off = wgid / NXCD; wgid = (xcd < r ? xcd * (q + 1) : r * (q + 1) + (xcd - r) * q) + off; }
        const int nig = WGM * nN, gid = wgid / nig, fm = gid * WGM, gsz = (nM - fm) < WGM ? (nM - fm) : WGM;
        u.pm = fm + ((wgid % nig) % gsz); u.pn = (wgid % nig) / gsz; return true;
    }
    __device__ __forceinline__ void a_ready(const Unit&) const {}
    __device__ __forceinline__ void done(const Unit&) const {}
};
__device__ __forceinline__ unsigned cvt_pk_bf16(float lo, float hi) { unsigned r; asm volatile("v_cvt_pk_bf16_f32 %0, %1, %2" : "=v"(r) : "v"(lo), "v"(hi)); return r; }
__device__ __forceinline__ float sigm(float x) { return 1.0f / (1.0f + __expf(-x)); }
struct EpiBf16 {
    static constexpr bool PERM = true, AFTER_DRAIN = false;
    bf16_t* O; int ldc;
    __device__ __forceinline__ void operator()(const f32x4 (&acc)[2][2][4][2], const Unit& u, int wr, int wc, int fr, int fq) const {
        const int row0 = u.pm * BM + wr * 64 + fr, col0 = u.pn * BM + wc * 32 + 8 * fq;
#pragma unroll
        for (int ai = 0; ai < 2; ++ai)
#pragma unroll
            for (int m = 0; m < 4; ++m) { bf16_t* rowp = O + (size_t)(row0 + ai * HALF + m * 16) * ldc + col0;
#pragma unroll
                for (int bj = 0; bj < 2; ++bj) { const f32x4 v0 = acc[ai][bj][m][0], v1 = acc[ai][bj][m][1];
                    u32x4 w; w.x = cvt_pk_bf16(v0[0], v0[1]); w.y = cvt_pk_bf16(v0[2], v0[3]); w.z = cvt_pk_bf16(v1[0], v1[1]); w.w = cvt_pk_bf16(v1[2], v1[3]);
                    *(u32x4*)(rowp + bj * HALF) = w; } }
    }
};
struct EpiMemKV {
    static constexpr bool PERM = false, AFTER_DRAIN = false;
    float* Kout; float* Vout;
    __device__ __forceinline__ void operator()(const f32x4 (&acc)[2][2][4][2], const Unit& u, int wr, int wc, int fr, int fq) const {
        const int row0 = u.pm * BM + wr * 64 + fr; int colt = u.pn * BM; float* base = colt < 512 ? Kout : Vout; colt &= 511;
        const int col0 = colt + wc * 32 + 4 * fq;
#pragma unroll
        for (int ai = 0; ai < 2; ++ai)
#pragma unroll
            for (int m = 0; m < 4; ++m) { float* rowp = base + (size_t)(row0 + ai * HALF + m * 16) * 512 + col0;
#pragma unroll
                for (int bj = 0; bj < 2; ++bj)
#pragma unroll
                    for (int n = 0; n < 2; ++n) *(f32x4*)(rowp + bj * HALF + n * 16) = acc[ai][bj][m][n]; }
    }
};
struct EpiLru {
    static constexpr bool PERM = false, AFTER_DRAIN = false;
    const float* ba; const float* bi; const float* lam; const bf16_t* XAC; float* LA; float* LB;
    __device__ __forceinline__ void operator()(const f32x4 (&acc)[2][2][4][2], const Unit& u, int wr, int wc, int fr, int fq) const {
        const int row0 = u.pm * BM + wr * 64 + fr, ch0 = u.pn * HALF + wc * 32 + 4 * fq;
        f32x4 bav[2], biv[2], spv[2];
#pragma unroll
        for (int n = 0; n < 2; ++n) { bav[n] = *(const f32x4*)(ba + ch0 + 16 * n); biv[n] = *(const f32x4*)(bi + ch0 + 16 * n);
            const f32x4 lv = *(const f32x4*)(lam + ch0 + 16 * n);
#pragma unroll
            for (int j = 0; j < 4; ++j) { const float z = -lv[j]; spv[n][j] = (z > 20.f) ? z : log1pf(__expf(z)); } }
#pragma unroll
        for (int ai = 0; ai < 2; ++ai)
#pragma unroll
            for (int m = 0; m < 4; ++m) { const size_t off = (size_t)(row0 + ai * HALF + m * 16) * 512 + ch0;
#pragma unroll
                for (int n = 0; n < 2; ++n) {
                    const f32x4 r = acc[ai][0][m][n] + bav[n], g = acc[ai][1][m][n] + biv[n];
                    const unsigned long long xw = *(const unsigned long long*)(XAC + off + 16 * n);
                    float xv[4]; xv[0] = __uint_as_float((unsigned)(xw & 0xffffu) << 16); xv[1] = __uint_as_float((unsigned)xw & 0xffff0000u);
                    xv[2] = __uint_as_float((unsigned)((xw >> 32) & 0xffffu) << 16); xv[3] = __uint_as_float((unsigned)(xw >> 32) & 0xffff0000u);
                    f32x4 av, bv;
#pragma unroll
                    for (int j = 0; j < 4; ++j) { const float la = -8.0f * sigm(r[j]) * spv[n][j]; av[j] = __expf(la); bv[j] = sqrtf(-expm1f(2.0f * la)) * (sigm(g[j]) * xv[j]); }
                    *(f32x4*)(LA + off + 16 * n) = av; *(f32x4*)(LB + off + 16 * n) = bv; } }
    }
};
struct EpiGate {
    static constexpr bool PERM = true, AFTER_DRAIN = false;
    const float* bias; const bf16_t* T; bf16_t* P;
    __device__ __forceinline__ void operator()(const f32x4 (&acc)[2][2][4][2], const Unit& u, int wr, int wc, int fr, int fq) const {
        const int row0 = u.pm * BM + wr * 64 + fr, col0 = u.pn * BM + wc * 32 + 8 * fq;
        f32x4 bv[2][2];
#pragma unroll
        for (int bj = 0; bj < 2; ++bj)
#pragma unroll
            for (int n = 0; n < 2; ++n) bv[bj][n] = *(const f32x4*)(bias + col0 + bj * HALF + 4 * n);
#pragma unroll
        for (int ai = 0; ai < 2; ++ai)
#pragma unroll
            for (int m = 0; m < 4; ++m) { const size_t off = (size_t)(row0 + ai * HALF + m * 16) * 5120 + col0;
#pragma unroll
                for (int bj = 0; bj < 2; ++bj) { const u32x4 t = *(const u32x4*)(T + off + bj * HALF);
                    const f32x4 v0 = acc[ai][bj][m][0] + bv[bj][0], v1 = acc[ai][bj][m][1] + bv[bj][1];
                    u32x4 w;
                    w.x = cvt_pk_bf16(sigm(v0[0]) * __uint_as_float(t.x << 16), sigm(v0[1]) * __uint_as_float(t.x & 0xffff0000u));
                    w.y = cvt_pk_bf16(sigm(v0[2]) * __uint_as_float(t.y << 16), sigm(v0[3]) * __uint_as_float(t.y & 0xffff0000u));
                    w.z = cvt_pk_bf16(sigm(v1[0]) * __uint_as_float(t.z << 16), sigm(v1[1]) * __uint_as_float(t.z & 0xffff0000u));
                    w.w = cvt_pk_bf16(sigm(v1[2]) * __uint_as_float(t.w << 16), sigm(v1[3]) * __uint_as_float(t.w & 0xffff0000u));
                    *(u32x4*)(P + off + bj * HALF) = w; }
                asm volatile("" ::: "memory"); }
    }
};
struct EpiRes {
    static constexpr bool PERM = false, AFTER_DRAIN = false;
    const float* X; float* Z; int nvalid; float alpha;
    __device__ __forceinline__ void operator()(const f32x4 (&acc)[2][2][4][2], const Unit& u, int wr, int wc, int fr, int fq) const {
        const int row0 = u.pm * BM + wr * 64 + fr, col0 = u.pn * BM + wc * 32 + 4 * fq;
#pragma unroll
        for (int ai = 0; ai < 2; ++ai)
#pragma unroll
            for (int m = 0; m < 4; ++m) { const int row = row0 + ai * HALF + m * 16; const size_t off = (size_t)row * 1024 + col0; const bool rv = row < nvalid;
#pragma unroll
                for (int bj = 0; bj < 2; ++bj)
#pragma unroll
                    for (int n = 0; n < 2; ++n) { f32x4 x = (f32x4){0.f, 0.f, 0.f, 0.f}; if (rv) x = *(const f32x4*)(X + off + bj * HALF + n * 16);
                        *(f32x4*)(Z + off + bj * HALF + n * 16) = x * alpha + acc[ai][bj][m][n]; }
                asm volatile("" ::: "memory"); }
    }
};
struct EpiSwiglu {
    static constexpr bool PERM = true, AFTER_DRAIN = false;
    bf16_t* H;
    __device__ __forceinline__ void operator()(const f32x4 (&acc)[2][2][4][2], const Unit& u, int wr, int wc, int fr, int fq) const {
        const int row0 = u.pm * BM + wr * 64 + fr, col0 = u.pn * HALF + wc * 32 + 8 * fq;
#pragma unroll
        for (int ai = 0; ai < 2; ++ai)
#pragma unroll
            for (int m = 0; m < 4; ++m) { bf16_t* rowp = H + (size_t)(row0 + ai * HALF + m * 16) * 2816 + col0;
                const f32x4 g0 = acc[ai][0][m][0], g1 = acc[ai][0][m][1], v0 = acc[ai][1][m][0], v1 = acc[ai][1][m][1];
                u32x4 w;
                w.x = cvt_pk_bf16(g0[0] * sigm(g0[0]) * v0[0], g0[1] * sigm(g0[1]) * v0[1]);
                w.y = cvt_pk_bf16(g0[2] * sigm(g0[2]) * v0[2], g0[3] * sigm(g0[3]) * v0[3]);
                w.z = cvt_pk_bf16(g1[0] * sigm(g1[0]) * v1[0], g1[1] * sigm(g1[1]) * v1[1]);
                w.w = cvt_pk_bf16(g1[2] * sigm(g1[2]) * v1[2], g1[3] * sigm(g1[3]) * v1[3]);
                *(u32x4*)rowp = w; }
    }
};

template <class Epi, class Sched, bool ALIGN_EPI = false, bool SP2 = false>
__device__ __forceinline__ void gemm_phase(PG8_LAS unsigned char* lds, const Gemm g, const Sched& S, const Epi& E) {
    int tid_ = threadIdx.x; asm volatile("" : "+v"(tid_));
    const int tid = tid_, wid = __builtin_amdgcn_readfirstlane(tid >> 6), lane = tid & 63, wr = wid >> 2, wc = wid & 3, fr = lane & 15, fq = lane >> 4;
    const int K = g.K, nt = K / BK;
    unsigned voffA[2], voffB[2];
#pragma unroll
    for (int i = 0; i < 2; ++i) { int R, C; stage_rc(tid * 16 + i * 8192, R, C); const int Rb = Epi::PERM ? ((R & ~31) + perm32(R & 31)) : R;
        voffA[i] = (unsigned)(R * K + C) * 2u; voffB[i] = (unsigned)(Rb * K + C) * 2u; }
    const size_t kstep = (size_t)(BK * 2);
    const size_t hstep = (size_t)HALF * K * 2;
    const size_t tstep = 2 * hstep;
    const unsigned ldsw = (unsigned)wid * 1024u;
    const int aoff = lds_byte(wr * 64 + fr, fq * 8), boff = lds_byte(wc * 32 + fr, fq * 8);
#define PG8_SA(b, h) (((b) * 2 + (h)) * HTB)
#define PG8_SB(b, h) ((4 + (b) * 2 + (h)) * HTB)
#define PG8_STAGE(bufoff, gbase, voff) do { _Pragma("unroll") for (int _i = 0; _i < 2; ++_i) \
        __builtin_amdgcn_global_load_lds((const unsigned*)((const char*)(gbase) + (voff)[_i]), (PG8_LAS unsigned*)(lds + (bufoff) + ldsw + _i * 8192), 16, 0, 0); } while (0)
#define PG8_LDA(dst, b, h) do { _Pragma("unroll") for (int m = 0; m < 4; ++m) _Pragma("unroll") for (int k = 0; k < 2; ++k) dst[m][k] = *(const PG8_LAS bf16x8*)(lds + PG8_SA(b, h) + aoff + m * 2048 + k * 1024); } while (0)
#define PG8_LDB(dst, b, h) do { _Pragma("unroll") for (int n = 0; n < 2; ++n) _Pragma("unroll") for (int k = 0; k < 2; ++k) dst[n][k] = *(const PG8_LAS bf16x8*)(lds + PG8_SB(b, h) + boff + n * 2048 + k * 1024); } while (0)
#define PG8_MMA(ai, bj, At, Bt) do { __builtin_amdgcn_s_setprio(1); _Pragma("unroll") for (int m = 0; m < 4; ++m) _Pragma("unroll") for (int n = 0; n < 2; ++n) _Pragma("unroll") for (int k = 0; k < 2; ++k) \
        acc[ai][bj][m][n] = __builtin_amdgcn_mfma_f32_16x16x32_bf16(Bt[n][k], At[m][k], acc[ai][bj][m][n], 0, 0, 0); __builtin_amdgcn_s_setprio(0); } while (0)
#define PG8_WAIT_V(n) asm volatile("s_waitcnt vmcnt(" #n ")" ::: "memory")
#define PG8_WAIT_L(n) asm volatile("s_waitcnt lgkmcnt(" #n ")" ::: "memory")
#define PG8_BAR __builtin_amdgcn_s_barrier()
#define PG8_SCHED __builtin_amdgcn_sched_barrier(0)
    Unit cur, nxt; int ui = 0;
    if (!S.next(0, cur)) return;
    f32x4 acc[2][2][4][2];
#pragma unroll
    for (int a = 0; a < 2; ++a)
#pragma unroll
        for (int b = 0; b < 2; ++b)
#pragma unroll
            for (int m = 0; m < 4; ++m)
#pragma unroll
                for (int n = 0; n < 2; ++n) acc[a][b][m][n] = (f32x4){0.f, 0.f, 0.f, 0.f};
    bf16x8 At[4][2], B0[2][2], B1[2][2];
    const char* cA = (const char*)g.A + (size_t)cur.pm * tstep; const char* cB = (const char*)g.Bt + (size_t)cur.pn * tstep;
    S.a_ready(cur);
    if constexpr (SP2) {
        PG8_STAGE(PG8_SB(0, 0), cB, voffB); PG8_STAGE(PG8_SB(0, 1), cB + hstep, voffB); PG8_STAGE(PG8_SA(0, 0), cA, voffA); PG8_STAGE(PG8_SA(0, 1), cA + hstep, voffA);
        if (wr == 1) PG8_BAR;
        PG8_WAIT_V(2); PG8_BAR;
        PG8_STAGE(PG8_SB(1, 0), cB + kstep, voffB); PG8_STAGE(PG8_SA(1, 0), cA + kstep, voffA); PG8_STAGE(PG8_SB(1, 1), cB + hstep + kstep, voffB);
        PG8_WAIT_V(6); PG8_BAR;
    } else {
        PG8_STAGE(PG8_SB(0, 0), cB, voffB); PG8_STAGE(PG8_SA(0, 0), cA, voffA); PG8_STAGE(PG8_SB(0, 1), cB + hstep, voffB); PG8_STAGE(PG8_SA(0, 1), cA + hstep, voffA);
        if (wr == 1) PG8_BAR;
        PG8_WAIT_V(4); PG8_BAR;
        PG8_STAGE(PG8_SB(1, 0), cB + kstep, voffB); PG8_STAGE(PG8_SA(1, 0), cA + kstep, voffA); PG8_STAGE(PG8_SB(1, 1), cB + hstep + kstep, voffB);
        PG8_WAIT_V(6); PG8_BAR;
    }
    for (;;) {
        const bool has_next = S.next(ui + 1, nxt);
        const char* nA = has_next ? (const char*)g.A + (size_t)nxt.pm * tstep : cA; const char* nB = has_next ? (const char*)g.Bt + (size_t)nxt.pn * tstep : cB;
        for (int t = 0; t < nt; t += 2) {
            const bool last = (t == nt - 2);
            const char* a1 = cA + (size_t)(t + 1) * kstep;
            const char* a2 = last ? nA : cA + (size_t)(t + 2) * kstep; const char* b2 = last ? nB : cB + (size_t)(t + 2) * kstep;
            const char* a3 = a2 + kstep; const char* b3 = b2 + kstep;
            if (last && has_next) S.a_ready(nxt);
            if constexpr (SP2) {
            PG8_LDB(B0, 0, 0); PG8_LDB(B1, 0, 1); PG8_SCHED; PG8_LDA(At, 0, 0); PG8_STAGE(PG8_SA(1, 1), a1 + hstep, voffA);
            PG8_WAIT_V(8); PG8_WAIT_L(0); PG8_BAR; PG8_MMA(0, 0, At, B0); PG8_MMA(0, 1, At, B1); PG8_BAR; PG8_SCHED;
            PG8_LDA(At, 0, 1); PG8_STAGE(PG8_SB(0, 0), b2, voffB); PG8_STAGE(PG8_SB(0, 1), b2 + hstep, voffB); PG8_STAGE(PG8_SA(0, 0), a2, voffA);
            PG8_WAIT_V(8); PG8_WAIT_L(0); PG8_BAR; PG8_MMA(1, 0, At, B0); PG8_MMA(1, 1, At, B1); PG8_BAR; PG8_SCHED;
            PG8_LDB(B0, 1, 0); PG8_LDB(B1, 1, 1); PG8_SCHED; PG8_LDA(At, 1, 0); PG8_STAGE(PG8_SA(0, 1), a2 + hstep, voffA);
            PG8_WAIT_V(8); PG8_WAIT_L(0); PG8_BAR; PG8_MMA(0, 0, At, B0); PG8_MMA(0, 1, At, B1); PG8_BAR; PG8_SCHED;
            PG8_LDA(At, 1, 1); PG8_STAGE(PG8_SB(1, 0), b3, voffB); PG8_STAGE(PG8_SB(1, 1), b3 + hstep, voffB); PG8_STAGE(PG8_SA(1, 0), a3, voffA);
            PG8_WAIT_V(8); PG8_WAIT_L(0); PG8_BAR; PG8_MMA(1, 0, At, B0); PG8_MMA(1, 1, At, B1); PG8_BAR; PG8_SCHED;
            } else {
            PG8_LDB(B0, 0, 0); PG8_SCHED; PG8_LDA(At, 0, 0); PG8_STAGE(PG8_SA(1, 1), a1 + hstep, voffA);
            PG8_WAIT_L(8); PG8_BAR; PG8_WAIT_L(0); PG8_MMA(0, 0, At, B0); PG8_BAR; PG8_SCHED;
            PG8_LDB(B1, 0, 1); PG8_STAGE(PG8_SB(0, 0), b2, voffB);
            PG8_BAR; PG8_WAIT_L(0); PG8_MMA(0, 1, At, B1); PG8_BAR;
            PG8_LDA(At, 0, 1); PG8_STAGE(PG8_SA(0, 0), a2, voffA);
            PG8_BAR; PG8_WAIT_L(0); PG8_MMA(1, 0, At, B0); PG8_BAR; PG8_SCHED;
            PG8_STAGE(PG8_SB(0, 1), b2 + hstep, voffB);
            PG8_WAIT_V(6); PG8_BAR; PG8_MMA(1, 1, At, B1); PG8_BAR;
            PG8_LDB(B0, 1, 0); PG8_SCHED; PG8_LDA(At, 1, 0); PG8_STAGE(PG8_SA(0, 1), a2 + hstep, voffA);
            PG8_WAIT_L(8); PG8_BAR; PG8_WAIT_L(0); PG8_MMA(0, 0, At, B0); PG8_BAR; PG8_SCHED;
            PG8_LDB(B1, 1, 1); PG8_STAGE(PG8_SB(1, 0), b3, voffB);
            PG8_BAR; PG8_WAIT_L(0); PG8_MMA(0, 1, At, B1); PG8_BAR;
            PG8_LDA(At, 1, 1); PG8_STAGE(PG8_SA(1, 0), a3, voffA);
            PG8_BAR; PG8_WAIT_L(0); PG8_MMA(1, 0, At, B0); PG8_BAR; PG8_SCHED;
            PG8_STAGE(PG8_SB(1, 1), b3 + hstep, voffB);
            PG8_WAIT_V(6); PG8_BAR; PG8_MMA(1, 1, At, B1); PG8_BAR;
            }
        }
        if constexpr (ALIGN_EPI) { if (wr == 0) PG8_BAR; }
        if constexpr (!Epi::AFTER_DRAIN) { E(acc, cur, wr, wc, fr, fq); S.done(cur); }
        if (!has_next) break;
#pragma unroll
        for (int a = 0; a < 2; ++a)
#pragma unroll
            for (int b = 0; b < 2; ++b)
#pragma unroll
                for (int m = 0; m < 4; ++m)
#pragma unroll
                    for (int n = 0; n < 2; ++n) acc[a][b][m][n] = (f32x4){0.f, 0.f, 0.f, 0.f};
        cur = nxt; cA = nA; cB = nB; ++ui;
        if constexpr (ALIGN_EPI) { if (wr == 1) PG8_BAR; }
    }
    PG8_WAIT_V(0);
    if constexpr (!ALIGN_EPI) { if (wr == 0) PG8_BAR; }
    PG8_BAR;
    if constexpr (Epi::AFTER_DRAIN) { E.fused(acc, cur, wr, wc, fr, fq, lds, wid, lane); S.done(cur); }
#undef PG8_SA
#undef PG8_SB
#undef PG8_STAGE
#undef PG8_LDA
#undef PG8_LDB
#undef PG8_MMA
#undef PG8_WAIT_V
#undef PG8_WAIT_L
#undef PG8_BAR
#undef PG8_SCHED
}
}
#define GAS __attribute__((address_space(1)))
#define LAS __attribute__((address_space(3)))
typedef unsigned short bf16;
typedef unsigned v4u __attribute__((ext_vector_type(4)));
typedef float f32x4 __attribute__((ext_vector_type(4)));
typedef short bf16x8 __attribute__((ext_vector_type(8)));
typedef GAS unsigned gu32;
typedef GAS unsigned long long gu64;
#define RLX_AGENT __ATOMIC_RELAXED, __HIP_MEMORY_SCOPE_AGENT
#define LDS_WAIT() asm volatile("s_waitcnt lgkmcnt(0)" ::: "memory")
#define VM_WAIT() asm volatile("s_waitcnt vmcnt(0)" ::: "memory")
__device__ __forceinline__ unsigned long long rt() { return __builtin_amdgcn_s_memrealtime(); }
__device__ __forceinline__ unsigned f2bf(float f) { unsigned u = __builtin_bit_cast(unsigned, f); return (u + 0x7fffu + ((u >> 16) & 1u)) >> 16; }
__device__ __forceinline__ unsigned pk2(float lo, float hi) { return f2bf(lo) | (f2bf(hi) << 16); }
#define XB_TMO      128
#define XB_XCNT(j)  (256  + 64 * (j))
#define XB_XSUB(j)  (1280 + 64 * (j))
#define XB_XGEN(j)  (2304 + 64 * (j))
#define XB_TOP      3328
#define XB_TOPGEN   3392
#define XCD_BAR_WORDS 3456
#define XB_SPIN_CAP (1u << 18)

__device__ __forceinline__ unsigned xb_ld(unsigned* p)              { return __hip_atomic_load(p, __ATOMIC_RELAXED, __HIP_MEMORY_SCOPE_AGENT); }
__device__ __forceinline__ unsigned xb_add(unsigned* p, unsigned v) { return __hip_atomic_fetch_add(p, v, __ATOMIC_RELAXED, __HIP_MEMORY_SCOPE_AGENT); }
__device__ __forceinline__ unsigned xb_xcc_id() { return (unsigned)__builtin_amdgcn_s_getreg((3 << 11) | 20) & 0xFu; }
#define XB_SPIN(cond, bar) do { unsigned _sp = 0; while (cond) { __builtin_amdgcn_s_sleep(1); \
    if ((++_sp & 255u) == 0u) { if (xb_ld(&(bar)[XB_TMO])) break; if (_sp > XB_SPIN_CAP) { atomicAdd(&(bar)[XB_TMO], 1u); break; } } } } while (0)

struct XcdBarrier {
    unsigned* bar; unsigned x;
    volatile LAS unsigned* st;
};

__device__ __forceinline__ XcdBarrier xcd_barrier_post(unsigned* bar, volatile LAS unsigned* st) {
    XcdBarrier b; b.bar = bar; b.x = xb_xcc_id(); b.st = st;
    if (threadIdx.x == 0) (void)xb_add(&bar[XB_XCNT(b.x)], 1u);
    return b;
}
__device__ __forceinline__ void xcd_barrier_complete(unsigned* bar, unsigned x, unsigned& nloc, unsigned& nx) {
    const unsigned G = gridDim.x * gridDim.y * gridDim.z;
    unsigned sum, cnt, mine, sp = 0u;
    for (;;) {
        sum = 0u; cnt = 0u; mine = 0u;
#pragma unroll
        for (unsigned j = 0; j < 16; ++j) { const unsigned c = xb_ld(&bar[XB_XCNT(j)]); sum += c; cnt += (c > 0u) ? 1u : 0u; mine = (j == x) ? c : mine; }
        if (sum == G) break;
        __builtin_amdgcn_s_sleep(1);
        if ((++sp & 255u) == 0u) { if (xb_ld(&bar[XB_TMO])) break; if (sp > XB_SPIN_CAP) { atomicAdd(&bar[XB_TMO], 1u); break; } }
    }
    nloc = mine > 0u ? mine : 1u; nx = cnt > 0u ? cnt : 1u;
}

__device__ __forceinline__ void xcd_barrier(const XcdBarrier& b) {
    asm volatile("s_waitcnt vmcnt(0)" ::: "memory");
    __syncthreads();
    if (threadIdx.x == 0) {
        unsigned* bar = b.bar;
        __builtin_amdgcn_s_waitcnt(0);
        unsigned nloc = b.st[0], nx = b.st[1];
        if (nloc == 0u) { xcd_barrier_complete(bar, b.x, nloc, nx); b.st[0] = nloc; b.st[1] = nx; }
        const unsigned old = xb_add(&bar[XB_XSUB(b.x)], 1u);
        const unsigned gen = old / nloc;
        if (old + 1u == (gen + 1u) * nloc) {
            __builtin_amdgcn_fence(__ATOMIC_RELEASE, "agent");
            asm volatile("s_waitcnt vmcnt(0)" ::: "memory");
            const unsigned og = xb_add(&bar[XB_TOP], 1u);
            const unsigned tg = og / nx;
            if (og + 1u == (tg + 1u) * nx) xb_add(&bar[XB_TOPGEN], 1u);
            else XB_SPIN(xb_ld(&bar[XB_TOPGEN]) == tg, bar);
            __builtin_amdgcn_fence(__ATOMIC_ACQUIRE, "agent");
            xb_add(&bar[XB_XGEN(b.x)], 1u);
            asm volatile("s_waitcnt vmcnt(0)" ::: "memory");
        } else {
            XB_SPIN(xb_ld(&bar[XB_XGEN(b.x)]) == gen, bar);
            __builtin_amdgcn_fence(__ATOMIC_ACQUIRE, "agent");
            asm volatile("s_waitcnt vmcnt(0)" ::: "memory");
        }
    }
    __syncthreads();
}
constexpr int NWAVES = 8, NTHR = 512;
constexpr int DM = 1024, BATCH = 8, SEQ = 2048, DEPTH = 2, DECB = 128, WBR = 512, NH = 4, HD = 128, NMEM = 256, DFF = 2816;
constexpr int MPR = BATCH * SEQ;
constexpr int MROWS = MPR + DECB;
constexpr int MP = 16640;
constexpr int NIN = 7176, NU = 7168;
constexpr float LN_EPS = 1e-5f, NORM_EPS = 1e-6f, ALPHA = 1.41421356237309515f;
constexpr int U_XA = 0, U_GQ = 512, U_GK = 1024, U_GV = 1536, U_GZ = 2048, U_HQ = 2560, U_HF = 3072, U_HI = 3584, U_HG = 4096, U_RQ = 4608, U_RK = 5120, U_RV = 5632, U_RG = 6144, U_XQ = 6656;
enum { I_XP = 0, I_XS, I_MEM, I_SLRUH, I_SLRUC, I_SGDNC, I_SGDNS, I_SHGRNS, I_SRETS, I_CK, I_CV, I_WIN, I_LCW, I_LCB, I_LWA, I_LBA, I_LWI, I_LBI, I_LLAM,
       I_GCW, I_GALOG, I_GDT, I_GNW, I_HLB, I_HNW, I_RGW, I_RGB, I_WMK, I_WMV, I_WMG, I_BMG, I_WBR, I_WOUT, I_LN1G, I_LN1B, I_WUP, I_WDN, I_LN2G, I_LN2B, N_INPUTS };
constexpr size_t O_YP = 0, O_YS = O_YP + (size_t)MPR * DM, O_PLH = O_YS + (size_t)DECB * DM, O_PLC = O_PLH + 2 * 8 * 512, O_PGC = O_PLC + 2 * 8 * 3 * 512,
    O_PGS = O_PGC + 2 * 8 * 3 * 1536, O_PHS = O_PGS + 2 * 8 * 4 * 16384, O_PRS = O_PHS + 2 * 8 * 4 * 16384, O_PMK = O_PRS + 2 * 8 * 4 * 16384, O_PMV = O_PMK + (size_t)2 * 8 * 256 * 512,
    O_SLH = O_PMV + (size_t)2 * 8 * 256 * 512, O_SLC = O_SLH + 2 * 128 * 512, O_SGC = O_SLC + 2 * 128 * 3 * 512, O_SGS = O_SGC + (size_t)2 * 128 * 3 * 1536,
    O_SHS = O_SGS + (size_t)2 * 128 * 4 * 16384, O_SRS = O_SHS + (size_t)2 * 128 * 4 * 16384, O_END = O_SRS + (size_t)2 * 128 * 4 * 16384;
constexpr size_t WS_CTL = 0, CTL_ZERO_BYTES = 1u << 20;
constexpr size_t SZ_WIN = (size_t)NU * DM * 2, SZ_WKV = (size_t)1024 * DM * 2, SZ_WLRU = (size_t)1024 * 512 * 2, SZ_WG = (size_t)5120 * DM * 2, SZ_WB = (size_t)5 * 1024 * 512 * 2,
    SZ_WO5 = (size_t)1024 * 5120 * 2, SZ_WUP = (size_t)5632 * DM * 2, SZ_WDN = (size_t)1024 * DFF * 2;
constexpr size_t WL_WIN = 0, WL_WKV = WL_WIN + SZ_WIN, WL_WLRU = WL_WKV + SZ_WKV, WL_WG = WL_WLRU + SZ_WLRU, WL_WB = WL_WG + SZ_WG, WL_WO5 = WL_WB + SZ_WB, WL_WUP = WL_WO5 + SZ_WO5,
    WL_WDN = WL_WUP + SZ_WUP, WL_SIZE = WL_WDN + SZ_WDN;
constexpr size_t WS_W = CTL_ZERO_BYTES;
constexpr size_t WS_WBA = WS_W + 2 * WL_SIZE;
constexpr size_t WS_LBV = WS_WBA + 2 * 8 * 1024 * 4;
constexpr size_t WS_ROPE = WS_LBV + 2 * 512 * 4;
constexpr size_t WS_XB = WS_ROPE + (size_t)2 * 2049 * 64 * 4 + 512;
constexpr size_t WS_MB = WS_XB + (size_t)MP * DM * 2;
constexpr size_t WS_KB = WS_MB + (size_t)2048 * DM * 2;
constexpr size_t WS_VT = WS_KB + (size_t)8 * 4 * 256 * 128 * 2;
constexpr size_t WS_BETA = WS_VT + (size_t)8 * 4 * 256 * 128 * 2;
constexpr size_t WS_EG = WS_BETA + (size_t)MP * 4 * 4;
constexpr size_t WS_U = WS_EG + (size_t)MP * 4 * 4;
constexpr size_t WS_R2 = WS_U + (size_t)MP * NU * 2;
constexpr size_t SZ_B512 = (size_t)MP * 512 * 2, SZ_F512 = (size_t)MP * 512 * 4;
constexpr size_t WS_XAC = WS_R2, WS_GQ = WS_XAC + SZ_B512, WS_GK = WS_GQ + SZ_B512, WS_GV = WS_GK + SZ_B512, WS_OG = WS_GV + SZ_B512, WS_OH = WS_OG + SZ_F512, WS_OR = WS_OH + SZ_F512;
static_assert(WS_OR + SZ_F512 == WS_R2 + (size_t)MP * 5120 * 2, "R2 map");
constexpr size_t WS_Z = WS_R2 + (size_t)MP * 5120 * 2;
constexpr size_t WS_LA = WS_Z, WS_LB = WS_Z + SZ_F512;
constexpr size_t WS_Y = WS_Z + (size_t)MP * DM * 4;
constexpr size_t WS_END = WS_Y + (size_t)5 * SZ_B512;
static_assert(WS_XB % 256 == 0 && WS_U % 256 == 0 && WS_R2 % 256 == 0 && WS_Z % 256 == 0 && WS_Y % 256 == 0, "alignment");
constexpr int CW_TMO = 0, CW_CODE = 1, CW_BAR = 4096, CW_QUEUE = 16384;
constexpr int SCR_BYTES = 143360;
constexpr int LDSCTL_OFF = SCR_BYTES, MISC_OFF = LDSCTL_OFF + 320, LDS_BYTES = 147456;
#ifndef PHMASK
#define PHMASK 0xFFFFFFFFu
#endif
#define EN(k) (((PHMASK) >> (k)) & 1u)
__device__ __forceinline__ float bflo(unsigned w) { return __uint_as_float(w << 16); }
__device__ __forceinline__ float bfhi(unsigned w) { return __uint_as_float(w & 0xffff0000u); }
__device__ __forceinline__ float sigm(float x) { return 1.0f / (1.0f + __expf(-x)); }
__device__ __forceinline__ float siluf(float x) { return x * sigm(x); }
__device__ __forceinline__ float softplusf(float x) { return (x > 20.f) ? x : log1pf(__expf(x)); }
__device__ __forceinline__ void unpack8(const v4u w, float (&o)[8]) { o[0] = bflo(w.x); o[1] = bfhi(w.x); o[2] = bflo(w.y); o[3] = bfhi(w.y); o[4] = bflo(w.z); o[5] = bfhi(w.z); o[6] = bflo(w.w); o[7] = bfhi(w.w); }
__device__ __forceinline__ v4u pack8(const float (&o)[8]) { v4u w; w.x = pk2(o[0], o[1]); w.y = pk2(o[2], o[3]); w.z = pk2(o[4], o[5]); w.w = pk2(o[6], o[7]); return w; }
__device__ __forceinline__ void ld8bf(const bf16* p, float (&o)[8]) { const v4u w = *(const v4u*)p; unpack8(w, o); }
__device__ __forceinline__ void ld8f(const float* p, float (&o)[8]) { const f32x4 a = *(const f32x4*)p, b = *(const f32x4*)(p + 4); o[0] = a.x; o[1] = a.y; o[2] = a.z; o[3] = a.w; o[4] = b.x; o[5] = b.y; o[6] = b.z; o[7] = b.w; }
__device__ __forceinline__ void st8f(float* p, const float (&o)[8]) { *(f32x4*)p = (f32x4){o[0], o[1], o[2], o[3]}; *(f32x4*)(p + 4) = (f32x4){o[4], o[5], o[6], o[7]}; }
template <int CTRL> __device__ __forceinline__ float dppf(float x) { return __builtin_bit_cast(float, __builtin_amdgcn_update_dpp(0, __builtin_bit_cast(int, x), CTRL, 0xf, 0xf, true)); }
__device__ __forceinline__ float row16_sum(float x) {
    x += dppf<0xB1>(x);
    x += dppf<0x4E>(x);
    x += dppf<0x141>(x);
    x += dppf<0x140>(x);
    return x;
}
__device__ __forceinline__ float wave_sum(float v) {
#pragma unroll
    for (int o = 1; o < 64; o <<= 1) v += __shfl_xor(v, o);
    return v;
}

typedef const float* cfp_t; typedef __attribute__((address_space(4))) const cfp_t* kin_t;
struct Frame {
    LAS unsigned char* lds;
    volatile LAS unsigned* MISC;
    gu32* ctl;
    int tid, lane, wave, vcu, G;
    kin_t in;
    float* out; unsigned char* ws;
};
#define WSP(T, off) ((T*)(F.ws + (off)))
#define INP(i) (F.in[i])

__device__ __forceinline__ void transpose_block(const float* src, int ld, bf16* dst, int ldt, LAS float* scr, int lane) {
#pragma unroll 8
    for (int i = 0; i < 32; ++i) { const int kk = 2 * i + (lane >> 5); scr[kk * 33 + (lane & 31)] = src[(size_t)kk * ld + (lane & 31)]; }
    LDS_WAIT(); asm volatile("" ::: "memory");
    const int c = lane & 7;
#pragma unroll
    for (int j = 0; j < 4; ++j) { const int n = (lane >> 3) + 8 * j; const LAS float* s = scr + (8 * c) * 33 + n;
        v4u o; o.x = pk2(s[0 * 33], s[1 * 33]); o.y = pk2(s[2 * 33], s[3 * 33]); o.z = pk2(s[4 * 33], s[5 * 33]); o.w = pk2(s[6 * 33], s[7 * 33]);
        *(GAS v4u*)(dst + (size_t)n * ldt + 8 * c) = o; }
    LDS_WAIT(); asm volatile("" ::: "memory");
}

__device__ __forceinline__ void p0_prologue(Frame& F) {
    LAS float* scr = (LAS float*)(F.lds + F.wave * 16384);
    const int gw = F.vcu * NWAVES + F.wave, NGW = F.G * NWAVES, lane = F.lane;
    constexpr int IT_IN = 16 * 224, IT_KV = 16 * 32, IT_G = 5 * 16 * 32, IT_B = 5 * 8 * 32, IT_O = 5 * 16 * 32, IT_UP = 16 * 176, IT_DN = 44 * 32, IT_LRU = 2 * 4 * 2 * 4;
    constexpr int IT_L = IT_IN + IT_KV + IT_G + IT_B + IT_O + IT_UP + IT_DN + IT_LRU;
#pragma clang loop unroll(disable)
    for (int it = gw; it < 2 * IT_L; it += NGW) {
        const int l = it / IT_L; int r = it % IT_L;
        unsigned char* wl = F.ws + WS_W + (size_t)l * WL_SIZE;
        if (r < IT_IN) { const int kb = r / 224, nb = r % 224, n0 = nb * 32, sc = n0 < 2560 ? n0 : n0 + 8;
            transpose_block(INP(I_WIN) + (size_t)l * DM * NIN + (size_t)(kb * 64) * NIN + sc, NIN, (bf16*)(wl + WL_WIN) + (size_t)n0 * DM + kb * 64, DM, scr, lane); continue; } r -= IT_IN;
        if (r < IT_KV) { const int kb = r / 32, nb = r % 32, n0 = nb * 32; const float* W = (n0 < 512 ? INP(I_WMK) : INP(I_WMV)) + (size_t)l * DM * 512;
            transpose_block(W + (size_t)(kb * 64) * 512 + (n0 & 511), 512, (bf16*)(wl + WL_WKV) + (size_t)n0 * DM + kb * 64, DM, scr, lane); continue; } r -= IT_KV;
        if (r < IT_G) { const int n = r / 512, q = r % 512, kb = q / 32, nb = q % 32;
            transpose_block(INP(I_WMG) + ((size_t)(l * 5 + n) * DM + kb * 64) * DM + nb * 32, DM, (bf16*)(wl + WL_WG) + (size_t)(n * 1024 + nb * 32) * DM + kb * 64, DM, scr, lane); continue; } r -= IT_G;
        if (r < IT_B) { const int n = r / 256, q = r % 256, kb = q / 32, nb = q % 32;
            transpose_block(INP(I_WBR) + ((size_t)(l * 5 + n) * 512 + kb * 64) * DM + nb * 32, DM, (bf16*)(wl + WL_WB) + ((size_t)n * 1024 + nb * 32) * 512 + kb * 64, 512, scr, lane); continue; } r -= IT_B;
        if (r < IT_O) { const int n = r / 512, q = r % 512, kb = q / 32, nb = q % 32;
            transpose_block(INP(I_WOUT) + ((size_t)l * DM + kb * 64) * DM + nb * 32, DM, (bf16*)(wl + WL_WO5) + (size_t)(nb * 32) * 5120 + n * 1024 + kb * 64, 5120, scr, lane); continue; } r -= IT_O;
        if (r < IT_UP) { const int kb = r / 176, nb = r % 176, c0 = nb * 32, half = c0 >= DFF ? 1 : 0, j0 = c0 - half * DFF, drow = (j0 >> 7) * 256 + half * 128 + (j0 & 127);
            transpose_block(INP(I_WUP) + ((size_t)l * DM + kb * 64) * 5632 + c0, 5632, (bf16*)(wl + WL_WUP) + (size_t)drow * DM + kb * 64, DM, scr, lane); continue; } r -= IT_UP;
        if (r < IT_DN) { const int kb = r / 32, nb = r % 32;
            transpose_block(INP(I_WDN) + ((size_t)l * DFF + kb * 64) * DM + nb * 32, DM, (bf16*)(wl + WL_WDN) + (size_t)(nb * 32) * DFF + kb * 64, DFF, scr, lane); continue; } r -= IT_DN;
        { const int which = r / 32, q = r % 32, h = q / 8, kb = (q % 8) / 4, nb = q % 4;
            const float* W = (which ? INP(I_LWI) : INP(I_LWA)) + ((size_t)(l * 4 + h) * 128 + kb * 64) * 128 + nb * 32;
            transpose_block(W, 128, (bf16*)(wl + WL_WLRU) + (size_t)(h * 256 + which * 128 + nb * 32) * 512 + h * 128 + kb * 64, 512, scr, lane); }
    }
    const size_t gt = (size_t)F.vcu * NTHR + F.tid, GT = (size_t)F.G * NTHR;
#pragma clang loop unroll(disable)
    for (size_t i = gt; i < (size_t)2 * 1024 * 64; i += GT) { const int l = (int)(i / (1024 * 64)), q = (int)(i % (1024 * 64)), row = q / 64, c8 = q % 64, h = row / 256;
        if ((c8 >> 4) != h) *(v4u*)((bf16*)(F.ws + WS_W + (size_t)l * WL_SIZE + WL_WLRU) + (size_t)row * 512 + c8 * 8) = (v4u){0u, 0u, 0u, 0u}; }
#pragma clang loop unroll(disable)
    for (size_t i = gt; i < (size_t)MP * 128; i += GT) { const size_t row = i / 128; const int c = (int)(i % 128) * 8; float v[8] = {0.f, 0.f, 0.f, 0.f, 0.f, 0.f, 0.f, 0.f};
        if (row < MROWS) { ld8f(row < MPR ? INP(I_XP) + row * DM + c : INP(I_XS) + (row - MPR) * DM + c, v); st8f(F.out + row * DM + c, v); }
        *(v4u*)(WSP(bf16, WS_XB) + row * DM + c) = pack8(v); }
#pragma clang loop unroll(disable)
    for (size_t i = gt; i < (size_t)2048 * 128; i += GT) { float v[8]; ld8f(INP(I_MEM) + i * 8, v); *(v4u*)(WSP(bf16, WS_MB) + i * 8) = pack8(v); }
#pragma clang loop unroll(disable)
    for (size_t i = gt; i < (size_t)2 * 8 * 1024; i += GT) { const int l = (int)(i / 8192), c = (int)(i / 1024) % 8, k = (int)(i % 1024); WSP(float, WS_WBA)[i] = INP(I_WIN)[((size_t)l * DM + k) * NIN + 2560 + c]; }
#pragma clang loop unroll(disable)
    for (size_t i = gt; i < 512; i += GT) { const float r0 = INP(I_HLB)[i], r1 = INP(I_HLB)[512 + i], mx = fmaxf(r0, r1), e0 = expf(r0 - mx), e1 = expf(r1 - mx);
        WSP(float, WS_LBV)[i] = 0.f; WSP(float, WS_LBV)[512 + i] = e1 / (e0 + e1); }
#pragma clang loop unroll(disable)
    for (size_t i = gt; i < (size_t)2049 * 64; i += GT) { const int p = (int)(i / 64), j = (int)(i % 64); const double pos = p < 2048 ? (double)p : 16384.0;
        const double inv = exp2(-(double)j * (13.287712379549449 / 64.0)); const double ang = pos * inv;
        WSP(float, WS_ROPE)[i] = (float)cos(ang); WSP(float, WS_ROPE)[(size_t)2049 * 64 + i] = (float)sin(ang); }
}
__device__ __forceinline__ void p2_prepass(Frame& F, int l) {
    const int gw = F.vcu * NWAVES + F.wave, NGW = F.G * NWAVES, lane = F.lane, c8 = lane * 8;
    bf16* U = WSP(bf16, WS_U);
    const float* ropec = WSP(float, WS_ROPE); const float* ropes = ropec + 2049 * 64;
#pragma clang loop unroll(disable)
    for (int m = gw; m < MROWS; m += NGW) {
        const bool prompt = m < MPR; const int b = m >> 11, t = m & 2047, s = m - MPR;
        bf16* urow = U + (size_t)m * NU;
        {   const float* xr = F.out + (size_t)m * DM; const float* wb = WSP(float, WS_WBA) + (size_t)l * 8 * 1024;
            float d[8];
#pragma unroll
            for (int c = 0; c < 8; ++c) d[c] = 0.f;
#pragma unroll
            for (int j = 0; j < 4; ++j) { const f32x4 xv = *(const f32x4*)(xr + 4 * lane + 256 * j);
#pragma unroll
                for (int c = 0; c < 8; ++c) { const f32x4 wv = *(const f32x4*)(wb + c * 1024 + 4 * lane + 256 * j); d[c] += (xv.x * wv.x + xv.y * wv.y) + (xv.z * wv.z + xv.w * wv.w); } }
#pragma unroll
            for (int c = 0; c < 8; ++c) d[c] = wave_sum(d[c]);
            if (lane < 4) { const float db = lane == 0 ? d[0] : lane == 1 ? d[1] : lane == 2 ? d[2] : d[3], da = lane == 0 ? d[4] : lane == 1 ? d[5] : lane == 2 ? d[6] : d[7];
                const float g = -expf(INP(I_GALOG)[l * 4 + lane]) * softplusf(da + INP(I_GDT)[l * 4 + lane]);
                WSP(float, WS_BETA)[(size_t)m * 4 + lane] = sigm(db); WSP(float, WS_EG)[(size_t)m * 4 + lane] = g; } }
        {   float x0[8], x1[8], x2[8], x3[8];
            ld8bf(urow + U_XA + c8, x3);
            if (prompt) {
                if (t >= 1) ld8bf(urow - NU + U_XA + c8, x2); else { for (int e = 0; e < 8; ++e) x2[e] = 0.f; }
                if (t >= 2) ld8bf(urow - 2 * NU + U_XA + c8, x1); else { for (int e = 0; e < 8; ++e) x1[e] = 0.f; }
                if (t >= 3) ld8bf(urow - 3 * NU + U_XA + c8, x0); else { for (int e = 0; e < 8; ++e) x0[e] = 0.f; }
                if (t >= SEQ - 3) st8f(F.out + O_PLC + ((size_t)(l * 8 + b) * 3 + (t - (SEQ - 3))) * 512 + c8, x3);
            } else {
                const float* sb = INP(I_SLRUC) + ((size_t)(l * DECB + s) * 3) * 512 + c8;
                ld8f(sb, x0); ld8f(sb + 512, x1); ld8f(sb + 1024, x2);
                float* so = F.out + O_SLC + ((size_t)(l * DECB + s) * 3) * 512 + c8;
                st8f(so, x1); st8f(so + 512, x2); st8f(so + 1024, x3);
            }
            float w0[8], w1[8], w2[8], w3[8], bb[8], o[8];
            const float* cw = INP(I_LCW) + (size_t)l * 4 * 512 + c8;
            ld8f(cw, w0); ld8f(cw + 512, w1); ld8f(cw + 1024, w2); ld8f(cw + 1536, w3); ld8f(INP(I_LCB) + l * 512 + c8, bb);
#pragma unroll
            for (int e = 0; e < 8; ++e) o[e] = w0[e] * x0[e] + w1[e] * x1[e] + w2[e] * x2[e] + w3[e] * x3[e] + bb[e];
            *(v4u*)(WSP(bf16, WS_XAC) + (size_t)m * 512 + c8) = pack8(o); }
#pragma unroll 1
        for (int grp = 0; grp < 3; ++grp) {
            const int cu = U_GQ + grp * 512 + c8, cc = grp * 512 + c8;
            float x0[8], x1[8], x2[8], x3[8];
            ld8bf(urow + cu, x3);
            if (prompt) {
                if (t >= 1) ld8bf(urow - NU + cu, x2); else { for (int e = 0; e < 8; ++e) x2[e] = 0.f; }
                if (t >= 2) ld8bf(urow - 2 * NU + cu, x1); else { for (int e = 0; e < 8; ++e) x1[e] = 0.f; }
                if (t >= 3) ld8bf(urow - 3 * NU + cu, x0); else { for (int e = 0; e < 8; ++e) x0[e] = 0.f; }
                if (t >= SEQ - 3) st8f(F.out + O_PGC + ((size_t)(l * 8 + b) * 3 + (t - (SEQ - 3))) * 1536 + cc, x3);
            } else {
                const float* sb = INP(I_SGDNC) + ((size_t)(l * DECB + s) * 3) * 1536 + cc;
                ld8f(sb, x0); ld8f(sb + 1536, x1); ld8f(sb + 3072, x2);
                float* so = F.out + O_SGC + ((size_t)(l * DECB + s) * 3) * 1536 + cc;
                st8f(so, x1); st8f(so + 1536, x2); st8f(so + 3072, x3);
            }
            float w0[8], w1[8], w2[8], w3[8], o[8];
            const float* cw = INP(I_GCW) + (size_t)l * 4 * 1536 + cc;
            ld8f(cw, w0); ld8f(cw + 1536, w1); ld8f(cw + 3072, w2); ld8f(cw + 4608, w3);
            float ss = 0.f;
#pragma unroll
            for (int e = 0; e < 8; ++e) { const float v = w0[e] * x0[e] + w1[e] * x1[e] + w2[e] * x2[e] + w3[e] * x3[e]; o[e] = siluf(v); ss += o[e] * o[e]; }
            if (grp < 2) { ss = row16_sum(ss); const float sc = rsqrtf(ss + NORM_EPS) * (grp == 0 ? 0.08838834764831845f : 1.0f);
#pragma unroll
                for (int e = 0; e < 8; ++e) o[e] *= sc; }
            bf16* dst = grp == 0 ? WSP(bf16, WS_GQ) : grp == 1 ? WSP(bf16, WS_GK) : WSP(bf16, WS_GV);
            *(v4u*)(dst + (size_t)m * 512 + c8) = pack8(o);
        }
        {   float q[8], f[8], lb[8]; ld8bf(urow + U_HQ + c8, q); ld8bf(urow + U_HF + c8, f); ld8f(WSP(float, WS_LBV) + l * 512 + c8, lb);
#pragma unroll
            for (int e = 0; e < 8; ++e) { q[e] = siluf(q[e]); f[e] = lb[e] + (1.0f - lb[e]) * sigm(f[e]); }
            *(v4u*)(urow + U_HQ + c8) = pack8(q); *(v4u*)(urow + U_HF + c8) = pack8(f); }
        {   const int ti = prompt ? t : 2048, jj = (lane & 7) * 8; const bool hi = (lane & 8) != 0;
            float cs[8], sn[8]; ld8f(ropec + (size_t)ti * 64 + jj, cs); ld8f(ropes + (size_t)ti * 64 + jj, sn);
#pragma unroll 1
            for (int w = 0; w < 2; ++w) { const int cu = (w ? U_RK : U_RQ) + c8; const float sc = w ? 0.08838834764831845f : 1.0f;
                float x[8], o[8]; ld8bf(urow + cu, x);
#pragma unroll
                for (int e = 0; e < 8; ++e) { const float other = __shfl_xor(x[e], 8); o[e] = (hi ? (x[e] * cs[e] + other * sn[e]) : (x[e] * cs[e] - other * sn[e])) * sc; }
                *(v4u*)(urow + cu) = pack8(o); } }
    }
    {   const size_t gt = (size_t)F.vcu * NTHR + F.tid, GT = (size_t)F.G * NTHR;
        const float* mk = F.out + O_PMK + (size_t)l * 8 * 256 * 512; const float* mv = F.out + O_PMV + (size_t)l * 8 * 256 * 512;
#pragma clang loop unroll(disable)
        for (size_t i = gt; i < (size_t)8 * 4 * 256 * 16; i += GT) { const int d8 = (int)(i % 16), mm = (int)(i / 16) % 256, h = (int)(i / 4096) % 4, b = (int)(i / 16384);
            float v[8]; ld8f(mk + ((size_t)(b * 256 + mm) * 4 + h) * 128 + d8 * 8, v); *(v4u*)(WSP(bf16, WS_KB) + (((size_t)(b * 4 + h) * 256 + mm) * 128 + d8 * 8)) = pack8(v); }
#pragma clang loop unroll(disable)
        for (size_t i = gt; i < (size_t)8 * 4 * 128 * 32; i += GT) { const int m8 = (int)(i % 32), d = (int)(i / 32) % 128, h = (int)(i / 4096) % 4, b = (int)(i / 16384);
            float v[8];
#pragma unroll
            for (int e = 0; e < 8; ++e) v[e] = mv[((size_t)(b * 256 + m8 * 8 + e) * 4 + h) * 128 + d];
            *(v4u*)(WSP(bf16, WS_VT) + (((size_t)(b * 4 + h) * 128 + d) * 256 + m8 * 8)) = pack8(v); }
    }
}
constexpr int SQ_A = 0, SQ_Q = 16384, SQ_V = 32768, SQ_SC = 36864, SQ_BUF = 37376, SQ_O = 2 * SQ_BUF, SQ_OBYTES = 8192;
struct SeqArgs { const bf16* A; const bf16* Q; const bf16* V; int lda, ldq, ldv; const float* beta; const float* eg; float gamma; const float* S0; float* Sout; float* O; int T; int vs0, vs1; };
template <int TYPE>
__device__ __forceinline__ void seq_unit(Frame& F, const SeqArgs& a) {
    LAS unsigned char* lds = F.lds;
    const int tid = F.tid, lane = F.lane, kg = lane & 15, v = 4 * F.wave + (lane >> 4);
    const int nch = (a.T + 63) >> 6;
    for (int vs = a.vs0; vs < a.vs1; ++vs) {
        const int v0 = vs * 32;
        float S[8];
#pragma unroll
        for (int i = 0; i < 8; ++i) S[i] = a.S0 ? a.S0[(size_t)(8 * kg + i) * 128 + v0 + v] : 0.f;
        v4u ra0 = (v4u){0u,0u,0u,0u}, ra1 = ra0, rq0 = ra0, rq1 = ra0, rv = ra0; float rsb = 0.f, rse = 0.f;
#define SQ_GLOAD(c_) do { const int t0 = (c_) * 64; \
            { const int p = tid, row = p >> 4, cc = p & 15; const bool ok = t0 + row < a.T; \
              ra0 = ok ? *(const v4u*)(a.A + (size_t)(t0 + row) * a.lda + cc * 8) : (v4u){0u, 0u, 0u, 0u}; rq0 = ok ? *(const v4u*)(a.Q + (size_t)(t0 + row) * a.ldq + cc * 8) : (v4u){0u, 0u, 0u, 0u}; } \
            { const int p = tid + 512, row = p >> 4, cc = p & 15; const bool ok = t0 + row < a.T; \
              ra1 = ok ? *(const v4u*)(a.A + (size_t)(t0 + row) * a.lda + cc * 8) : (v4u){0u, 0u, 0u, 0u}; rq1 = ok ? *(const v4u*)(a.Q + (size_t)(t0 + row) * a.ldq + cc * 8) : (v4u){0u, 0u, 0u, 0u}; } \
            if (tid < 256) { const int row = tid >> 2, cc = tid & 3; rv = (t0 + row < a.T) ? *(const v4u*)(a.V + (size_t)(t0 + row) * a.ldv + v0 + cc * 8) : (v4u){0u, 0u, 0u, 0u}; } \
            if (TYPE == 0 && tid >= 256 && tid < 320) { const int row = tid - 256; if (t0 + row < a.T) { rsb = a.beta[(size_t)(t0 + row) * 4]; rse = __expf(a.eg[(size_t)(t0 + row) * 4]); } else { rsb = 0.f; rse = 1.f; } } } while (0)
#define SQ_LSTORE(buf_) do { LAS unsigned char* B_ = lds + (buf_) * SQ_BUF; \
            *(LAS v4u*)(B_ + SQ_A + tid * 16) = ra0; *(LAS v4u*)(B_ + SQ_A + (tid + 512) * 16) = ra1; \
            *(LAS v4u*)(B_ + SQ_Q + tid * 16) = rq0; *(LAS v4u*)(B_ + SQ_Q + (tid + 512) * 16) = rq1; \
            if (tid < 256) *(LAS v4u*)(B_ + SQ_V + tid * 16) = rv; \
            if (TYPE == 0 && tid >= 256 && tid < 320) { ((LAS float*)(B_ + SQ_SC))[(tid - 256) * 2] = rsb; ((LAS float*)(B_ + SQ_SC))[(tid - 256) * 2 + 1] = rse; } } while (0)
        SQ_GLOAD(0); SQ_LSTORE(0);
        __syncthreads();
        for (int c = 0; c < nch; ++c) {
            const int buf = c & 1;
            if (c + 1 < nch) SQ_GLOAD(c + 1);
            const LAS unsigned char* B = lds + buf * SQ_BUF;
            LAS float* Ob = (LAS float*)(lds + SQ_O + buf * SQ_OBYTES);
            const int n = (a.T - c * 64) < 64 ? (a.T - c * 64) : 64;
#pragma unroll 4
            for (int tt = 0; tt < n; ++tt) {
                float kk[8], qq[8];
                unpack8(*(const LAS v4u*)(B + SQ_A + tt * 256 + kg * 16), kk);
                unpack8(*(const LAS v4u*)(B + SQ_Q + tt * 256 + kg * 16), qq);
                const float vv = __uint_as_float((unsigned)(*(const LAS unsigned short*)(B + SQ_V + tt * 64 + v * 2)) << 16);
                if (TYPE == 0) {
                    const float be = ((const LAS float*)(B + SQ_SC))[tt * 2], eg = ((const LAS float*)(B + SQ_SC))[tt * 2 + 1];
                    float ks = (kk[0] * S[0] + kk[1] * S[1]) + (kk[2] * S[2] + kk[3] * S[3]) + ((kk[4] * S[4] + kk[5] * S[5]) + (kk[6] * S[6] + kk[7] * S[7]));
                    ks = row16_sum(ks);
                    const float uu = be * (vv - eg * ks);
#pragma unroll
                    for (int i = 0; i < 8; ++i) S[i] = eg * S[i] + kk[i] * uu;
                } else if (TYPE == 1) {
#pragma unroll
                    for (int i = 0; i < 8; ++i) S[i] = kk[i] * S[i] + (1.0f - kk[i]) * vv;
                } else {
#pragma unroll
                    for (int i = 0; i < 8; ++i) S[i] = a.gamma * S[i] + kk[i] * vv;
                }
                float o = (qq[0] * S[0] + qq[1] * S[1]) + (qq[2] * S[2] + qq[3] * S[3]) + ((qq[4] * S[4] + qq[5] * S[5]) + (qq[6] * S[6] + qq[7] * S[7]));
                o = row16_sum(o);
                if (kg == 0) Ob[tt * 32 + v] = o;
            }
            if (c + 1 < nch) SQ_LSTORE(buf ^ 1);
            __syncthreads();
            { const int row = tid >> 3, c4 = tid & 7; if (c * 64 + row < a.T) *(f32x4*)(a.O + (size_t)(c * 64 + row) * 512 + v0 + c4 * 4) = *(const LAS f32x4*)((const LAS unsigned char*)Ob + row * 128 + c4 * 16); }
        }
#pragma unroll
        for (int i = 0; i < 8; ++i) a.Sout[(size_t)(8 * kg + i) * 128 + v0 + v] = S[i];
        __syncthreads();
    }
}

__device__ __forceinline__ void lru_scan_unit(Frame& F, int l, int b, int cg) {
    const int tid = F.tid, seg = tid >> 5, ch = cg * 32 + (tid & 31);
    const float* LA = WSP(float, WS_LA) + ((size_t)(b * SEQ + seg * 128)) * 512 + ch; const float* LB = WSP(float, WS_LB) + ((size_t)(b * SEQ + seg * 128)) * 512 + ch;
    LAS float* car = (LAS float*)F.lds;
    float A = 1.f, Bc = 0.f;
#pragma unroll 8
    for (int t = 0; t < 128; ++t) { const float av = LA[(size_t)t * 512], bv = LB[(size_t)t * 512]; Bc = av * Bc + bv; A *= av; }
    car[(seg * 32 + (tid & 31)) * 2] = A; car[(seg * 32 + (tid & 31)) * 2 + 1] = Bc;
    __syncthreads();
    float h = 0.f;
    for (int s2 = 0; s2 < seg; ++s2) h = car[(s2 * 32 + (tid & 31)) * 2] * h + car[(s2 * 32 + (tid & 31)) * 2 + 1];
    bf16* Y = WSP(bf16, WS_Y) + ((size_t)(b * SEQ + seg * 128)) * 512 + ch;
#pragma unroll 8
    for (int t = 0; t < 128; ++t) { const float av = LA[(size_t)t * 512], bv = LB[(size_t)t * 512]; h = av * h + bv; Y[(size_t)t * 512] = (bf16)f2bf(h); }
    if (seg == 15) F.out[O_PLH + (size_t)(l * 8 + b) * 512 + ch] = h;
    __syncthreads();
}

constexpr int XK_STRIDE = 272, XV_STRIDE = 528, XV_OFF = 256 * XK_STRIDE;
static_assert(XV_OFF + 128 * XV_STRIDE <= SCR_BYTES, "cross-attention LDS");
__device__ __forceinline__ void cross_prompt_unit(Frame& F, int b, int h, int tb) {
    LAS unsigned char* lds = F.lds; const int tid = F.tid, lane = F.lane, g = lane >> 4, lr = lane & 15;
    const bf16* Kb = WSP(bf16, WS_KB) + (size_t)(b * 4 + h) * 256 * 128; const bf16* Vt = WSP(bf16, WS_VT) + (size_t)(b * 4 + h) * 128 * 256;
#pragma unroll
    for (int i = 0; i < 8; ++i) { const int p = tid + 512 * i, row = p >> 4, c = p & 15; *(LAS v4u*)(lds + row * XK_STRIDE + c * 16) = *(const v4u*)(Kb + (size_t)row * 128 + c * 8); }
#pragma unroll
    for (int i = 0; i < 8; ++i) { const int p = tid + 512 * i, row = p >> 5, c = p & 31; *(LAS v4u*)(lds + XV_OFF + row * XV_STRIDE + c * 16) = *(const v4u*)(Vt + (size_t)row * 256 + c * 8); }
    __syncthreads();
    const bf16* U = WSP(bf16, WS_U); bf16* Y4 = WSP(bf16, WS_Y) + (size_t)4 * MP * 512;
    typedef float f4 __attribute__((ext_vector_type(4)));
#pragma unroll 1
    for (int gi = 0; gi < 4; ++gi) {
        const int m0 = b * SEQ + tb * 512 + (F.wave + 8 * gi) * 16;
        bf16x8 qf[4];
#pragma unroll
        for (int ks = 0; ks < 4; ++ks) qf[ks] = *(const bf16x8*)(U + (size_t)(m0 + lr) * NU + U_XQ + h * 128 + 32 * ks + 8 * g);
        f4 st[16];
#pragma unroll
        for (int mt = 0; mt < 16; ++mt) { f4 acc = (f4){0.f, 0.f, 0.f, 0.f};
#pragma unroll
            for (int ks = 0; ks < 4; ++ks) { const bf16x8 af = *(const LAS bf16x8*)(lds + (16 * mt + lr) * XK_STRIDE + (32 * ks + 8 * g) * 2); acc = __builtin_amdgcn_mfma_f32_16x16x32_bf16(af, qf[ks], acc, 0, 0, 0); }
            st[mt] = acc; __builtin_amdgcn_sched_barrier(0); }
        float mx = -3.0e38f;
#pragma unroll
        for (int mt = 0; mt < 16; ++mt) mx = fmaxf(mx, fmaxf(fmaxf(st[mt][0], st[mt][1]), fmaxf(st[mt][2], st[mt][3])));
        mx = fmaxf(mx, __shfl_xor(mx, 16)); mx = fmaxf(mx, __shfl_xor(mx, 32));
        const float sc = 0.08838834764831845f; float sum = 0.f;
#pragma unroll
        for (int mt = 0; mt < 16; ++mt)
#pragma unroll
            for (int r = 0; r < 4; ++r) { const float p = __expf((st[mt][r] - mx) * sc); st[mt][r] = p; sum += p; }
        sum += __shfl_xor(sum, 16); sum += __shfl_xor(sum, 32);
        const float inv = 1.0f / sum;
        bf16x8 pf[8];
#pragma unroll
        for (int k2 = 0; k2 < 8; ++k2) { v4u w; w.x = pk2(st[2 * k2][0], st[2 * k2][1]); w.y = pk2(st[2 * k2][2], st[2 * k2][3]); w.z = pk2(st[2 * k2 + 1][0], st[2 * k2 + 1][1]); w.w = pk2(st[2 * k2 + 1][2], st[2 * k2 + 1][3]);
            pf[k2] = __builtin_bit_cast(bf16x8, w); }
#pragma unroll
        for (int dt = 0; dt < 8; ++dt) { f4 acc = (f4){0.f, 0.f, 0.f, 0.f};
#pragma unroll
            for (int k2 = 0; k2 < 8; ++k2) { const LAS unsigned char* vp = lds + XV_OFF + (16 * dt + lr) * XV_STRIDE + (32 * k2 + 4 * g) * 2;
                const unsigned long long lo = *(const LAS unsigned long long*)vp, hi = *(const LAS unsigned long long*)(vp + 32);
                v4u w; w.x = (unsigned)lo; w.y = (unsigned)(lo >> 32); w.z = (unsigned)hi; w.w = (unsigned)(hi >> 32);
                acc = __builtin_amdgcn_mfma_f32_16x16x32_bf16(__builtin_bit_cast(bf16x8, w), pf[k2], acc, 0, 0, 0); }
            unsigned long long o = (unsigned long long)pk2(acc[0] * inv, acc[1] * inv) | ((unsigned long long)pk2(acc[2] * inv, acc[3] * inv) << 32);
            *(unsigned long long*)(Y4 + (size_t)(m0 + lr) * 512 + h * 128 + 16 * dt + 4 * g) = o; __builtin_amdgcn_sched_barrier(0); }
    }
    __syncthreads();
}

__device__ __forceinline__ void cross_sample_unit(Frame& F, int l, int s, int h) {
    const int tid = F.tid; LAS float* sm = (LAS float*)F.lds;
    const bf16* U = WSP(bf16, WS_U);
    if (tid < 128) sm[tid] = bflo((unsigned)U[(size_t)(MPR + s) * NU + U_XQ + h * 128 + tid]);
    __syncthreads();
    const float* K = INP(I_CK) + (((size_t)(l * DECB + s) * 256) * 4 + h) * 128; const float* V = INP(I_CV) + (((size_t)(l * DECB + s) * 256) * 4 + h) * 128;
    { const int mm = tid >> 1, hf = tid & 1; const float* kr = K + (size_t)mm * 512 + hf * 64; float d = 0.f;
#pragma unroll
      for (int j = 0; j < 16; ++j) { const f32x4 kv = *(const f32x4*)(kr + 4 * j); const LAS float* q = sm + hf * 64 + 4 * j; d += (kv.x * q[0] + kv.y * q[1]) + (kv.z * q[2] + kv.w * q[3]); }
      d += __shfl_xor(d, 1);
      if (hf == 0) sm[128 + mm] = d * 0.08838834764831845f; }
    __syncthreads();
    float mx = -3.0e38f;
    for (int j = 0; j < 256; ++j) mx = fmaxf(mx, sm[128 + j]);
    float sum = 0.f;
    for (int j = 0; j < 256; ++j) sum += __expf(sm[128 + j] - mx);
    { const int d = tid & 127, q4 = tid >> 7; float o = 0.f;
#pragma unroll 8
      for (int j = 0; j < 64; ++j) { const int mm = q4 * 64 + j; o += __expf(sm[128 + mm] - mx) * V[(size_t)mm * 512 + d]; }
      sm[384 + q4 * 128 + d] = o; }
    __syncthreads();
    if (tid < 128) { const float o = (sm[384 + tid] + sm[512 + tid]) + (sm[640 + tid] + sm[768 + tid]);
        WSP(bf16, WS_Y)[(size_t)4 * MP * 512 + (size_t)(MPR + s) * 512 + h * 128 + tid] = (bf16)f2bf(o / sum); }
    __syncthreads();
}

__device__ __forceinline__ size_t blk_off(int ld, int r, int j) { return (size_t)(r >> 3) * ld + (r & 7) * 16 + j; }
constexpr int CP_ROW = 272, CP_WAVE = 10240;
constexpr size_t WS_AQK = WS_END;
constexpr size_t WS_DEC = WS_AQK + (size_t)3 * 4096 * 256 * 2;
constexpr size_t WS_DG = WS_DEC + (size_t)4096 * 128 * 4;
constexpr size_t WS_END2 = WS_DG + 4096 * 4;
template <int BR>
__device__ __forceinline__ void p3b_chunkprep_br(Frame& F, int l) {
    constexpr int br = BR;
    const int gw = F.vcu * NWAVES + F.wave, NGW = F.G * NWAVES, lane = F.lane, g = lane >> 4, lr = lane & 15;
    LAS unsigned char* wl = F.lds + F.wave * CP_WAVE;
    LAS float* akk = (LAS float*)(wl + 8704); LAS float* Gs = (LAS float*)(wl + 9728); LAS float* Bs = (LAS float*)(wl + 9792);
    bf16* U = WSP(bf16, WS_U);
#pragma clang loop unroll(disable)
    for (int it = gw; it < 4096; it += NGW) {
        const int q = it, b = q >> 9, c = (q >> 2) & 127, h = q & 3;
        const size_t m0 = (size_t)b * SEQ + c * 16; const int blk = (b * 128 + c) * 4 + h;
        bf16 *pq, *pk, *pv; constexpr int ld = (BR == 0) ? 512 : NU;
        if (br == 0) { pq = WSP(bf16, WS_GQ) + m0 * 512 + h * 128; pk = WSP(bf16, WS_GK) + m0 * 512 + h * 128; pv = WSP(bf16, WS_GV) + m0 * 512 + h * 128; }
        else if (br == 1) { pq = U + m0 * NU + U_HQ + h * 128; pk = U + m0 * NU + U_HF + h * 128; pv = U + m0 * NU + U_HI + h * 128; }
        else { pq = U + m0 * NU + U_RQ + h * 128; pk = U + m0 * NU + U_RK + h * 128; pv = U + m0 * NU + U_RV + h * 128; }
        float qv[16][2], kv[16][2], vv[16][2];
        bf16* pql = pq + 2 * lane; const bf16* pkl = pk + 2 * lane; const bf16* pvl = pv + 2 * lane; asm volatile("" : "+v"(pql), "+v"(pkl), "+v"(pvl));
#pragma unroll
        for (int j = 0; j < 16; ++j) { const unsigned wq = *(const unsigned*)(pql + (size_t)j * ld), wk = *(const unsigned*)(pkl + (size_t)j * ld), wv = *(const unsigned*)(pvl + (size_t)j * ld);
            qv[j][0] = bflo(wq); qv[j][1] = bfhi(wq); kv[j][0] = bflo(wk); kv[j][1] = bfhi(wk); vv[j][0] = bflo(wv); vv[j][1] = bfhi(wv); }
        asm volatile("s_waitcnt vmcnt(0)" ::: "memory");
        float Gt[16];
        float bet[16];
        if (br == 0) { float acc = 0.f;
#pragma unroll
            for (int j = 0; j < 16; ++j) { float gj = WSP(float, WS_EG)[(m0 + j) * 4 + h], bj = WSP(float, WS_BETA)[(m0 + j) * 4 + h]; asm volatile("" : "+v"(gj), "+v"(bj));
                acc += gj; Gt[j] = acc; bet[j] = bj; } }
        else if (br == 2) { float lg = logf(1.0f - exp2f(-5.0f - (float)h)); asm volatile("" : "+v"(lg));
#pragma unroll
            for (int j = 0; j < 16; ++j) { Gt[j] = (float)(j + 1) * lg; bet[j] = 0.f; } }
        else {
#pragma unroll
            for (int j = 0; j < 16; ++j) { Gt[j] = 0.f; bet[j] = 0.f; } }
        if (br == 1) {
            float G0[16], G1[16]; float a0 = 0.f, a1 = 0.f;
#pragma unroll
            for (int j = 0; j < 16; ++j) { a0 += __logf(fmaxf(kv[j][0], 1e-30f)); a1 += __logf(fmaxf(kv[j][1], 1e-30f)); G0[j] = a0; G1[j] = a1; }
            const float mid0 = G0[7], mid1 = G1[7], e0 = G0[15], e1 = G1[15];
            unsigned ket0[8], ket1[8], vt0[8], vt1[8];
#pragma unroll
            for (int j = 0; j < 16; ++j) { const float k0 = 1.0f - kv[j][0], k1 = 1.0f - kv[j][1];
                *(LAS unsigned*)(wl + j * CP_ROW + 4 * lane) = pk2(k0 * __expf(mid0 - G0[j]), k1 * __expf(mid1 - G1[j]));
                *(LAS unsigned*)(wl + 4352 + j * CP_ROW + 4 * lane) = pk2(qv[j][0] * __expf(G0[j] - mid0), qv[j][1] * __expf(G1[j] - mid1));
                *(unsigned*)(pql + (size_t)j * ld) = pk2(qv[j][0] * __expf(G0[j]), qv[j][1] * __expf(G1[j]));
                const float t0 = k0 * __expf(e0 - G0[j]), t1 = k1 * __expf(e1 - G1[j]);
                if (j & 1) { ket0[j >> 1] |= f2bf(t0) << 16; ket1[j >> 1] |= f2bf(t1) << 16; vt0[j >> 1] |= f2bf(vv[j][0]) << 16; vt1[j >> 1] |= f2bf(vv[j][1]) << 16; }
                else { ket0[j >> 1] = f2bf(t0); ket1[j >> 1] = f2bf(t1); vt0[j >> 1] = f2bf(vv[j][0]); vt1[j >> 1] = f2bf(vv[j][1]); } }
            { bf16* d = pk + blk_off(ld, 2 * lane, 0); *(v4u*)d = (v4u){ket0[0], ket0[1], ket0[2], ket0[3]}; *(v4u*)(d + 8) = (v4u){ket0[4], ket0[5], ket0[6], ket0[7]};
              *(v4u*)(d + 16) = (v4u){ket1[0], ket1[1], ket1[2], ket1[3]}; *(v4u*)(d + 24) = (v4u){ket1[4], ket1[5], ket1[6], ket1[7]}; }
            { bf16* d = pv + blk_off(ld, 2 * lane, 0); *(v4u*)d = (v4u){vt0[0], vt0[1], vt0[2], vt0[3]}; *(v4u*)(d + 8) = (v4u){vt0[4], vt0[5], vt0[6], vt0[7]};
              *(v4u*)(d + 16) = (v4u){vt1[0], vt1[1], vt1[2], vt1[3]}; *(v4u*)(d + 24) = (v4u){vt1[4], vt1[5], vt1[6], vt1[7]}; }
            { float* dd = WSP(float, WS_DEC) + (size_t)blk * 128 + 2 * lane; dd[0] = __expf(e0); dd[1] = __expf(e1); }
        } else {
            unsigned ket0[8], ket1[8], vt0[8], vt1[8];
#pragma unroll
            for (int j = 0; j < 16; ++j) {
                *(LAS unsigned*)(wl + j * CP_ROW + 4 * lane) = pk2(kv[j][0], kv[j][1]);
                *(LAS unsigned*)(wl + 4352 + j * CP_ROW + 4 * lane) = pk2(qv[j][0], qv[j][1]);
                const float eq = __expf(Gt[j]), ek = __expf(Gt[15] - Gt[j]);
                *(unsigned*)(pql + (size_t)j * ld) = pk2(qv[j][0] * eq, qv[j][1] * eq);
                const float t0 = kv[j][0] * ek, t1 = kv[j][1] * ek;
                if (j & 1) { ket0[j >> 1] |= f2bf(t0) << 16; ket1[j >> 1] |= f2bf(t1) << 16; vt0[j >> 1] |= f2bf(vv[j][0]) << 16; vt1[j >> 1] |= f2bf(vv[j][1]) << 16; }
                else { ket0[j >> 1] = f2bf(t0); ket1[j >> 1] = f2bf(t1); vt0[j >> 1] = f2bf(vv[j][0]); vt1[j >> 1] = f2bf(vv[j][1]); } }
            { bf16* d = pk + blk_off(ld, 2 * lane, 0); *(v4u*)d = (v4u){ket0[0], ket0[1], ket0[2], ket0[3]}; *(v4u*)(d + 8) = (v4u){ket0[4], ket0[5], ket0[6], ket0[7]};
              *(v4u*)(d + 16) = (v4u){ket1[0], ket1[1], ket1[2], ket1[3]}; *(v4u*)(d + 24) = (v4u){ket1[4], ket1[5], ket1[6], ket1[7]}; }
            if (br == 2) { bf16* d = pv + blk_off(ld, 2 * lane, 0); *(v4u*)d = (v4u){vt0[0], vt0[1], vt0[2], vt0[3]}; *(v4u*)(d + 8) = (v4u){vt0[4], vt0[5], vt0[6], vt0[7]};
              *(v4u*)(d + 16) = (v4u){vt1[0], vt1[1], vt1[2], vt1[3]}; *(v4u*)(d + 24) = (v4u){vt1[4], vt1[5], vt1[6], vt1[7]}; }
            if (br == 0 && lane == 0) WSP(float, WS_DG)[blk] = __expf(Gt[15]);
        }
        if (lane < 16) { float gsel = Gt[0], bsel = bet[0];
#pragma unroll
            for (int j = 1; j < 16; ++j) { gsel = (lane == j) ? Gt[j] : gsel; bsel = (lane == j) ? bet[j] : bsel; }
            Gs[lane] = gsel; Bs[lane] = bsel; }
        asm volatile("s_waitcnt lgkmcnt(0)" ::: "memory");
        f32x4 cq = (f32x4){0.f, 0.f, 0.f, 0.f}, ck = (f32x4){0.f, 0.f, 0.f, 0.f};
#pragma unroll
        for (int ks = 0; ks < 4; ++ks) { const bf16x8 ka = *(const LAS bf16x8*)(wl + lr * CP_ROW + (32 * ks + 8 * g) * 2), qb = *(const LAS bf16x8*)(wl + 4352 + lr * CP_ROW + (32 * ks + 8 * g) * 2);
            cq = __builtin_amdgcn_mfma_f32_16x16x32_bf16(ka, qb, cq, 0, 0, 0);
            if (br == 0) ck = __builtin_amdgcn_mfma_f32_16x16x32_bf16(ka, ka, ck, 0, 0, 0); }
        {   const float Gi = Gs[lr], bi = Bs[lr]; float aq[4], ak[4];
#pragma unroll
            for (int r = 0; r < 4; ++r) { const int j = 4 * g + r; const float dcy = (br == 1) ? 1.0f : __expf(fminf(Gi - Gs[j], 0.f));
                aq[r] = (lr >= j) ? cq[r] * dcy : 0.f; ak[r] = (lr > j) ? ck[r] * dcy * bi : 0.f; }
            *(unsigned long long*)(WSP(bf16, WS_AQK) + ((size_t)br * 4096 + blk) * 256 + lr * 16 + 4 * g) = (unsigned long long)pk2(aq[0], aq[1]) | ((unsigned long long)pk2(aq[2], aq[3]) << 32);
            if (br == 0) *(LAS f32x4*)(akk + lr * 16 + 4 * g) = (f32x4){ak[0], ak[1], ak[2], ak[3]}; }
        if (br == 0) {
            asm volatile("s_waitcnt lgkmcnt(0)" ::: "memory");
            float X[16][4];
#pragma unroll
            for (int i = 0; i < 16; ++i) { const float eb = bet[i] * __expf(Gt[i]);
                float x0 = bet[i] * vv[i][0], x1 = bet[i] * vv[i][1], x2 = eb * kv[i][0], x3 = eb * kv[i][1];
#pragma unroll
                for (int j = 0; j < i; ++j) { const float a = akk[i * 16 + j]; x0 -= a * X[j][0]; x1 -= a * X[j][1]; x2 -= a * X[j][2]; x3 -= a * X[j][3]; }
                X[i][0] = x0; X[i][1] = x1; X[i][2] = x2; X[i][3] = x3;
                *(unsigned*)(WSP(bf16, WS_XAC) + (m0 + i) * 512 + h * 128 + 2 * lane) = pk2(-x2, -x3); }
            unsigned u0[8], u1[8];
#pragma unroll
            for (int j = 0; j < 8; ++j) { u0[j] = pk2(X[2 * j][0], X[2 * j + 1][0]); u1[j] = pk2(X[2 * j][1], X[2 * j + 1][1]); }
            bf16* d = pv + blk_off(ld, 2 * lane, 0); *(v4u*)d = (v4u){u0[0], u0[1], u0[2], u0[3]}; *(v4u*)(d + 8) = (v4u){u0[4], u0[5], u0[6], u0[7]};
            *(v4u*)(d + 16) = (v4u){u1[0], u1[1], u1[2], u1[3]}; *(v4u*)(d + 24) = (v4u){u1[4], u1[5], u1[6], u1[7]};
        }
        asm volatile("s_waitcnt lgkmcnt(0)" ::: "memory");
    }
}

__device__ __forceinline__ void p3b_chunkprep(Frame& F, int l) { p3b_chunkprep_br<0>(F, l); p3b_chunkprep_br<1>(F, l); p3b_chunkprep_br<2>(F, l); }
constexpr int ST_ROW = 272, ST_BUF = 32 * ST_ROW;
template <int TYPE>
__device__ __forceinline__ void seqc_unit(Frame& F, int l, int b, int h, int vs) {
    LAS unsigned char* lds = F.lds; const int lane = F.lane, w = F.wave, g = lane >> 4, lr = lane & 15;
    bf16* U = WSP(bf16, WS_U);
    const bf16 *pq, *pk, *pv; int ld; float* O; float* Sout; const int br = TYPE;
    const size_t mb = (size_t)b * SEQ, so = ((size_t)(l * 8 + b) * 4 + h) * 16384;
    if (TYPE == 0) { pq = WSP(bf16, WS_GQ) + mb * 512 + h * 128; pk = WSP(bf16, WS_GK) + mb * 512 + h * 128; pv = WSP(bf16, WS_GV) + mb * 512 + h * 128; ld = 512; O = WSP(float, WS_OG); Sout = F.out + O_PGS + so; }
    else if (TYPE == 1) { pq = U + mb * NU + U_HQ + h * 128; pk = U + mb * NU + U_HF + h * 128; pv = U + mb * NU + U_HI + h * 128; ld = NU; O = WSP(float, WS_OH); Sout = F.out + O_PHS + so; }
    else { pq = U + mb * NU + U_RQ + h * 128; pk = U + mb * NU + U_RK + h * 128; pv = U + mb * NU + U_RV + h * 128; ld = NU; O = WSP(float, WS_OR); Sout = F.out + O_PRS + so; }
    const bf16* pw = WSP(bf16, WS_XAC) + mb * 512 + h * 128;
    const bf16* paq = WSP(bf16, WS_AQK) + ((size_t)br * 4096 + (size_t)b * 512 + h) * 256;
    const float* pdec = WSP(float, WS_DEC) + ((size_t)b * 512 + h) * 128;
    const float* pdg = WSP(float, WS_DG) + (size_t)b * 512 + h;
    const float gam16 = exp2f(16.0f * log2f(1.0f - exp2f(-5.0f - (float)h)));
    const int v0 = vs * 32;
    for (int i = F.tid; i < ST_BUF / 4; i += NTHR) ((LAS unsigned*)lds)[i] = 0u;
    f32x4 S0 = (f32x4){0.f, 0.f, 0.f, 0.f}, S1 = S0;
    unsigned long long ketf, vf0, vf1, aqf; v4u wf[4], qf[4]; f32x4 decv; float dsc;
    ketf = vf0 = vf1 = aqf = 0ull; decv = (f32x4){1.f, 1.f, 1.f, 1.f}; dsc = 1.f;
#pragma unroll
    for (int ks = 0; ks < 4; ++ks) { wf[ks] = (v4u){0u, 0u, 0u, 0u}; qf[ks] = (v4u){0u, 0u, 0u, 0u}; }
#define SC_LOAD(c_) do { const size_t mc = (size_t)(c_) * 16; \
        ketf = *(const unsigned long long*)(pk + mc * ld + blk_off(ld, 16 * w + lr, 4 * g)); \
        vf0 = *(const unsigned long long*)(pv + mc * ld + blk_off(ld, v0 + lr, 4 * g)); vf1 = *(const unsigned long long*)(pv + mc * ld + blk_off(ld, v0 + 16 + lr, 4 * g)); \
        if (TYPE == 0) { _Pragma("unroll") for (int ks = 0; ks < 4; ++ks) wf[ks] = *(const v4u*)(pw + (mc + lr) * 512 + 32 * ks + 8 * g); dsc = pdg[(size_t)(c_) * 4]; } \
        if (TYPE == 1) decv = *(const f32x4*)(pdec + (size_t)(c_) * 512 + 16 * w + 4 * g); \
        if (w < 2) { _Pragma("unroll") for (int ks = 0; ks < 4; ++ks) qf[ks] = *(const v4u*)(pq + (mc + lr) * ld + 32 * ks + 8 * g); aqf = *(const unsigned long long*)(paq + (size_t)(c_) * 1024 + lr * 16 + 4 * g); } } while (0)
    SC_LOAD(0);
    __syncthreads();
#pragma unroll 1
    for (int c = 0; c < 128; ++c) {
        const LAS unsigned char* Sc = lds + (c & 1) * ST_BUF; LAS unsigned char* Sn = lds + ((c & 1) ^ 1) * ST_BUF;
        const unsigned long long ketc = ketf, vc0 = vf0, vc1 = vf1, aqc = aqf; v4u wc[4], qc[4]; const f32x4 decc = decv; const float dscc = dsc;
#pragma unroll
        for (int ks = 0; ks < 4; ++ks) { wc[ks] = wf[ks]; qc[ks] = qf[ks]; }
        if (c + 1 < 128) SC_LOAD(c + 1);
        bf16x8 sf[2][4];
#pragma unroll
        for (int vt = 0; vt < 2; ++vt)
#pragma unroll
            for (int ks = 0; ks < 4; ++ks) sf[vt][ks] = *(const LAS bf16x8*)(Sc + (16 * vt + lr) * ST_ROW + (32 * ks + 8 * g) * 2);
        bf16x8 vfr[2];
        if (TYPE == 0) {
#pragma unroll
            for (int vt = 0; vt < 2; ++vt) { const unsigned long long uu = vt ? vc1 : vc0;
                f32x4 acc = (f32x4){bflo((unsigned)uu), bfhi((unsigned)uu), bflo((unsigned)(uu >> 32)), bfhi((unsigned)(uu >> 32))};
#pragma unroll
                for (int ks = 0; ks < 4; ++ks) acc = __builtin_amdgcn_mfma_f32_16x16x32_bf16(__builtin_bit_cast(bf16x8, wc[ks]), sf[vt][ks], acc, 0, 0, 0);
                vfr[vt] = __builtin_bit_cast(bf16x8, (v4u){pk2(acc[0], acc[1]), pk2(acc[2], acc[3]), 0u, 0u}); }
        } else {
            vfr[0] = __builtin_bit_cast(bf16x8, (v4u){(unsigned)vc0, (unsigned)(vc0 >> 32), 0u, 0u}); vfr[1] = __builtin_bit_cast(bf16x8, (v4u){(unsigned)vc1, (unsigned)(vc1 >> 32), 0u, 0u});
        }
        if (w < 2) { f32x4 acc = (f32x4){0.f, 0.f, 0.f, 0.f};
#pragma unroll
            for (int ks = 0; ks < 4; ++ks) acc = __builtin_amdgcn_mfma_f32_16x16x32_bf16(w ? sf[1][ks] : sf[0][ks], __builtin_bit_cast(bf16x8, qc[ks]), acc, 0, 0, 0);
            acc = __builtin_amdgcn_mfma_f32_16x16x32_bf16(w ? vfr[1] : vfr[0], __builtin_bit_cast(bf16x8, (v4u){(unsigned)aqc, (unsigned)(aqc >> 32), 0u, 0u}), acc, 0, 0, 0);
            *(f32x4*)(O + (mb + (size_t)c * 16 + lr) * 512 + h * 128 + v0 + 16 * w + 4 * g) = acc; }
        const bf16x8 kfr = __builtin_bit_cast(bf16x8, (v4u){(unsigned)ketc, (unsigned)(ketc >> 32), 0u, 0u});
        if (TYPE == 0) { S0 = S0 * dscc; S1 = S1 * dscc; } else if (TYPE == 1) { S0 = S0 * decc; S1 = S1 * decc; } else { S0 = S0 * gam16; S1 = S1 * gam16; }
        S0 = __builtin_amdgcn_mfma_f32_16x16x32_bf16(kfr, vfr[0], S0, 0, 0, 0);
        S1 = __builtin_amdgcn_mfma_f32_16x16x32_bf16(kfr, vfr[1], S1, 0, 0, 0);
        *(LAS unsigned long long*)(Sn + lr * ST_ROW + (16 * w + 4 * g) * 2) = (unsigned long long)pk2(S0[0], S0[1]) | ((unsigned long long)pk2(S0[2], S0[3]) << 32);
        *(LAS unsigned long long*)(Sn + (16 + lr) * ST_ROW + (16 * w + 4 * g) * 2) = (unsigned long long)pk2(S1[0], S1[1]) | ((unsigned long long)pk2(S1[2], S1[3]) << 32);
        __syncthreads();
    }
#undef SC_LOAD
#pragma unroll
    for (int r = 0; r < 4; ++r) { Sout[(size_t)(16 * w + 4 * g + r) * 128 + v0 + lr] = S0[r]; Sout[(size_t)(16 * w + 4 * g + r) * 128 + v0 + 16 + lr] = S1[r]; }
    __syncthreads();
}

__device__ __forceinline__ void p4_mixers(Frame& F, int l) {
    constexpr int N_SEQP = 128, Q_GDN = 0, Q_HGRN = 128, Q_RET = 256, Q_LRU = 384, Q_XP = 512, Q_SS = 640, Q_XS = Q_SS + 3 * 512, Q_END = Q_XS + 512;
    const bf16* U = WSP(bf16, WS_U);
    for (;;) {
        F.tid = threadIdx.x; asm volatile("" : "+v"(F.tid)); F.lane = F.tid & 63; F.wave = __builtin_amdgcn_readfirstlane(F.tid >> 6);
        if (F.tid == 0) F.MISC[16] = __hip_atomic_fetch_add((unsigned*)(F.ctl + CW_QUEUE + 64 * l), 1u, __ATOMIC_RELAXED, __HIP_MEMORY_SCOPE_AGENT);
        __syncthreads();
        const int idx = (int)F.MISC[16];
        __syncthreads();
        if (idx >= Q_END) break;
        if (idx < Q_LRU) {
            const int type = idx / N_SEQP, j = idx % N_SEQP, b = j >> 4, h = (j >> 2) & 3, vs = j & 3;
            if (type == 0) { if (EN(22)) seqc_unit<0>(F, l, b, h, vs); } else if (type == 1) { if (EN(23)) seqc_unit<1>(F, l, b, h, vs); } else { if (EN(24)) seqc_unit<2>(F, l, b, h, vs); }
        } else if (idx < Q_XP) { const int j = idx - Q_LRU; if (EN(19)) lru_scan_unit(F, l, j >> 4, j & 15); }
        else if (idx < Q_SS) { const int j = idx - Q_XP; if (EN(20)) cross_prompt_unit(F, j >> 4, (j >> 2) & 3, j & 3); }
        else if (idx < Q_XS) {
            const int j = idx - Q_SS, type = j / 512, s = (j % 512) >> 2, h = j & 3; const size_t m0 = (size_t)MPR + s;
            SeqArgs a; a.T = 1; a.vs0 = 0; a.vs1 = 4; a.gamma = 0.f; a.beta = nullptr; a.eg = nullptr;
            const size_t so = ((size_t)(l * DECB + s) * 4 + h) * 16384;
            if (type == 0) { a.A = WSP(bf16, WS_GK) + m0 * 512 + h * 128; a.Q = WSP(bf16, WS_GQ) + m0 * 512 + h * 128; a.V = WSP(bf16, WS_GV) + m0 * 512 + h * 128; a.lda = a.ldq = a.ldv = 512;
                a.beta = WSP(float, WS_BETA) + m0 * 4 + h; a.eg = WSP(float, WS_EG) + m0 * 4 + h; a.S0 = INP(I_SGDNS) + so; a.Sout = F.out + O_SGS + so; a.O = WSP(float, WS_OG) + m0 * 512 + h * 128; if (EN(16)) seq_unit<0>(F, a); }
            else if (type == 1) { a.A = U + m0 * NU + U_HF + h * 128; a.Q = U + m0 * NU + U_HQ + h * 128; a.V = U + m0 * NU + U_HI + h * 128; a.lda = a.ldq = a.ldv = NU;
                a.S0 = INP(I_SHGRNS) + so; a.Sout = F.out + O_SHS + so; a.O = WSP(float, WS_OH) + m0 * 512 + h * 128; if (EN(17)) seq_unit<1>(F, a); }
            else { a.A = U + m0 * NU + U_RK + h * 128; a.Q = U + m0 * NU + U_RQ + h * 128; a.V = U + m0 * NU + U_RV + h * 128; a.lda = a.ldq = a.ldv = NU; a.gamma = 1.0f - exp2f(-5.0f - (float)h);
                a.S0 = INP(I_SRETS) + so; a.Sout = F.out + O_SRS + so; a.O = WSP(float, WS_OR) + m0 * 512 + h * 128; if (EN(18)) seq_unit<2>(F, a); }
        } else { const int j = idx - Q_XS; if (EN(21)) cross_sample_unit(F, l, j >> 2, j & 3); }
    }
}
__device__ __forceinline__ void p5_postpass(Frame& F, int l) {
    const int gw = F.vcu * NWAVES + F.wave, NGW = F.G * NWAVES, lane = F.lane, c8 = lane * 8;
    const bf16* U = WSP(bf16, WS_U); bf16* Y = WSP(bf16, WS_Y);
#pragma clang loop unroll(disable)
    for (int m = gw; m < MROWS; m += NGW) {
        const bf16* urow = U + (size_t)m * NU;
        {   float o[8], z[8], w[8], y[8]; ld8f(WSP(float, WS_OG) + (size_t)m * 512 + c8, o); ld8bf(urow + U_GZ + c8, z); ld8f(INP(I_GNW) + l * 512 + c8, w);
            float ss = 0.f;
#pragma unroll
            for (int e = 0; e < 8; ++e) ss += o[e] * o[e];
            const float rstd = rsqrtf(row16_sum(ss) * (1.0f / 128.0f) + NORM_EPS);
#pragma unroll
            for (int e = 0; e < 8; ++e) y[e] = o[e] * rstd * w[e] * siluf(z[e]);
            *(v4u*)(Y + ((size_t)1 * MP + m) * 512 + c8) = pack8(y); }
        {   float o[8], z[8], w[8], y[8]; ld8f(WSP(float, WS_OH) + (size_t)m * 512 + c8, o); ld8bf(urow + U_HG + c8, z); ld8f(INP(I_HNW) + l * 512 + c8, w);
            float ss = 0.f;
#pragma unroll
            for (int e = 0; e < 8; ++e) ss += o[e] * o[e];
            const float rstd = rsqrtf(row16_sum(ss) * (1.0f / 128.0f) + NORM_EPS);
#pragma unroll
            for (int e = 0; e < 8; ++e) y[e] = o[e] * rstd * w[e] * sigm(z[e]);
            *(v4u*)(Y + ((size_t)2 * MP + m) * 512 + c8) = pack8(y); }
        {   float o[8], z[8], w[8], bb[8], y[8]; ld8f(WSP(float, WS_OR) + (size_t)m * 512 + c8, o); ld8bf(urow + U_RG + c8, z); ld8f(INP(I_RGW) + l * 512 + c8, w); ld8f(INP(I_RGB) + l * 512 + c8, bb);
            float s1 = 0.f;
#pragma unroll
            for (int e = 0; e < 8; ++e) s1 += o[e];
            const float mu = row16_sum(s1) * (1.0f / 128.0f); float s2 = 0.f;
#pragma unroll
            for (int e = 0; e < 8; ++e) { o[e] -= mu; s2 += o[e] * o[e]; }
            const float rstd = rsqrtf(row16_sum(s2) * (1.0f / 128.0f) + NORM_EPS);
#pragma unroll
            for (int e = 0; e < 8; ++e) y[e] = (o[e] * rstd * w[e] + bb[e]) * siluf(z[e]);
            *(v4u*)(Y + ((size_t)3 * MP + m) * 512 + c8) = pack8(y); }
        if (m >= MPR) {
            const int s = m - MPR; float a[8], b[8], h0[8], h[8];
            ld8f(WSP(float, WS_LA) + (size_t)m * 512 + c8, a); ld8f(WSP(float, WS_LB) + (size_t)m * 512 + c8, b); ld8f(INP(I_SLRUH) + ((size_t)l * DECB + s) * 512 + c8, h0);
#pragma unroll
            for (int e = 0; e < 8; ++e) h[e] = a[e] * h0[e] + b[e];
            st8f(F.out + O_SLH + ((size_t)l * DECB + s) * 512 + c8, h);
            *(v4u*)(Y + (size_t)m * 512 + c8) = pack8(h); }
    }
}
__device__ __forceinline__ void ln_pass(Frame& F, const float* gam, const float* bet) {
    const int gw = F.vcu * NWAVES + F.wave, NGW = F.G * NWAVES, lane = F.lane;
#pragma clang loop unroll(disable)
    for (int m = gw; m < MROWS; m += NGW) {
        const f32x4* zr = (const f32x4*)(WSP(float, WS_Z) + (size_t)m * DM) + lane;
        f32x4 v[4]; float s = 0.f;
#pragma unroll
        for (int j = 0; j < 4; ++j) { v[j] = zr[64 * j]; s += (v[j].x + v[j].y) + (v[j].z + v[j].w); }
        const float mean = wave_sum(s) * (1.f / DM); float s2 = 0.f;
#pragma unroll
        for (int j = 0; j < 4; ++j) { v[j] = v[j] - mean; s2 += (v[j].x * v[j].x + v[j].y * v[j].y) + (v[j].z * v[j].z + v[j].w * v[j].w); }
        const float rstd = rsqrtf(wave_sum(s2) * (1.f / DM) + LN_EPS);
        f32x4* xo = (f32x4*)(F.out + (size_t)m * DM) + lane; unsigned long long* xb = (unsigned long long*)(WSP(bf16, WS_XB) + (size_t)m * DM) + lane;
#pragma unroll
        for (int j = 0; j < 4; ++j) { const f32x4 gv = *((const f32x4*)gam + lane + 64 * j), bv = *((const f32x4*)bet + lane + 64 * j); const f32x4 y = v[j] * rstd * gv + bv;
            xo[64 * j] = y; xb[64 * j] = (unsigned long long)pk2(y.x, y.y) | ((unsigned long long)pk2(y.z, y.w) << 32); }
    }
}

struct Args { const float* in[N_INPUTS]; float* out; unsigned char* ws; };
#ifndef MAXPHASE
#define MAXPHASE 1000
#endif
__global__ void __launch_bounds__(NTHR, 2) mega_fwd(Args args) {
    extern __shared__ __attribute__((aligned(16))) unsigned char lds[];
    Frame F;
    F.lds = (LAS unsigned char*)lds; F.MISC = (volatile LAS unsigned*)(F.lds + MISC_OFF);
    F.tid = threadIdx.x; F.lane = F.tid & 63; F.wave = __builtin_amdgcn_readfirstlane(F.tid >> 6);
    F.G = gridDim.x; { const int bx = blockIdx.x; F.vcu = (F.G % 8 == 0) ? (bx % 8) * (F.G / 8) + bx / 8 : bx; }
    F.in = (kin_t)__builtin_amdgcn_kernarg_segment_ptr(); F.out = args.out; F.ws = args.ws; F.ctl = (gu32*)(args.ws + WS_CTL);
    for (int u = F.tid; u < (LDS_BYTES - LDSCTL_OFF) / 4; u += NTHR) ((LAS unsigned*)(F.lds + LDSCTL_OFF))[u] = 0u;
    __syncthreads();
    XcdBarrier bar = xcd_barrier_post((unsigned*)(F.ctl + CW_BAR), F.MISC + 8);
    int phase = 0;
#define GRID_BAR() do { asm volatile("" : "+s"(bar.x), "+s"(bar.bar)); xcd_barrier(bar); if (++phase >= MAXPHASE) return; asm volatile("" : "+s"(F.ws), "+s"(F.out), "+s"(F.in)); F.tid = threadIdx.x; asm volatile("" : "+v"(F.tid)); F.lane = F.tid & 63; F.wave = __builtin_amdgcn_readfirstlane(F.tid >> 6); } while (0)
    LAS unsigned char* glds = F.lds;

    if (EN(0)) p0_prologue(F);
    GRID_BAR();
#pragma unroll 1
    for (int l = 0; l < DEPTH; ++l) {
        unsigned char* wl = F.ws + WS_W + (size_t)l * WL_SIZE;
        if (EN(1)) {   pg8::Gemm g{WSP(bf16, WS_XB), (const bf16*)(wl + WL_WIN), MP, NU, DM}; pg8::StaticOrder S; S.init(MP, NU, F.G, (int)blockIdx.x);
            pg8::EpiBf16 E{WSP(bf16, WS_U), NU};
            pg8::gemm_phase<pg8::EpiBf16, pg8::StaticOrder, true, true>(glds, g, S, E); }
        if (EN(2)) {   pg8::Gemm g{WSP(bf16, WS_MB), (const bf16*)(wl + WL_WKV), 2048, 1024, DM}; pg8::StaticOrder S; S.init(2048, 1024, F.G, (int)blockIdx.x);
            pg8::EpiMemKV E{F.out + O_PMK + (size_t)l * 2048 * 512, F.out + O_PMV + (size_t)l * 2048 * 512};
            pg8::gemm_phase<pg8::EpiMemKV, pg8::StaticOrder, true, true>(glds, g, S, E); }
        GRID_BAR();
        if (EN(3)) p2_prepass(F, l);
        GRID_BAR();
        if (EN(4)) {   pg8::Gemm g{WSP(bf16, WS_XAC), (const bf16*)(wl + WL_WLRU), MP, 1024, 512}; pg8::StaticOrder S; S.init(MP, 1024, F.G, (int)blockIdx.x);
            pg8::EpiLru E{INP(I_LBA) + l * 512, INP(I_LBI) + l * 512, INP(I_LLAM) + l * 512, WSP(bf16, WS_XAC), WSP(float, WS_LA), WSP(float, WS_LB)};
            pg8::gemm_phase<pg8::EpiLru, pg8::StaticOrder, true, true>(glds, g, S, E); }
        GRID_BAR();
        if (EN(14)) p3b_chunkprep(F, l);
        GRID_BAR();
        if (EN(5)) p4_mixers(F, l);
        GRID_BAR();
        if (EN(6)) p5_postpass(F, l);
        GRID_BAR();
#pragma unroll 1
        for (int n = 0; n < (EN(7) ? 5 : 0); ++n) {
            pg8::Gemm g{WSP(bf16, WS_Y) + (size_t)n * MP * 512, (const bf16*)(wl + WL_WB) + (size_t)n * 1024 * 512, MP, 1024, 512}; pg8::StaticOrder S; S.init(MP, 1024, F.G, (int)blockIdx.x);
            pg8::EpiBf16 E{WSP(bf16, WS_U) + n * 1024, 5120};
            pg8::gemm_phase<pg8::EpiBf16, pg8::StaticOrder, true, true>(glds, g, S, E); }
        GRID_BAR();
        if (EN(8)) {   pg8::Gemm g{WSP(bf16, WS_XB), (const bf16*)(wl + WL_WG), MP, 5120, DM}; pg8::StaticOrder S; S.init(MP, 5120, F.G, (int)blockIdx.x);
            pg8::EpiGate E{INP(I_BMG) + (size_t)l * 5120, WSP(bf16, WS_U), WSP(bf16, WS_R2)};
            pg8::gemm_phase<pg8::EpiGate, pg8::StaticOrder, true, true>(glds, g, S, E); }
        GRID_BAR();
        if (EN(9)) {   pg8::Gemm g{WSP(bf16, WS_R2), (const bf16*)(wl + WL_WO5), MP, 1024, 5120}; pg8::StaticOrder S; S.init(MP, 1024, F.G, (int)blockIdx.x);
            pg8::EpiRes E{F.out, WSP(float, WS_Z), MROWS, ALPHA};
            pg8::gemm_phase<pg8::EpiRes, pg8::StaticOrder, true, true>(glds, g, S, E); }
        GRID_BAR();
        if (EN(10)) ln_pass(F, INP(I_LN1G) + l * DM, INP(I_LN1B) + l * DM);
        GRID_BAR();
        if (EN(11)) {   pg8::Gemm g{WSP(bf16, WS_XB), (const bf16*)(wl + WL_WUP), MP, 5632, DM}; pg8::StaticOrder S; S.init(MP, 5632, F.G, (int)blockIdx.x);
            pg8::EpiSwiglu E{WSP(bf16, WS_U)};
            pg8::gemm_phase<pg8::EpiSwiglu, pg8::StaticOrder, true, true>(glds, g, S, E); }
        GRID_BAR();
        if (EN(12)) {   pg8::Gemm g{WSP(bf16, WS_U), (const bf16*)(wl + WL_WDN), MP, 1024, DFF}; pg8::StaticOrder S; S.init(MP, 1024, F.G, (int)blockIdx.x);
            pg8::EpiRes E{F.out, WSP(float, WS_Z), MROWS, ALPHA};
            pg8::gemm_phase<pg8::EpiRes, pg8::StaticOrder, true, true>(glds, g, S, E); }
        GRID_BAR();
        if (EN(13)) ln_pass(F, INP(I_LN2G) + l * DM, INP(I_LN2B) + l * DM);
        if (l + 1 < DEPTH) GRID_BAR();
    }
}

extern "C" void kernel_launch(void* const* d_in, const int* in_sizes, int n_in, void* d_out, int out_size, void* d_ws, size_t ws_size, hipStream_t stream) {
    static int grid = 0;
    if (grid == 0) {
        if (n_in != N_INPUTS || (size_t)out_size != O_END || ws_size < WS_END2) { fprintf(stderr, "kernel_launch: expected %d inputs, %zu outputs, >= %zu bytes of workspace; got %d, %d, %zu\n", (int)N_INPUTS, (size_t)O_END, (size_t)WS_END2, n_in, out_size, ws_size); grid = -1; return; }
        int dev = 0, cus = 0, per_cu = 0;
        if (hipGetDevice(&dev) != hipSuccess || hipDeviceGetAttribute(&cus, hipDeviceAttributeMultiprocessorCount, dev) != hipSuccess) { fprintf(stderr, "kernel_launch: device query failed\n"); grid = -1; return; }
        if (hipFuncSetAttribute((const void*)mega_fwd, hipFuncAttributeMaxDynamicSharedMemorySize, LDS_BYTES) != hipSuccess) { fprintf(stderr, "kernel_launch: hipFuncSetAttribute failed\n"); grid = -1; return; }
        if (hipOccupancyMaxActiveBlocksPerMultiprocessor(&per_cu, (const void*)mega_fwd, NTHR, LDS_BYTES) != hipSuccess || per_cu < 1) fprintf(stderr, "kernel_launch: note: occupancy query says %d blocks per CU\n", per_cu);
        (void)hipGetLastError();
        grid = cus;
    }
    if (grid < 0) return;
    if (hipMemsetAsync((char*)d_ws + WS_CTL, 0, CTL_ZERO_BYTES, stream) != hipSuccess) { fprintf(stderr, "kernel_launch: hipMemsetAsync failed\n"); return; }
    Args a{};
    for (int i = 0; i < N_INPUTS; ++i) a.in[i] = (const float*)d_in[i];
    a.out = (float*)d_out; a.ws = (unsigned char*)d_ws;
    hipLaunchKernelGGL(mega_fwd, dim3(grid), dim3(NTHR), LDS_BYTES, stream, a);
    const hipError_t le = hipPeekAtLastError();
    if (le != hipSuccess) fprintf(stderr, "kernel_launch: launch failed: %s\n", hipGetErrorName(le));
}
```

```cpp
#include <hip/hip_runtime.h>
#include <cstdio>
#include <cstdint>
namespace pg8 {
#define PG8_LAS __attribute__((address_space(3)))
typedef unsigned short bf16_t;
typedef short bf16x8 __attribute__((ext_vector_type(8)));
typedef float f32x4 __attribute__((ext_vector_type(4)));
typedef unsigned u32x4 __attribute__((ext_vector_type(4)));
constexpr int BM = 256, BK = 64, HALF = 128, HTB = HALF * BK * 2  , STAGE_BYTES = 8 * HTB, NXCD = 8, WGM = 8;

__host__ __device__ __forceinline__ int lds_byte(int r, int c) { const int st = (r >> 4) * 2 + (c >> 5), rr = r & 15, cc = c & 31, ob = rr * 64 + cc * 2; return st * 1024 + (ob ^ (((ob >> 9) & 1) << 5)); }
__host__ __device__ __forceinline__ void stage_rc(int b, int& R, int& C) { const int st = b / 1024, sb = b % 1024, swz = sb ^ (((sb >> 9) & 1) << 5); R = (st >> 1) * 16 + swz / 64; C = (st & 1) * 32 + (swz % 64) / 2; }
__host__ __device__ __forceinline__ int perm32(int rho) { const int n = rho >> 4, i = rho & 15; return 8 * (i >> 2) + 4 * n + (i & 3); }

struct Unit { int pm, pn; };
struct Gemm { const bf16_t* A; const bf16_t* Bt; int M, N, K; int a_div; size_t a_stride; };

struct StaticOrder {
    int nM, nN, nwg, G, c;
    __host__ __device__ void init(int M, int N, int G_, int c_) { nM = M / BM; nN = N / BM; nwg = nM * nN; G = G_; c = c_; }
    __host__ __device__ bool next(int i, Unit& u) const {
        const long L = (long)i * G + c; if (L >= nwg) return false;
        int wgid = (int)L; { const int q = nwg / NXCD, r = nwg % NXCD, xcd = wgid % NXCD, off = wgid / NXCD; wgid = (xcd < r ? xcd * (q + 1) : r * (q + 1) + (xcd - r) * q) + off; }
        const int nig = WGM * nN, gid = wgid / nig, fm = gid * WGM, gsz = (nM - fm) < WGM ? (nM - fm) : WGM;
        u.pm = fm + ((wgid % nig) % gsz); u.pn = (wgid % nig) / gsz; return true;
    }
    __device__ __forceinline__ void a_ready(const Unit&) const {}
    __device__ __forceinline__ void done(const Unit&) const {}
};
typedef __bf16 hbf2_t __attribute__((ext_vector_type(2))); typedef float hf2_t __attribute__((ext_vector_type(2)));
__device__ __forceinline__ unsigned cvt_pk_bf16(float lo, float hi) { const hf2_t v = {lo, hi}; const hbf2_t r = __builtin_convertvector(v, hbf2_t); return __builtin_bit_cast(unsigned, r); }
__device__ __forceinline__ float sigm(float x) { return 1.0f / (1.0f + __expf(-x)); }
struct EpiBf16 {
    static constexpr bool PERM = true, AFTER_DRAIN = false;
    bf16_t* O; int ldc;
    __device__ __forceinline__ void operator()(const f32x4 (&acc)[2][2][4][2], const Unit& u, int wr, int wc, int fr, int fq) const {
        const int row0 = u.pm * BM + wr * 64 + fr, col0 = u.pn * BM + wc * 32 + 8 * fq;
#pragma unroll
        for (int ai = 0; ai < 2; ++ai)
#pragma unroll
            for (int m = 0; m < 4; ++m) { bf16_t* rowp = O + (size_t)(row0 + ai * HALF + m * 16) * ldc + col0;
#pragma unroll
                for (int bj = 0; bj < 2; ++bj) { const f32x4 v0 = acc[ai][bj][m][0], v1 = acc[ai][bj][m][1];
                    u32x4 w; w.x = cvt_pk_bf16(v0[0], v0[1]); w.y = cvt_pk_bf16(v0[2], v0[3]); w.z = cvt_pk_bf16(v1[0], v1[1]); w.w = cvt_pk_bf16(v1[2], v1[3]);
                    *(u32x4*)(rowp + bj * HALF) = w; } }
    }
};
struct EpiMemKV {
    static constexpr bool PERM = false, AFTER_DRAIN = false;
    float* Kout; float* Vout;
    __device__ __forceinline__ void operator()(const f32x4 (&acc)[2][2][4][2], const Unit& u, int wr, int wc, int fr, int fq) const {
        const int row0 = u.pm * BM + wr * 64 + fr; int colt = u.pn * BM; float* base = colt < 512 ? Kout : Vout; colt &= 511;
        const int col0 = colt + wc * 32 + 4 * fq;
#pragma unroll
        for (int ai = 0; ai < 2; ++ai)
#pragma unroll
            for (int m = 0; m < 4; ++m) { float* rowp = base + (size_t)(row0 + ai * HALF + m * 16) * 512 + col0;
#pragma unroll
                for (int bj = 0; bj < 2; ++bj)
#pragma unroll
                    for (int n = 0; n < 2; ++n) *(f32x4*)(rowp + bj * HALF + n * 16) = acc[ai][bj][m][n]; }
    }
};
struct EpiLru {
    static constexpr bool PERM = false, AFTER_DRAIN = false;
    const float* ba; const float* bi; const float* lam; const bf16_t* XAC; float* LA; float* LB;
    __device__ __forceinline__ void operator()(const f32x4 (&acc)[2][2][4][2], const Unit& u, int wr, int wc, int fr, int fq) const {
        const int row0 = u.pm * BM + wr * 64 + fr, ch0 = u.pn * HALF + wc * 32 + 4 * fq;
        f32x4 bav[2], biv[2], spv[2];
#pragma unroll
        for (int n = 0; n < 2; ++n) { bav[n] = *(const f32x4*)(ba + ch0 + 16 * n); biv[n] = *(const f32x4*)(bi + ch0 + 16 * n);
            const f32x4 lv = *(const f32x4*)(lam + ch0 + 16 * n);
#pragma unroll
            for (int j = 0; j < 4; ++j) { const float z = -lv[j]; spv[n][j] = (z > 20.f) ? z : log1pf(__expf(z)); } }
#pragma unroll
        for (int ai = 0; ai < 2; ++ai)
#pragma unroll
            for (int m = 0; m < 4; ++m) { const size_t off = (size_t)(row0 + ai * HALF + m * 16) * 512 + ch0;
#pragma unroll
                for (int n = 0; n < 2; ++n) {
                    const f32x4 r = acc[ai][0][m][n] + bav[n], g = acc[ai][1][m][n] + biv[n];
                    const unsigned long long xw = *(const unsigned long long*)(XAC + off + 16 * n);
                    float xv[4]; xv[0] = __uint_as_float((unsigned)(xw & 0xffffu) << 16); xv[1] = __uint_as_float((unsigned)xw & 0xffff0000u);
                    xv[2] = __uint_as_float((unsigned)((xw >> 32) & 0xffffu) << 16); xv[3] = __uint_as_float((unsigned)(xw >> 32) & 0xffff0000u);
                    f32x4 av, bv;
#pragma unroll
                    for (int j = 0; j < 4; ++j) { const float la = -8.0f * sigm(r[j]) * spv[n][j]; av[j] = __expf(la); bv[j] = sqrtf(-expm1f(2.0f * la)) * (sigm(g[j]) * xv[j]); }
                    *(f32x4*)(LA + off + 16 * n) = av; *(f32x4*)(LB + off + 16 * n) = bv; } }
    }
};
struct EpiGate {
    static constexpr bool PERM = true, AFTER_DRAIN = false;
    const float* bias; const bf16_t* T; bf16_t* P;
    __device__ __forceinline__ void operator()(const f32x4 (&acc)[2][2][4][2], const Unit& u, int wr, int wc, int fr, int fq) const {
        const int row0 = u.pm * BM + wr * 64 + fr, col0 = u.pn * BM + wc * 32 + 8 * fq;
        f32x4 bv[2][2];
#pragma unroll
        for (int bj = 0; bj < 2; ++bj)
#pragma unroll
            for (int n = 0; n < 2; ++n) bv[bj][n] = *(const f32x4*)(bias + col0 + bj * HALF + 4 * n);
#pragma unroll
        for (int ai = 0; ai < 2; ++ai)
#pragma unroll
            for (int m = 0; m < 4; ++m) { const size_t off = (size_t)(row0 + ai * HALF + m * 16) * 5120 + col0;
#pragma unroll
                for (int bj = 0; bj < 2; ++bj) { const u32x4 t = *(const u32x4*)(T + off + bj * HALF);
                    const f32x4 v0 = acc[ai][bj][m][0] + bv[bj][0], v1 = acc[ai][bj][m][1] + bv[bj][1];
                    u32x4 w;
                    w.x = cvt_pk_bf16(sigm(v0[0]) * __uint_as_float(t.x << 16), sigm(v0[1]) * __uint_as_float(t.x & 0xffff0000u));
                    w.y = cvt_pk_bf16(sigm(v0[2]) * __uint_as_float(t.y << 16), sigm(v0[3]) * __uint_as_float(t.y & 0xffff0000u));
                    w.z = cvt_pk_bf16(sigm(v1[0]) * __uint_as_float(t.z << 16), sigm(v1[1]) * __uint_as_float(t.z & 0xffff0000u));
                    w.w = cvt_pk_bf16(sigm(v1[2]) * __uint_as_float(t.w << 16), sigm(v1[3]) * __uint_as_float(t.w & 0xffff0000u));
                    *(u32x4*)(P + off + bj * HALF) = w; }
                asm volatile("" ::: "memory"); }
    }
};
struct EpiRes {
    static constexpr bool PERM = false, AFTER_DRAIN = false;
    const float* X; float* Z; int nvalid; float alpha;
    __device__ __forceinline__ void operator()(const f32x4 (&acc)[2][2][4][2], const Unit& u, int wr, int wc, int fr, int fq) const {
        const int row0 = u.pm * BM + wr * 64 + fr, col0 = u.pn * BM + wc * 32 + 4 * fq;
#pragma unroll
        for (int ai = 0; ai < 2; ++ai)
#pragma unroll
            for (int m = 0; m < 4; ++m) { const int row = row0 + ai * HALF + m * 16; const size_t off = (size_t)row * 1024 + col0; const bool rv = row < nvalid;
#pragma unroll
                for (int bj = 0; bj < 2; ++bj)
#pragma unroll
                    for (int n = 0; n < 2; ++n) { f32x4 x = (f32x4){0.f, 0.f, 0.f, 0.f}; if (rv) x = *(const f32x4*)(X + off + bj * HALF + n * 16);
                        *(f32x4*)(Z + off + bj * HALF + n * 16) = x * alpha + acc[ai][bj][m][n]; }
                asm volatile("" ::: "memory"); }
    }
};
struct EpiSwiglu {
    static constexpr bool PERM = true, AFTER_DRAIN = false;
    bf16_t* H;
    __device__ __forceinline__ void operator()(const f32x4 (&acc)[2][2][4][2], const Unit& u, int wr, int wc, int fr, int fq) const {
        const int row0 = u.pm * BM + wr * 64 + fr, col0 = u.pn * HALF + wc * 32 + 8 * fq;
#pragma unroll
        for (int ai = 0; ai < 2; ++ai)
#pragma unroll
            for (int m = 0; m < 4; ++m) { bf16_t* rowp = H + (size_t)(row0 + ai * HALF + m * 16) * 2816 + col0;
                const f32x4 g0 = acc[ai][0][m][0], g1 = acc[ai][0][m][1], v0 = acc[ai][1][m][0], v1 = acc[ai][1][m][1];
                u32x4 w;
                w.x = cvt_pk_bf16(g0[0] * sigm(g0[0]) * v0[0], g0[1] * sigm(g0[1]) * v0[1]);
                w.y = cvt_pk_bf16(g0[2] * sigm(g0[2]) * v0[2], g0[3] * sigm(g0[3]) * v0[3]);
                w.z = cvt_pk_bf16(g1[0] * sigm(g1[0]) * v1[0], g1[1] * sigm(g1[1]) * v1[1]);
                w.w = cvt_pk_bf16(g1[2] * sigm(g1[2]) * v1[2], g1[3] * sigm(g1[3]) * v1[3]);
                *(u32x4*)rowp = w; }
    }
};

template <class Epi, class Sched, bool ALIGN_EPI = false, bool SP2 = false>
__device__ __forceinline__ void gemm_phase(PG8_LAS unsigned char* lds, const Gemm g, const Sched& S, const Epi& E) {
    int tid_ = threadIdx.x; asm volatile("" : "+v"(tid_));
    const int tid = tid_, wid = __builtin_amdgcn_readfirstlane(tid >> 6), lane = tid & 63, wr = wid >> 2, wc = wid & 3, fr = lane & 15, fq = lane >> 4;
    const int K = g.K, nt = K / BK;
    unsigned voffA[2], voffB[2];
#pragma unroll
    for (int i = 0; i < 2; ++i) { int R, C; stage_rc(tid * 16 + i * 8192, R, C); const int Rb = Epi::PERM ? ((R & ~31) + perm32(R & 31)) : R;
        voffA[i] = (unsigned)(R * K + C) * 2u; voffB[i] = (unsigned)(Rb * K + C) * 2u; }
    const size_t kstep = (size_t)(BK * 2);
    const size_t hstep = (size_t)HALF * K * 2;
    const size_t tstep = 2 * hstep;
    const unsigned ldsw = (unsigned)wid * 1024u;
    const int aoff = lds_byte(wr * 64 + fr, fq * 8), boff = lds_byte(wc * 32 + fr, fq * 8);
#define PG8_SA(b, h) (((b) * 2 + (h)) * HTB)
#define PG8_SB(b, h) ((4 + (b) * 2 + (h)) * HTB)
#define PG8_STAGE(bufoff, gbase, voff) do { _Pragma("unroll") for (int _i = 0; _i < 2; ++_i) \
        __builtin_amdgcn_global_load_lds((const unsigned*)((const char*)(gbase) + (voff)[_i]), (PG8_LAS unsigned*)(lds + (bufoff) + ldsw + _i * 8192), 16, 0, 0); } while (0)
#define PG8_LDA(dst, b, h) do { _Pragma("unroll") for (int m = 0; m < 4; ++m) _Pragma("unroll") for (int k = 0; k < 2; ++k) dst[m][k] = *(const PG8_LAS bf16x8*)(lds + PG8_SA(b, h) + aoff + m * 2048 + k * 1024); } while (0)
#define PG8_LDB(dst, b, h) do { _Pragma("unroll") for (int n = 0; n < 2; ++n) _Pragma("unroll") for (int k = 0; k < 2; ++k) dst[n][k] = *(const PG8_LAS bf16x8*)(lds + PG8_SB(b, h) + boff + n * 2048 + k * 1024); } while (0)
#define PG8_MMA(ai, bj, At, Bt) do { __builtin_amdgcn_s_setprio(1); _Pragma("unroll") for (int m = 0; m < 4; ++m) _Pragma("unroll") for (int n = 0; n < 2; ++n) _Pragma("unroll") for (int k = 0; k < 2; ++k) \
        acc[ai][bj][m][n] = __builtin_amdgcn_mfma_f32_16x16x32_bf16(Bt[n][k], At[m][k], acc[ai][bj][m][n], 0, 0, 0); __builtin_amdgcn_s_setprio(0); } while (0)
#define PG8_WAIT_V(n) asm volatile("s_waitcnt vmcnt(" #n ")" ::: "memory")
#define PG8_WAIT_L(n) asm volatile("s_waitcnt lgkmcnt(" #n ")" ::: "memory")
#define PG8_BAR __builtin_amdgcn_s_barrier()
#define PG8_SCHED __builtin_amdgcn_sched_barrier(0)
    Unit cur, nxt; int ui = 0;
    if (!S.next(0, cur)) return;
    f32x4 acc[2][2][4][2];
#pragma unroll
    for (int a = 0; a < 2; ++a)
#pragma unroll
        for (int b = 0; b < 2; ++b)
#pragma unroll
            for (int m = 0; m < 4; ++m)
#pragma unroll
                for (int n = 0; n < 2; ++n) acc[a][b][m][n] = (f32x4){0.f, 0.f, 0.f, 0.f};
    bf16x8 At[4][2], B0[2][2], B1[2][2];
    const char* cA = (const char*)g.A + (size_t)cur.pm * tstep + (g.a_div ? (size_t)(cur.pn / g.a_div) * g.a_stride : (size_t)0); const char* cB = (const char*)g.Bt + (size_t)cur.pn * tstep;
    S.a_ready(cur);
    if constexpr (SP2) {
        PG8_STAGE(PG8_SB(0, 0), cB, voffB); PG8_STAGE(PG8_SB(0, 1), cB + hstep, voffB); PG8_STAGE(PG8_SA(0, 0), cA, voffA); PG8_STAGE(PG8_SA(0, 1), cA + hstep, voffA);
        if (wr == 1) PG8_BAR;
        PG8_WAIT_V(2); PG8_BAR;
        PG8_STAGE(PG8_SB(1, 0), cB + kstep, voffB); PG8_STAGE(PG8_SA(1, 0), cA + kstep, voffA); PG8_STAGE(PG8_SB(1, 1), cB + hstep + kstep, voffB);
        PG8_WAIT_V(6); PG8_BAR;
    } else {
        PG8_STAGE(PG8_SB(0, 0), cB, voffB); PG8_STAGE(PG8_SA(0, 0), cA, voffA); PG8_STAGE(PG8_SB(0, 1), cB + hstep, voffB); PG8_STAGE(PG8_SA(0, 1), cA + hstep, voffA);
        if (wr == 1) PG8_BAR;
        PG8_WAIT_V(4); PG8_BAR;
        PG8_STAGE(PG8_SB(1, 0), cB + kstep, voffB); PG8_STAGE(PG8_SA(1, 0), cA + kstep, voffA); PG8_STAGE(PG8_SB(1, 1), cB + hstep + kstep, voffB);
        PG8_WAIT_V(6); PG8_BAR;
    }
    for (;;) {
        const bool has_next = S.next(ui + 1, nxt);
        const char* nA = has_next ? (const char*)g.A + (size_t)nxt.pm * tstep + (g.a_div ? (size_t)(nxt.pn / g.a_div) * g.a_stride : (size_t)0) : cA; const char* nB = has_next ? (const char*)g.Bt + (size_t)nxt.pn * tstep : cB;
        for (int t = 0; t < nt; t += 2) {
            const bool last = (t == nt - 2);
            const char* a1 = cA + (size_t)(t + 1) * kstep;
            const char* a2 = last ? nA : cA + (size_t)(t + 2) * kstep; const char* b2 = last ? nB : cB + (size_t)(t + 2) * kstep;
            const char* a3 = a2 + kstep; const char* b3 = b2 + kstep;
            if (last && has_next) S.a_ready(nxt);
            if constexpr (SP2) {
            PG8_LDB(B0, 0, 0); PG8_LDB(B1, 0, 1); PG8_SCHED; PG8_LDA(At, 0, 0); PG8_STAGE(PG8_SA(1, 1), a1 + hstep, voffA);
            PG8_WAIT_V(8); PG8_WAIT_L(0); PG8_BAR; PG8_MMA(0, 0, At, B0); PG8_MMA(0, 1, At, B1); PG8_BAR; PG8_SCHED;
            PG8_LDA(At, 0, 1); PG8_STAGE(PG8_SB(0, 0), b2, voffB); PG8_STAGE(PG8_SB(0, 1), b2 + hstep, voffB); PG8_STAGE(PG8_SA(0, 0), a2, voffA);
            PG8_WAIT_V(8); PG8_WAIT_L(0); PG8_BAR; PG8_MMA(1, 0, At, B0); PG8_MMA(1, 1, At, B1); PG8_BAR; PG8_SCHED;
            PG8_LDB(B0, 1, 0); PG8_LDB(B1, 1, 1); PG8_SCHED; PG8_LDA(At, 1, 0); PG8_STAGE(PG8_SA(0, 1), a2 + hstep, voffA);
            PG8_WAIT_V(8); PG8_WAIT_L(0); PG8_BAR; PG8_MMA(0, 0, At, B0); PG8_MMA(0, 1, At, B1); PG8_BAR; PG8_SCHED;
            PG8_LDA(At, 1, 1); PG8_STAGE(PG8_SB(1, 0), b3, voffB); PG8_STAGE(PG8_SB(1, 1), b3 + hstep, voffB); PG8_STAGE(PG8_SA(1, 0), a3, voffA);
            PG8_WAIT_V(8); PG8_WAIT_L(0); PG8_BAR; PG8_MMA(1, 0, At, B0); PG8_MMA(1, 1, At, B1); PG8_BAR; PG8_SCHED;
            } else {
            PG8_LDB(B0, 0, 0); PG8_SCHED; PG8_LDA(At, 0, 0); PG8_STAGE(PG8_SA(1, 1), a1 + hstep, voffA);
            PG8_WAIT_L(8); PG8_BAR; PG8_WAIT_L(0); PG8_MMA(0, 0, At, B0); PG8_BAR; PG8_SCHED;
            PG8_LDB(B1, 0, 1); PG8_STAGE(PG8_SB(0, 0), b2, voffB);
            PG8_BAR; PG8_WAIT_L(0); PG8_MMA(0, 1, At, B1); PG8_BAR;
            PG8_LDA(At, 0, 1); PG8_STAGE(PG8_SA(0, 0), a2, voffA);
            PG8_BAR; PG8_WAIT_L(0); PG8_MMA(1, 0, At, B0); PG8_BAR; PG8_SCHED;
            PG8_STAGE(PG8_SB(0, 1), b2 + hstep, voffB);
            PG8_WAIT_V(6); PG8_BAR; PG8_MMA(1, 1, At, B1); PG8_BAR;
            PG8_LDB(B0, 1, 0); PG8_SCHED; PG8_LDA(At, 1, 0); PG8_STAGE(PG8_SA(0, 1), a2 + hstep, voffA);
            PG8_WAIT_L(8); PG8_BAR; PG8_WAIT_L(0); PG8_MMA(0, 0, At, B0); PG8_BAR; PG8_SCHED;
            PG8_LDB(B1, 1, 1); PG8_STAGE(PG8_SB(1, 0), b3, voffB);
            PG8_BAR; PG8_WAIT_L(0); PG8_MMA(0, 1, At, B1); PG8_BAR;
            PG8_LDA(At, 1, 1); PG8_STAGE(PG8_SA(1, 0), a3, voffA);
            PG8_BAR; PG8_WAIT_L(0); PG8_MMA(1, 0, At, B0); PG8_BAR; PG8_SCHED;
            PG8_STAGE(PG8_SB(1, 1), b3 + hstep, voffB);
            PG8_WAIT_V(6); PG8_BAR; PG8_MMA(1, 1, At, B1); PG8_BAR;
            }
        }
        if constexpr (ALIGN_EPI) { if (wr == 0) PG8_BAR; }
        if constexpr (!Epi::AFTER_DRAIN) { E(acc, cur, wr, wc, fr, fq); S.done(cur); }
        if (!has_next) break;
#pragma unroll
        for (int a = 0; a < 2; ++a)
#pragma unroll
            for (int b = 0; b < 2; ++b)
#pragma unroll
                for (int m = 0; m < 4; ++m)
#pragma unroll
                    for (int n = 0; n < 2; ++n) acc[a][b][m][n] = (f32x4){0.f, 0.f, 0.f, 0.f};
        cur = nxt; cA = nA; cB = nB; ++ui;
        if constexpr (ALIGN_EPI) { if (wr == 1) PG8_BAR; }
    }
    PG8_WAIT_V(0);
    if constexpr (!ALIGN_EPI) { if (wr == 0) PG8_BAR; }
    PG8_BAR;
    if constexpr (Epi::AFTER_DRAIN) { E.fused(acc, cur, wr, wc, fr, fq, lds, wid, lane); S.done(cur); }
#undef PG8_SA
#undef PG8_SB
#undef PG8_STAGE
#undef PG8_LDA
#undef PG8_LDB
#undef PG8_MMA
#undef PG8_WAIT_V
#undef PG8_WAIT_L
#undef PG8_BAR
#undef PG8_SCHED
}
}
#define GAS __attribute__((address_space(1)))
#define LAS __attribute__((address_space(3)))
typedef unsigned short bf16;
typedef unsigned v4u __attribute__((ext_vector_type(4)));
typedef float f32x4 __attribute__((ext_vector_type(4)));
typedef short bf16x8 __attribute__((ext_vector_type(8)));
typedef GAS unsigned gu32;
typedef GAS unsigned long long gu64;
#define RLX_AGENT __ATOMIC_RELAXED, __HIP_MEMORY_SCOPE_AGENT
#define LDS_WAIT() asm volatile("s_waitcnt lgkmcnt(0)" ::: "memory")
#define VM_WAIT() asm volatile("s_waitcnt vmcnt(0)" ::: "memory")
__device__ __forceinline__ unsigned long long rt() { return __builtin_amdgcn_s_memrealtime(); }
__device__ __forceinline__ unsigned f2bf(float f) { unsigned u = __builtin_bit_cast(unsigned, f); return (u + 0x7fffu + ((u >> 16) & 1u)) >> 16; }
__device__ __forceinline__ unsigned pk2(float lo, float hi) { return f2bf(lo) | (f2bf(hi) << 16); }
typedef __bf16 hbf2_t __attribute__((ext_vector_type(2))); typedef float hf2_t __attribute__((ext_vector_type(2)));
__device__ __forceinline__ unsigned cvtpk(float lo, float hi) { const hf2_t v = {lo, hi}; const hbf2_t r = __builtin_convertvector(v, hbf2_t); return __builtin_bit_cast(unsigned, r); }
#define XB_TMO      128
#define XB_XCNT(j)  (256  + 64 * (j))
#define XB_XSUB(j)  (1280 + 64 * (j))
#define XB_XGEN(j)  (2304 + 64 * (j))
#define XB_TOP      3328
#define XB_TOPGEN   3392
#define XCD_BAR_WORDS 3456
#define XB_SPIN_CAP (1u << 18)

__device__ __forceinline__ unsigned xb_ld(unsigned* p)              { return __hip_atomic_load(p, __ATOMIC_RELAXED, __HIP_MEMORY_SCOPE_AGENT); }
__device__ __forceinline__ unsigned xb_add(unsigned* p, unsigned v) { return __hip_atomic_fetch_add(p, v, __ATOMIC_RELAXED, __HIP_MEMORY_SCOPE_AGENT); }
__device__ __forceinline__ unsigned xb_xcc_id() { return (unsigned)__builtin_amdgcn_s_getreg((3 << 11) | 20) & 0xFu; }
#define XB_SPIN(cond, bar) do { unsigned _sp = 0; while (cond) { __builtin_amdgcn_s_sleep(1); \
    if ((++_sp & 255u) == 0u) { if (xb_ld(&(bar)[XB_TMO])) break; if (_sp > XB_SPIN_CAP) { atomicAdd(&(bar)[XB_TMO], 1u); break; } } } } while (0)

struct XcdBarrier {
    unsigned* bar; unsigned x;
    volatile LAS unsigned* st;
};

__device__ __forceinline__ XcdBarrier xcd_barrier_post(unsigned* bar, volatile LAS unsigned* st) {
    XcdBarrier b; b.bar = bar; b.x = xb_xcc_id(); b.st = st;
    if (threadIdx.x == 0) (void)xb_add(&bar[XB_XCNT(b.x)], 1u);
    return b;
}
__device__ __forceinline__ void xcd_barrier_complete(unsigned* bar, unsigned x, unsigned& nloc, unsigned& nx) {
    const unsigned G = gridDim.x * gridDim.y * gridDim.z;
    unsigned sum, cnt, mine, sp = 0u;
    for (;;) {
        sum = 0u; cnt = 0u; mine = 0u;
#pragma unroll
        for (unsigned j = 0; j < 16; ++j) { const unsigned c = xb_ld(&bar[XB_XCNT(j)]); sum += c; cnt += (c > 0u) ? 1u : 0u; mine = (j == x) ? c : mine; }
        if (sum == G) break;
        __builtin_amdgcn_s_sleep(1);
        if ((++sp & 255u) == 0u) { if (xb_ld(&bar[XB_TMO])) break; if (sp > XB_SPIN_CAP) { atomicAdd(&bar[XB_TMO], 1u); break; } }
    }
    nloc = mine > 0u ? mine : 1u; nx = cnt > 0u ? cnt : 1u;
}

__device__ __forceinline__ void xcd_barrier(const XcdBarrier& b) {
    asm volatile("s_waitcnt vmcnt(0)" ::: "memory");
    __syncthreads();
    if (threadIdx.x == 0) {
        unsigned* bar = b.bar;
        __builtin_amdgcn_s_waitcnt(0);
        unsigned nloc = b.st[0], nx = b.st[1];
        if (nloc == 0u) { xcd_barrier_complete(bar, b.x, nloc, nx); b.st[0] = nloc; b.st[1] = nx; }
        const unsigned old = xb_add(&bar[XB_XSUB(b.x)], 1u);
        const unsigned gen = old / nloc;
        if (old + 1u == (gen + 1u) * nloc) {
            __builtin_amdgcn_fence(__ATOMIC_RELEASE, "agent");
            asm volatile("s_waitcnt vmcnt(0)" ::: "memory");
            const unsigned og = xb_add(&bar[XB_TOP], 1u);
            const unsigned tg = og / nx;
            if (og + 1u == (tg + 1u) * nx) xb_add(&bar[XB_TOPGEN], 1u);
            else XB_SPIN(xb_ld(&bar[XB_TOPGEN]) == tg, bar);
            __builtin_amdgcn_fence(__ATOMIC_ACQUIRE, "agent");
            xb_add(&bar[XB_XGEN(b.x)], 1u);
            asm volatile("s_waitcnt vmcnt(0)" ::: "memory");
        } else {
            XB_SPIN(xb_ld(&bar[XB_XGEN(b.x)]) == gen, bar);
            __builtin_amdgcn_fence(__ATOMIC_ACQUIRE, "agent");
            asm volatile("s_waitcnt vmcnt(0)" ::: "memory");
        }
    }
    __syncthreads();
}
constexpr int NWAVES = 8, NTHR = 512;
constexpr int DM = 1024, BATCH = 8, SEQ = 2048, DEPTH = 2, DECB = 128, WBR = 512, NH = 4, HD = 128, NMEM = 256, DFF = 2816;
constexpr int MPR = BATCH * SEQ;
constexpr int MROWS = MPR + DECB;
constexpr int MP = 16640;
constexpr int NIN = 7176, NU = 7168;
constexpr float LN_EPS = 1e-5f, NORM_EPS = 1e-6f, ALPHA = 1.41421356237309515f;
constexpr int U_XA = 0, U_GQ = 512, U_GK = 1024, U_GV = 1536, U_GZ = 2048, U_HQ = 2560, U_HF = 3072, U_HI = 3584, U_HG = 4096, U_RQ = 4608, U_RK = 5120, U_RV = 5632, U_RG = 6144, U_XQ = 6656;
enum { I_XP = 0, I_XS, I_MEM, I_SLRUH, I_SLRUC, I_SGDNC, I_SGDNS, I_SHGRNS, I_SRETS, I_CK, I_CV, I_WIN, I_LCW, I_LCB, I_LWA, I_LBA, I_LWI, I_LBI, I_LLAM,
       I_GCW, I_GALOG, I_GDT, I_GNW, I_HLB, I_HNW, I_RGW, I_RGB, I_WMK, I_WMV, I_WMG, I_BMG, I_WBR, I_WOUT, I_LN1G, I_LN1B, I_WUP, I_WDN, I_LN2G, I_LN2B, N_INPUTS };
constexpr size_t O_YP = 0, O_YS = O_YP + (size_t)MPR * DM, O_PLH = O_YS + (size_t)DECB * DM, O_PLC = O_PLH + 2 * 8 * 512, O_PGC = O_PLC + 2 * 8 * 3 * 512,
    O_PGS = O_PGC + 2 * 8 * 3 * 1536, O_PHS = O_PGS + 2 * 8 * 4 * 16384, O_PRS = O_PHS + 2 * 8 * 4 * 16384, O_PMK = O_PRS + 2 * 8 * 4 * 16384, O_PMV = O_PMK + (size_t)2 * 8 * 256 * 512,
    O_SLH = O_PMV + (size_t)2 * 8 * 256 * 512, O_SLC = O_SLH + 2 * 128 * 512, O_SGC = O_SLC + 2 * 128 * 3 * 512, O_SGS = O_SGC + (size_t)2 * 128 * 3 * 1536,
    O_SHS = O_SGS + (size_t)2 * 128 * 4 * 16384, O_SRS = O_SHS + (size_t)2 * 128 * 4 * 16384, O_END = O_SRS + (size_t)2 * 128 * 4 * 16384;
constexpr size_t WS_CTL = 0, CTL_ZERO_BYTES = 1u << 20;
constexpr size_t SZ_WIN = (size_t)NU * DM * 2, SZ_WKV = (size_t)1024 * DM * 2, SZ_WLRU = (size_t)1024 * 512 * 2, SZ_WG = (size_t)5120 * DM * 2, SZ_WB = (size_t)5 * 1024 * 512 * 2,
    SZ_WO5 = (size_t)1024 * 5120 * 2, SZ_WUP = (size_t)5632 * DM * 2, SZ_WDN = (size_t)1024 * DFF * 2;
constexpr size_t WL_WIN = 0, WL_WKV = WL_WIN + SZ_WIN, WL_WLRU = WL_WKV + SZ_WKV, WL_WG = WL_WLRU + SZ_WLRU, WL_WB = WL_WG + SZ_WG, WL_WO5 = WL_WB + SZ_WB, WL_WUP = WL_WO5 + SZ_WO5,
    WL_WDN = WL_WUP + SZ_WUP, WL_SIZE = WL_WDN + SZ_WDN;
constexpr size_t WS_W = CTL_ZERO_BYTES;
constexpr size_t WS_WBA = WS_W + 2 * WL_SIZE;
constexpr size_t WS_LBV = WS_WBA + 2 * 8 * 1024 * 4;
constexpr size_t WS_ROPE = WS_LBV + 2 * 512 * 4;
constexpr size_t WS_XB = WS_ROPE + (size_t)2 * 2049 * 64 * 4 + 512;
constexpr size_t WS_MB = WS_XB + (size_t)MP * DM * 2;
constexpr size_t WS_KB = WS_MB + (size_t)2048 * DM * 2;
constexpr size_t WS_VT = WS_KB + (size_t)8 * 4 * 256 * 128 * 2;
constexpr size_t WS_BETA = WS_VT + (size_t)8 * 4 * 256 * 128 * 2;
constexpr size_t WS_EG = WS_BETA + (size_t)MP * 4 * 4;
constexpr size_t WS_U = WS_EG + (size_t)MP * 4 * 4;
constexpr size_t WS_R2 = WS_U + (size_t)MP * NU * 2;
constexpr size_t SZ_B512 = (size_t)MP * 512 * 2, SZ_F512 = (size_t)MP * 512 * 4;
constexpr size_t WS_XAC = WS_R2, WS_GQ = WS_XAC + SZ_B512, WS_GK = WS_GQ + SZ_B512, WS_GV = WS_GK + SZ_B512, WS_OG = WS_GV + SZ_B512, WS_OH = WS_OG + SZ_F512, WS_OR = WS_OH + SZ_F512;
static_assert(WS_OR + SZ_F512 == WS_R2 + (size_t)MP * 5120 * 2, "R2 map");
constexpr size_t WS_Z = WS_R2 + (size_t)MP * 5120 * 2;
constexpr size_t WS_LA = WS_Z, WS_LB = WS_Z + SZ_F512;
constexpr size_t WS_Y = WS_Z + (size_t)MP * DM * 4;
constexpr size_t WS_END = WS_Y + (size_t)5 * SZ_B512;
static_assert(WS_XB % 256 == 0 && WS_U % 256 == 0 && WS_R2 % 256 == 0 && WS_Z % 256 == 0 && WS_Y % 256 == 0, "alignment");
constexpr int CW_TMO = 0, CW_CODE = 1, CW_BAR = 4096, CW_QUEUE = 16384;
constexpr int SCR_BYTES = 143360;
constexpr int LDSCTL_OFF = SCR_BYTES, MISC_OFF = LDSCTL_OFF + 320, LDS_BYTES = 147456;
#ifndef PHMASK
#define PHMASK 0xFFFFFFFFu
#endif
#define EN(k) (((PHMASK) >> (k)) & 1u)
__device__ __forceinline__ float bflo(unsigned w) { return __uint_as_float(w << 16); }
__device__ __forceinline__ float bfhi(unsigned w) { return __uint_as_float(w & 0xffff0000u); }
__device__ __forceinline__ float sigm(float x) { return 1.0f / (1.0f + __expf(-x)); }
__device__ __forceinline__ float siluf(float x) { return x * sigm(x); }
__device__ __forceinline__ float softplusf(float x) { return (x > 20.f) ? x : log1pf(__expf(x)); }
__device__ __forceinline__ void unpack8(const v4u w, float (&o)[8]) { o[0] = bflo(w.x); o[1] = bfhi(w.x); o[2] = bflo(w.y); o[3] = bfhi(w.y); o[4] = bflo(w.z); o[5] = bfhi(w.z); o[6] = bflo(w.w); o[7] = bfhi(w.w); }
__device__ __forceinline__ v4u pack8(const float (&o)[8]) { v4u w; w.x = cvtpk(o[0], o[1]); w.y = cvtpk(o[2], o[3]); w.z = cvtpk(o[4], o[5]); w.w = cvtpk(o[6], o[7]); return w; }
__device__ __forceinline__ void ld8bf(const bf16* p, float (&o)[8]) { const v4u w = *(const v4u*)p; unpack8(w, o); }
__device__ __forceinline__ void ld8f(const float* p, float (&o)[8]) { const f32x4 a = *(const f32x4*)p, b = *(const f32x4*)(p + 4); o[0] = a.x; o[1] = a.y; o[2] = a.z; o[3] = a.w; o[4] = b.x; o[5] = b.y; o[6] = b.z; o[7] = b.w; }
__device__ __forceinline__ void st8f(float* p, const float (&o)[8]) { *(f32x4*)p = (f32x4){o[0], o[1], o[2], o[3]}; *(f32x4*)(p + 4) = (f32x4){o[4], o[5], o[6], o[7]}; }
template <int CTRL> __device__ __forceinline__ float dppf(float x) { return __builtin_bit_cast(float, __builtin_amdgcn_update_dpp(0, __builtin_bit_cast(int, x), CTRL, 0xf, 0xf, true)); }
__device__ __forceinline__ float row16_sum(float x) {
    x += dppf<0xB1>(x);
    x += dppf<0x4E>(x);
    x += dppf<0x141>(x);
    x += dppf<0x140>(x);
    return x;
}
__device__ __forceinline__ float wave_sum(float v) {
#pragma unroll
    for (int o = 1; o < 64; o <<= 1) v += __shfl_xor(v, o);
    return v;
}

typedef const float* cfp_t; typedef __attribute__((address_space(4))) const cfp_t* kin_t;
struct Frame {
    LAS unsigned char* lds;
    volatile LAS unsigned* MISC;
    gu32* ctl;
    int tid, lane, wave, vcu, G;
    kin_t in;
    float* out; unsigned char* ws;
};
#define WSP(T, off) ((T*)(F.ws + (off)))
#define INP(i) (F.in[i])

__device__ __forceinline__ void transpose_block(const float* src, int ld, bf16* dst, int ldt, LAS float* scr, int lane) {
#pragma unroll 8
    for (int i = 0; i < 32; ++i) { const int kk = 2 * i + (lane >> 5); scr[kk * 33 + (lane & 31)] = src[(size_t)kk * ld + (lane & 31)]; }
    LDS_WAIT(); asm volatile("" ::: "memory");
    const int c = lane & 7;
#pragma unroll
    for (int j = 0; j < 4; ++j) { const int n = (lane >> 3) + 8 * j; const LAS float* s = scr + (8 * c) * 33 + n;
        v4u o; o.x = pk2(s[0 * 33], s[1 * 33]); o.y = pk2(s[2 * 33], s[3 * 33]); o.z = pk2(s[4 * 33], s[5 * 33]); o.w = pk2(s[6 * 33], s[7 * 33]);
        *(GAS v4u*)(dst + (size_t)n * ldt + 8 * c) = o; }
    LDS_WAIT(); asm volatile("" ::: "memory");
}

__device__ __forceinline__ void p0_prologue(Frame& F) {
    LAS float* scr = (LAS float*)(F.lds + F.wave * 16384);
    const int gw = F.vcu * NWAVES + F.wave, NGW = F.G * NWAVES, lane = F.lane;
    constexpr int IT_IN = 16 * 224, IT_KV = 16 * 32, IT_G = 5 * 16 * 32, IT_B = 5 * 8 * 32, IT_O = 16 * 32, IT_UP = 16 * 176, IT_DN = 44 * 32, IT_LRU = 2 * 4 * 2 * 4;
    constexpr int IT_L = IT_IN + IT_KV + IT_G + IT_B + IT_O + IT_UP + IT_DN + IT_LRU;
#pragma clang loop unroll(disable)
    for (int it = gw; it < 2 * IT_L; it += NGW) {
        const int l = it / IT_L; int r = it % IT_L;
        unsigned char* wl = F.ws + WS_W + (size_t)l * WL_SIZE;
        if (r < IT_IN) { const int kb = r / 224, nb = r % 224, n0 = nb * 32, sc = n0 < 2560 ? n0 : n0 + 8;
            transpose_block(INP(I_WIN) + (size_t)l * DM * NIN + (size_t)(kb * 64) * NIN + sc, NIN, (bf16*)(wl + WL_WIN) + (size_t)n0 * DM + kb * 64, DM, scr, lane); continue; } r -= IT_IN;
        if (r < IT_KV) { const int kb = r / 32, nb = r % 32, n0 = nb * 32; const float* W = (n0 < 512 ? INP(I_WMK) : INP(I_WMV)) + (size_t)l * DM * 512;
            transpose_block(W + (size_t)(kb * 64) * 512 + (n0 & 511), 512, (bf16*)(wl + WL_WKV) + (size_t)n0 * DM + kb * 64, DM, scr, lane); continue; } r -= IT_KV;
        if (r < IT_G) { const int n = r / 512, q = r % 512, kb = q / 32, nb = q % 32;
            transpose_block(INP(I_WMG) + ((size_t)(l * 5 + n) * DM + kb * 64) * DM + nb * 32, DM, (bf16*)(wl + WL_WG) + (size_t)(n * 1024 + nb * 32) * DM + kb * 64, DM, scr, lane); continue; } r -= IT_G;
        if (r < IT_B) { const int n = r / 256, q = r % 256, kb = q / 32, nb = q % 32;
            transpose_block(INP(I_WBR) + ((size_t)(l * 5 + n) * 512 + kb * 64) * DM + nb * 32, DM, (bf16*)(wl + WL_WB) + ((size_t)n * 1024 + nb * 32) * 512 + kb * 64, 512, scr, lane); continue; } r -= IT_B;
        if (r < IT_O) { const int q = r, kb = q / 32, nb = q % 32;
            transpose_block(INP(I_WOUT) + ((size_t)l * DM + kb * 64) * DM + nb * 32, DM, (bf16*)(wl + WL_WO5) + (size_t)(nb * 32) * 1024 + kb * 64, 1024, scr, lane); continue; } r -= IT_O;
        if (r < IT_UP) { const int kb = r / 176, nb = r % 176, c0 = nb * 32, half = c0 >= DFF ? 1 : 0, j0 = c0 - half * DFF, drow = (j0 >> 7) * 256 + half * 128 + (j0 & 127);
            transpose_block(INP(I_WUP) + ((size_t)l * DM + kb * 64) * 5632 + c0, 5632, (bf16*)(wl + WL_WUP) + (size_t)drow * DM + kb * 64, DM, scr, lane); continue; } r -= IT_UP;
        if (r < IT_DN) { const int kb = r / 32, nb = r % 32;
            transpose_block(INP(I_WDN) + ((size_t)l * DFF + kb * 64) * DM + nb * 32, DM, (bf16*)(wl + WL_WDN) + (size_t)(nb * 32) * DFF + kb * 64, DFF, scr, lane); continue; } r -= IT_DN;
        { const int which = r / 32, q = r % 32, h = q / 8, kb = (q % 8) / 4, nb = q % 4;
            const float* W = (which ? INP(I_LWI) : INP(I_LWA)) + ((size_t)(l * 4 + h) * 128 + kb * 64) * 128 + nb * 32;
            transpose_block(W, 128, (bf16*)(wl + WL_WLRU) + (size_t)(h * 256 + which * 128 + nb * 32) * 512 + h * 128 + kb * 64, 512, scr, lane); }
    }
    const size_t gt = (size_t)F.vcu * NTHR + F.tid, GT = (size_t)F.G * NTHR;
#pragma clang loop unroll(disable)
    for (size_t i = gt; i < (size_t)2 * 1024 * 64; i += GT) { const int l = (int)(i / (1024 * 64)), q = (int)(i % (1024 * 64)), row = q / 64, c8 = q % 64, h = row / 256;
        if ((c8 >> 4) != h) *(v4u*)((bf16*)(F.ws + WS_W + (size_t)l * WL_SIZE + WL_WLRU) + (size_t)row * 512 + c8 * 8) = (v4u){0u, 0u, 0u, 0u}; }
#pragma clang loop unroll(disable)
    for (size_t i = gt; i < (size_t)MP * 128; i += GT) { const size_t row = i / 128; const int c = (int)(i % 128) * 8; float v[8] = {0.f, 0.f, 0.f, 0.f, 0.f, 0.f, 0.f, 0.f};
        if (row < MROWS) { ld8f(row < MPR ? INP(I_XP) + row * DM + c : INP(I_XS) + (row - MPR) * DM + c, v); st8f(F.out + row * DM + c, v); }
        *(v4u*)(WSP(bf16, WS_XB) + row * DM + c) = pack8(v); }
#pragma clang loop unroll(disable)
    for (size_t i = gt; i < (size_t)2048 * 128; i += GT) { float v[8]; ld8f(INP(I_MEM) + i * 8, v); *(v4u*)(WSP(bf16, WS_MB) + i * 8) = pack8(v); }
#pragma clang loop unroll(disable)
    for (size_t i = gt; i < (size_t)2 * 8 * 1024; i += GT) { const int l = (int)(i / 8192), c = (int)(i / 1024) % 8, k = (int)(i % 1024); WSP(float, WS_WBA)[i] = INP(I_WIN)[((size_t)l * DM + k) * NIN + 2560 + c]; }
#pragma clang loop unroll(disable)
    for (size_t i = gt; i < 512; i += GT) { const float r0 = INP(I_HLB)[i], r1 = INP(I_HLB)[512 + i], mx = fmaxf(r0, r1), e0 = expf(r0 - mx), e1 = expf(r1 - mx);
        WSP(float, WS_LBV)[i] = 0.f; WSP(float, WS_LBV)[512 + i] = e1 / (e0 + e1); }
#pragma clang loop unroll(disable)
    for (size_t i = gt; i < (size_t)2049 * 64; i += GT) { const int p = (int)(i / 64), j = (int)(i % 64); const double pos = p < 2048 ? (double)p : 16384.0;
        const double inv = exp2(-(double)j * (13.287712379549449 / 64.0)); const double ang = pos * inv;
        WSP(float, WS_ROPE)[i] = (float)cos(ang); WSP(float, WS_ROPE)[(size_t)2049 * 64 + i] = (float)sin(ang); }
}
__device__ __forceinline__ void p2_prepass(Frame& F, int l) {
    const int gw = F.vcu * NWAVES + F.wave, NGW = F.G * NWAVES, lane = F.lane, c8 = lane * 8;
    bf16* U = WSP(bf16, WS_U);
    const float* ropec = WSP(float, WS_ROPE); const float* ropes = ropec + 2049 * 64;
#pragma clang loop unroll(disable)
    for (int m = gw; m < MROWS; m += NGW) {
        const bool prompt = m < MPR; const int b = m >> 11, t = m & 2047, s = m - MPR;
        bf16* urow = U + (size_t)m * NU;
        {   const float* xr = F.out + (size_t)m * DM; const float* wb = WSP(float, WS_WBA) + (size_t)l * 8 * 1024;
            float d[8];
#pragma unroll
            for (int c = 0; c < 8; ++c) d[c] = 0.f;
#pragma unroll
            for (int j = 0; j < 4; ++j) { const f32x4 xv = *(const f32x4*)(xr + 4 * lane + 256 * j);
#pragma unroll
                for (int c = 0; c < 8; ++c) { const f32x4 wv = *(const f32x4*)(wb + c * 1024 + 4 * lane + 256 * j); d[c] += (xv.x * wv.x + xv.y * wv.y) + (xv.z * wv.z + xv.w * wv.w); } }
#pragma unroll
            for (int c = 0; c < 8; ++c) d[c] = wave_sum(d[c]);
            if (lane < 4) { const float db = lane == 0 ? d[0] : lane == 1 ? d[1] : lane == 2 ? d[2] : d[3], da = lane == 0 ? d[4] : lane == 1 ? d[5] : lane == 2 ? d[6] : d[7];
                const float g = -expf(INP(I_GALOG)[l * 4 + lane]) * softplusf(da + INP(I_GDT)[l * 4 + lane]);
                WSP(float, WS_BETA)[(size_t)m * 4 + lane] = sigm(db); WSP(float, WS_EG)[(size_t)m * 4 + lane] = g; } }
        {   float x0[8], x1[8], x2[8], x3[8];
            ld8bf(urow + U_XA + c8, x3);
            if (prompt) {
                if (t >= 1) ld8bf(urow - NU + U_XA + c8, x2); else { for (int e = 0; e < 8; ++e) x2[e] = 0.f; }
                if (t >= 2) ld8bf(urow - 2 * NU + U_XA + c8, x1); else { for (int e = 0; e < 8; ++e) x1[e] = 0.f; }
                if (t >= 3) ld8bf(urow - 3 * NU + U_XA + c8, x0); else { for (int e = 0; e < 8; ++e) x0[e] = 0.f; }
                if (t >= SEQ - 3) st8f(F.out + O_PLC + ((size_t)(l * 8 + b) * 3 + (t - (SEQ - 3))) * 512 + c8, x3);
            } else {
                const float* sb = INP(I_SLRUC) + ((size_t)(l * DECB + s) * 3) * 512 + c8;
                ld8f(sb, x0); ld8f(sb + 512, x1); ld8f(sb + 1024, x2);
                float* so = F.out + O_SLC + ((size_t)(l * DECB + s) * 3) * 512 + c8;
                st8f(so, x1); st8f(so + 512, x2); st8f(so + 1024, x3);
            }
            float w0[8], w1[8], w2[8], w3[8], bb[8], o[8];
            const float* cw = INP(I_LCW) + (size_t)l * 4 * 512 + c8;
            ld8f(cw, w0); ld8f(cw + 512, w1); ld8f(cw + 1024, w2); ld8f(cw + 1536, w3); ld8f(INP(I_LCB) + l * 512 + c8, bb);
#pragma unroll
            for (int e = 0; e < 8; ++e) o[e] = w0[e] * x0[e] + w1[e] * x1[e] + w2[e] * x2[e] + w3[e] * x3[e] + bb[e];
            *(v4u*)(WSP(bf16, WS_XAC) + (size_t)m * 512 + c8) = pack8(o); }
#pragma unroll 1
        for (int grp = 0; grp < 3; ++grp) {
            const int cu = U_GQ + grp * 512 + c8, cc = grp * 512 + c8;
            float x0[8], x1[8], x2[8], x3[8];
            ld8bf(urow + cu, x3);
            if (prompt) {
                if (t >= 1) ld8bf(urow - NU + cu, x2); else { for (int e = 0; e < 8; ++e) x2[e] = 0.f; }
                if (t >= 2) ld8bf(urow - 2 * NU + cu, x1); else { for (int e = 0; e < 8; ++e) x1[e] = 0.f; }
                if (t >= 3) ld8bf(urow - 3 * NU + cu, x0); else { for (int e = 0; e < 8; ++e) x0[e] = 0.f; }
                if (t >= SEQ - 3) st8f(F.out + O_PGC + ((size_t)(l * 8 + b) * 3 + (t - (SEQ - 3))) * 1536 + cc, x3);
            } else {
                const float* sb = INP(I_SGDNC) + ((size_t)(l * DECB + s) * 3) * 1536 + cc;
                ld8f(sb, x0); ld8f(sb + 1536, x1); ld8f(sb + 3072, x2);
                float* so = F.out + O_SGC + ((size_t)(l * DECB + s) * 3) * 1536 + cc;
                st8f(so, x1); st8f(so + 1536, x2); st8f(so + 3072, x3);
            }
            float w0[8], w1[8], w2[8], w3[8], o[8];
            const float* cw = INP(I_GCW) + (size_t)l * 4 * 1536 + cc;
            ld8f(cw, w0); ld8f(cw + 1536, w1); ld8f(cw + 3072, w2); ld8f(cw + 4608, w3);
            float ss = 0.f;
#pragma unroll
            for (int e = 0; e < 8; ++e) { const float v = w0[e] * x0[e] + w1[e] * x1[e] + w2[e] * x2[e] + w3[e] * x3[e]; o[e] = siluf(v); ss += o[e] * o[e]; }
            if (grp < 2) { ss = row16_sum(ss); const float sc = rsqrtf(ss + NORM_EPS) * (grp == 0 ? 0.08838834764831845f : 1.0f);
#pragma unroll
                for (int e = 0; e < 8; ++e) o[e] *= sc; }
            bf16* dst = grp == 0 ? WSP(bf16, WS_GQ) : grp == 1 ? WSP(bf16, WS_GK) : WSP(bf16, WS_GV);
            *(v4u*)(dst + (size_t)m * 512 + c8) = pack8(o);
        }
        {   float q[8], f[8], lb[8]; ld8bf(urow + U_HQ + c8, q); ld8bf(urow + U_HF + c8, f); ld8f(WSP(float, WS_LBV) + l * 512 + c8, lb);
#pragma unroll
            for (int e = 0; e < 8; ++e) { q[e] = siluf(q[e]); f[e] = lb[e] + (1.0f - lb[e]) * sigm(f[e]); }
            *(v4u*)(urow + U_HQ + c8) = pack8(q); *(v4u*)(urow + U_HF + c8) = pack8(f); }
        {   const int ti = prompt ? t : 2048, jj = (lane & 7) * 8; const bool hi = (lane & 8) != 0;
            float cs[8], sn[8]; ld8f(ropec + (size_t)ti * 64 + jj, cs); ld8f(ropes + (size_t)ti * 64 + jj, sn);
#pragma unroll 1
            for (int w = 0; w < 2; ++w) { const int cu = (w ? U_RK : U_RQ) + c8; const float sc = w ? 0.08838834764831845f : 1.0f;
                float x[8], o[8]; ld8bf(urow + cu, x);
#pragma unroll
                for (int e = 0; e < 8; ++e) { const float other = __shfl_xor(x[e], 8); o[e] = (hi ? (x[e] * cs[e] + other * sn[e]) : (x[e] * cs[e] - other * sn[e])) * sc; }
                *(v4u*)(urow + cu) = pack8(o); } }
    }
    {   const size_t gt = (size_t)F.vcu * NTHR + F.tid, GT = (size_t)F.G * NTHR;
        const float* mk = F.out + O_PMK + (size_t)l * 8 * 256 * 512; const float* mv = F.out + O_PMV + (size_t)l * 8 * 256 * 512;
#pragma clang loop unroll(disable)
        for (size_t i = gt; i < (size_t)8 * 4 * 256 * 16; i += GT) { const int d8 = (int)(i % 16), mm = (int)(i / 16) % 256, h = (int)(i / 4096) % 4, b = (int)(i / 16384);
            float v[8]; ld8f(mk + ((size_t)(b * 256 + mm) * 4 + h) * 128 + d8 * 8, v); *(v4u*)(WSP(bf16, WS_KB) + (((size_t)(b * 4 + h) * 256 + mm) * 128 + d8 * 8)) = pack8(v); }
#pragma clang loop unroll(disable)
        for (size_t i = gt; i < (size_t)8 * 4 * 128 * 32; i += GT) { const int m8 = (int)(i % 32), d = (int)(i / 32) % 128, h = (int)(i / 4096) % 4, b = (int)(i / 16384);
            float v[8];
#pragma unroll
            for (int e = 0; e < 8; ++e) v[e] = mv[((size_t)(b * 256 + m8 * 8 + e) * 4 + h) * 128 + d];
            *(v4u*)(WSP(bf16, WS_VT) + (((size_t)(b * 4 + h) * 128 + d) * 256 + m8 * 8)) = pack8(v); }
    }
}
constexpr int SQ_A = 0, SQ_Q = 16384, SQ_V = 32768, SQ_SC = 36864, SQ_BUF = 37376, SQ_O = 2 * SQ_BUF, SQ_OBYTES = 8192;
struct SeqArgs { const bf16* A; const bf16* Q; const bf16* V; int lda, ldq, ldv; const float* beta; const float* eg; float gamma; const float* S0; float* Sout; float* O; int T; int vs0, vs1; };
template <int TYPE>
__device__ __forceinline__ void seq_unit(Frame& F, const SeqArgs& a) {
    LAS unsigned char* lds = F.lds;
    const int tid = F.tid, lane = F.lane, kg = lane & 15, v = 4 * F.wave + (lane >> 4);
    const int nch = (a.T + 63) >> 6;
    for (int vs = a.vs0; vs < a.vs1; ++vs) {
        const int v0 = vs * 32;
        float S[8];
#pragma unroll
        for (int i = 0; i < 8; ++i) S[i] = a.S0 ? a.S0[(size_t)(8 * kg + i) * 128 + v0 + v] : 0.f;
        v4u ra0 = (v4u){0u,0u,0u,0u}, ra1 = ra0, rq0 = ra0, rq1 = ra0, rv = ra0; float rsb = 0.f, rse = 0.f;
#define SQ_GLOAD(c_) do { const int t0 = (c_) * 64; \
            { const int p = tid, row = p >> 4, cc = p & 15; const bool ok = t0 + row < a.T; \
              ra0 = ok ? *(const v4u*)(a.A + (size_t)(t0 + row) * a.lda + cc * 8) : (v4u){0u, 0u, 0u, 0u}; rq0 = ok ? *(const v4u*)(a.Q + (size_t)(t0 + row) * a.ldq + cc * 8) : (v4u){0u, 0u, 0u, 0u}; } \
            { const int p = tid + 512, row = p >> 4, cc = p & 15; const bool ok = t0 + row < a.T; \
              ra1 = ok ? *(const v4u*)(a.A + (size_t)(t0 + row) * a.lda + cc * 8) : (v4u){0u, 0u, 0u, 0u}; rq1 = ok ? *(const v4u*)(a.Q + (size_t)(t0 + row) * a.ldq + cc * 8) : (v4u){0u, 0u, 0u, 0u}; } \
            if (tid < 256) { const int row = tid >> 2, cc = tid & 3; rv = (t0 + row < a.T) ? *(const v4u*)(a.V + (size_t)(t0 + row) * a.ldv + v0 + cc * 8) : (v4u){0u, 0u, 0u, 0u}; } \
            if (TYPE == 0 && tid >= 256 && tid < 320) { const int row = tid - 256; if (t0 + row < a.T) { rsb = a.beta[(size_t)(t0 + row) * 4]; rse = __expf(a.eg[(size_t)(t0 + row) * 4]); } else { rsb = 0.f; rse = 1.f; } } } while (0)
#define SQ_LSTORE(buf_) do { LAS unsigned char* B_ = lds + (buf_) * SQ_BUF; \
            *(LAS v4u*)(B_ + SQ_A + tid * 16) = ra0; *(LAS v4u*)(B_ + SQ_A + (tid + 512) * 16) = ra1; \
            *(LAS v4u*)(B_ + SQ_Q + tid * 16) = rq0; *(LAS v4u*)(B_ + SQ_Q + (tid + 512) * 16) = rq1; \
            if (tid < 256) *(LAS v4u*)(B_ + SQ_V + tid * 16) = rv; \
            if (TYPE == 0 && tid >= 256 && tid < 320) { ((LAS float*)(B_ + SQ_SC))[(tid - 256) * 2] = rsb; ((LAS float*)(B_ + SQ_SC))[(tid - 256) * 2 + 1] = rse; } } while (0)
        SQ_GLOAD(0); SQ_LSTORE(0);
        __syncthreads();
        for (int c = 0; c < nch; ++c) {
            const int buf = c & 1;
            if (c + 1 < nch) SQ_GLOAD(c + 1);
            const LAS unsigned char* B = lds + buf * SQ_BUF;
            LAS float* Ob = (LAS float*)(lds + SQ_O + buf * SQ_OBYTES);
            const int n = (a.T - c * 64) < 64 ? (a.T - c * 64) : 64;
#pragma unroll 4
            for (int tt = 0; tt < n; ++tt) {
                float kk[8], qq[8];
                unpack8(*(const LAS v4u*)(B + SQ_A + tt * 256 + kg * 16), kk);
                unpack8(*(const LAS v4u*)(B + SQ_Q + tt * 256 + kg * 16), qq);
                const float vv = __uint_as_float((unsigned)(*(const LAS unsigned short*)(B + SQ_V + tt * 64 + v * 2)) << 16);
                if (TYPE == 0) {
                    const float be = ((const LAS float*)(B + SQ_SC))[tt * 2], eg = ((const LAS float*)(B + SQ_SC))[tt * 2 + 1];
                    float ks = (kk[0] * S[0] + kk[1] * S[1]) + (kk[2] * S[2] + kk[3] * S[3]) + ((kk[4] * S[4] + kk[5] * S[5]) + (kk[6] * S[6] + kk[7] * S[7]));
                    ks = row16_sum(ks);
                    const float uu = be * (vv - eg * ks);
#pragma unroll
                    for (int i = 0; i < 8; ++i) S[i] = eg * S[i] + kk[i] * uu;
                } else if (TYPE == 1) {
#pragma unroll
                    for (int i = 0; i < 8; ++i) S[i] = kk[i] * S[i] + (1.0f - kk[i]) * vv;
                } else {
#pragma unroll
                    for (int i = 0; i < 8; ++i) S[i] = a.gamma * S[i] + kk[i] * vv;
                }
                float o = (qq[0] * S[0] + qq[1] * S[1]) + (qq[2] * S[2] + qq[3] * S[3]) + ((qq[4] * S[4] + qq[5] * S[5]) + (qq[6] * S[6] + qq[7] * S[7]));
                o = row16_sum(o);
                if (kg == 0) Ob[tt * 32 + v] = o;
            }
            if (c + 1 < nch) SQ_LSTORE(buf ^ 1);
            __syncthreads();
            { const int row = tid >> 3, c4 = tid & 7; if (c * 64 + row < a.T) *(f32x4*)(a.O + (size_t)(c * 64 + row) * 512 + v0 + c4 * 4) = *(const LAS f32x4*)((const LAS unsigned char*)Ob + row * 128 + c4 * 16); }
        }
#pragma unroll
        for (int i = 0; i < 8; ++i) a.Sout[(size_t)(8 * kg + i) * 128 + v0 + v] = S[i];
        __syncthreads();
    }
}

__device__ __forceinline__ void lru_scan_unit(Frame& F, int l, int b, int cg) {
    const int tid = F.tid, seg = tid >> 5, ch = cg * 32 + (tid & 31);
    const float* LA = WSP(float, WS_LA) + ((size_t)(b * SEQ + seg * 128)) * 512 + ch; const float* LB = WSP(float, WS_LB) + ((size_t)(b * SEQ + seg * 128)) * 512 + ch;
    LAS float* car = (LAS float*)F.lds;
    float A = 1.f, Bc = 0.f;
#pragma unroll 8
    for (int t = 0; t < 128; ++t) { const float av = LA[(size_t)t * 512], bv = LB[(size_t)t * 512]; Bc = av * Bc + bv; A *= av; }
    car[(seg * 32 + (tid & 31)) * 2] = A; car[(seg * 32 + (tid & 31)) * 2 + 1] = Bc;
    __syncthreads();
    float h = 0.f;
    for (int s2 = 0; s2 < seg; ++s2) h = car[(s2 * 32 + (tid & 31)) * 2] * h + car[(s2 * 32 + (tid & 31)) * 2 + 1];
    bf16* Y = WSP(bf16, WS_Y) + ((size_t)(b * SEQ + seg * 128)) * 512 + ch;
#pragma unroll 8
    for (int t = 0; t < 128; ++t) { const float av = LA[(size_t)t * 512], bv = LB[(size_t)t * 512]; h = av * h + bv; Y[(size_t)t * 512] = (bf16)f2bf(h); }
    if (seg == 15) F.out[O_PLH + (size_t)(l * 8 + b) * 512 + ch] = h;
    __syncthreads();
}

constexpr int XK_STRIDE = 272, XV_STRIDE = 528, XV_OFF = 256 * XK_STRIDE;
static_assert(XV_OFF + 128 * XV_STRIDE <= SCR_BYTES, "cross-attention LDS");
__device__ __forceinline__ void cross_prompt_unit(Frame& F, int b, int h, int tb) {
    LAS unsigned char* lds = F.lds; const int tid = F.tid, lane = F.lane, g = lane >> 4, lr = lane & 15;
    const bf16* Kb = WSP(bf16, WS_KB) + (size_t)(b * 4 + h) * 256 * 128; const bf16* Vt = WSP(bf16, WS_VT) + (size_t)(b * 4 + h) * 128 * 256;
#pragma unroll
    for (int i = 0; i < 8; ++i) { const int p = tid + 512 * i, row = p >> 4, c = p & 15; *(LAS v4u*)(lds + row * XK_STRIDE + c * 16) = *(const v4u*)(Kb + (size_t)row * 128 + c * 8); }
#pragma unroll
    for (int i = 0; i < 8; ++i) { const int p = tid + 512 * i, row = p >> 5, c = p & 31; *(LAS v4u*)(lds + XV_OFF + row * XV_STRIDE + c * 16) = *(const v4u*)(Vt + (size_t)row * 256 + c * 8); }
    __syncthreads();
    const bf16* U = WSP(bf16, WS_U); bf16* Y4 = WSP(bf16, WS_Y) + (size_t)4 * MP * 512;
    typedef float f4 __attribute__((ext_vector_type(4)));
#pragma unroll 1
    for (int gi = 0; gi < 4; ++gi) {
        const int m0 = b * SEQ + tb * 512 + (F.wave + 8 * gi) * 16;
        bf16x8 qf[4];
#pragma unroll
        for (int ks = 0; ks < 4; ++ks) qf[ks] = *(const bf16x8*)(U + (size_t)(m0 + lr) * NU + U_XQ + h * 128 + 32 * ks + 8 * g);
        f4 st[16];
#pragma unroll
        for (int mt = 0; mt < 16; ++mt) { f4 acc = (f4){0.f, 0.f, 0.f, 0.f};
#pragma unroll
            for (int ks = 0; ks < 4; ++ks) { const bf16x8 af = *(const LAS bf16x8*)(lds + (16 * mt + lr) * XK_STRIDE + (32 * ks + 8 * g) * 2); acc = __builtin_amdgcn_mfma_f32_16x16x32_bf16(af, qf[ks], acc, 0, 0, 0); }
            st[mt] = acc; __builtin_amdgcn_sched_barrier(0); }
        float mx = -3.0e38f;
#pragma unroll
        for (int mt = 0; mt < 16; ++mt) mx = fmaxf(mx, fmaxf(fmaxf(st[mt][0], st[mt][1]), fmaxf(st[mt][2], st[mt][3])));
        mx = fmaxf(mx, __shfl_xor(mx, 16)); mx = fmaxf(mx, __shfl_xor(mx, 32));
        const float sc = 0.08838834764831845f; float sum = 0.f;
#pragma unroll
        for (int mt = 0; mt < 16; ++mt)
#pragma unroll
            for (int r = 0; r < 4; ++r) { const float p = __expf((st[mt][r] - mx) * sc); st[mt][r] = p; sum += p; }
        sum += __shfl_xor(sum, 16); sum += __shfl_xor(sum, 32);
        const float inv = 1.0f / sum;
        bf16x8 pf[8];
#pragma unroll
        for (int k2 = 0; k2 < 8; ++k2) { v4u w; w.x = pk2(st[2 * k2][0], st[2 * k2][1]); w.y = pk2(st[2 * k2][2], st[2 * k2][3]); w.z = pk2(st[2 * k2 + 1][0], st[2 * k2 + 1][1]); w.w = pk2(st[2 * k2 + 1][2], st[2 * k2 + 1][3]);
            pf[k2] = __builtin_bit_cast(bf16x8, w); }
#pragma unroll
        for (int dt = 0; dt < 8; ++dt) { f4 acc = (f4){0.f, 0.f, 0.f, 0.f};
#pragma unroll
            for (int k2 = 0; k2 < 8; ++k2) { const LAS unsigned char* vp = lds + XV_OFF + (16 * dt + lr) * XV_STRIDE + (32 * k2 + 4 * g) * 2;
                const unsigned long long lo = *(const LAS unsigned long long*)vp, hi = *(const LAS unsigned long long*)(vp + 32);
                v4u w; w.x = (unsigned)lo; w.y = (unsigned)(lo >> 32); w.z = (unsigned)hi; w.w = (unsigned)(hi >> 32);
                acc = __builtin_amdgcn_mfma_f32_16x16x32_bf16(__builtin_bit_cast(bf16x8, w), pf[k2], acc, 0, 0, 0); }
            unsigned long long o = (unsigned long long)pk2(acc[0] * inv, acc[1] * inv) | ((unsigned long long)pk2(acc[2] * inv, acc[3] * inv) << 32);
            *(unsigned long long*)(Y4 + (size_t)(m0 + lr) * 512 + h * 128 + 16 * dt + 4 * g) = o; __builtin_amdgcn_sched_barrier(0); }
    }
    __syncthreads();
}

__device__ __forceinline__ void cross_sample_unit(Frame& F, int l, int s, int h) {
    const int tid = F.tid; LAS float* sm = (LAS float*)F.lds;
    const bf16* U = WSP(bf16, WS_U);
    if (tid < 128) sm[tid] = bflo((unsigned)U[(size_t)(MPR + s) * NU + U_XQ + h * 128 + tid]);
    __syncthreads();
    const float* K = INP(I_CK) + (((size_t)(l * DECB + s) * 256) * 4 + h) * 128; const float* V = INP(I_CV) + (((size_t)(l * DECB + s) * 256) * 4 + h) * 128;
    { const int mm = tid >> 1, hf = tid & 1; const float* kr = K + (size_t)mm * 512 + hf * 64; float d = 0.f;
#pragma unroll
      for (int j = 0; j < 16; ++j) { const f32x4 kv = *(const f32x4*)(kr + 4 * j); const LAS float* q = sm + hf * 64 + 4 * j; d += (kv.x * q[0] + kv.y * q[1]) + (kv.z * q[2] + kv.w * q[3]); }
      d += __shfl_xor(d, 1);
      if (hf == 0) sm[128 + mm] = d * 0.08838834764831845f; }
    __syncthreads();
    float mx = -3.0e38f;
    for (int j = 0; j < 256; ++j) mx = fmaxf(mx, sm[128 + j]);
    float sum = 0.f;
    for (int j = 0; j < 256; ++j) sum += __expf(sm[128 + j] - mx);
    { const int d = tid & 127, q4 = tid >> 7; float o = 0.f;
#pragma unroll 8
      for (int j = 0; j < 64; ++j) { const int mm = q4 * 64 + j; o += __expf(sm[128 + mm] - mx) * V[(size_t)mm * 512 + d]; }
      sm[384 + q4 * 128 + d] = o; }
    __syncthreads();
    if (tid < 128) { const float o = (sm[384 + tid] + sm[512 + tid]) + (sm[640 + tid] + sm[768 + tid]);
        WSP(bf16, WS_Y)[(size_t)4 * MP * 512 + (size_t)(MPR + s) * 512 + h * 128 + tid] = (bf16)f2bf(o / sum); }
    __syncthreads();
}

__device__ __forceinline__ size_t blk_off(int ld, int r, int j) { return (size_t)(r >> 3) * ld + (r & 7) * 16 + j; }
constexpr int CP_ROW = 272, CP_WAVE = 10240;
constexpr size_t WS_AQK = WS_END;
constexpr size_t WS_DEC = WS_AQK + (size_t)3 * 4096 * 256 * 2;
constexpr size_t WS_DG = WS_DEC + (size_t)4096 * 128 * 4;
constexpr size_t WS_END2 = WS_DG + 4096 * 4;
template <int BR>
__device__ __forceinline__ void p3b_chunkprep_br(Frame& F, int l) {
    constexpr int br = BR;
    const int gw = F.vcu * NWAVES + F.wave, NGW = F.G * NWAVES, lane = F.lane, g = lane >> 4, lr = lane & 15;
    LAS unsigned char* wl = F.lds + F.wave * CP_WAVE;
    LAS float* akk = (LAS float*)(wl + 8704); LAS float* Gs = (LAS float*)(wl + 9728); LAS float* Bs = (LAS float*)(wl + 9792);
    bf16* U = WSP(bf16, WS_U);
#pragma clang loop unroll(disable)
    for (int it = gw; it < 4096; it += NGW) {
        const int q = it, b = q >> 9, c = (q >> 2) & 127, h = q & 3;
        const size_t m0 = (size_t)b * SEQ + c * 16; const int blk = (b * 128 + c) * 4 + h;
        bf16 *pq, *pk, *pv; constexpr int ld = (BR == 0) ? 512 : NU;
        if (br == 0) { pq = WSP(bf16, WS_GQ) + m0 * 512 + h * 128; pk = WSP(bf16, WS_GK) + m0 * 512 + h * 128; pv = WSP(bf16, WS_GV) + m0 * 512 + h * 128; }
        else if (br == 1) { pq = U + m0 * NU + U_HQ + h * 128; pk = U + m0 * NU + U_HF + h * 128; pv = U + m0 * NU + U_HI + h * 128; }
        else { pq = U + m0 * NU + U_RQ + h * 128; pk = U + m0 * NU + U_RK + h * 128; pv = U + m0 * NU + U_RV + h * 128; }
        float qv[16][2], kv[16][2], vv[16][2];
        bf16* pql = pq + 2 * lane; const bf16* pkl = pk + 2 * lane; const bf16* pvl = pv + 2 * lane; asm volatile("" : "+v"(pql), "+v"(pkl), "+v"(pvl));
#pragma unroll
        for (int j = 0; j < 16; ++j) { const unsigned wq = *(const unsigned*)(pql + (size_t)j * ld), wk = *(const unsigned*)(pkl + (size_t)j * ld), wv = *(const unsigned*)(pvl + (size_t)j * ld);
            qv[j][0] = bflo(wq); qv[j][1] = bfhi(wq); kv[j][0] = bflo(wk); kv[j][1] = bfhi(wk); vv[j][0] = bflo(wv); vv[j][1] = bfhi(wv); }
        asm volatile("s_waitcnt vmcnt(0)" ::: "memory");
        float Gt[16];
        float bet[16];
        if (br == 0) { float acc = 0.f;
#pragma unroll
            for (int j = 0; j < 16; ++j) { float gj = WSP(float, WS_EG)[(m0 + j) * 4 + h], bj = WSP(float, WS_BETA)[(m0 + j) * 4 + h]; asm volatile("" : "+v"(gj), "+v"(bj));
                acc += gj; Gt[j] = acc; bet[j] = bj; } }
        else if (br == 2) { float lg = logf(1.0f - exp2f(-5.0f - (float)h)); asm volatile("" : "+v"(lg));
#pragma unroll
            for (int j = 0; j < 16; ++j) { Gt[j] = (float)(j + 1) * lg; bet[j] = 0.f; } }
        else {
#pragma unroll
            for (int j = 0; j < 16; ++j) { Gt[j] = 0.f; bet[j] = 0.f; } }
        if (br == 1) {
            float G0[16], G1[16]; float a0 = 0.f, a1 = 0.f;
#pragma unroll
            for (int j = 0; j < 16; ++j) { a0 += __logf(fmaxf(kv[j][0], 1e-30f)); a1 += __logf(fmaxf(kv[j][1], 1e-30f)); G0[j] = a0; G1[j] = a1; }
            const float mid0 = G0[7], mid1 = G1[7], e0 = G0[15], e1 = G1[15];
            unsigned ket0[8], ket1[8], vt0[8], vt1[8];
#pragma unroll
            for (int j = 0; j < 16; ++j) { const float k0 = 1.0f - kv[j][0], k1 = 1.0f - kv[j][1];
                *(LAS unsigned*)(wl + j * CP_ROW + 4 * lane) = pk2(k0 * __expf(mid0 - G0[j]), k1 * __expf(mid1 - G1[j]));
                *(LAS unsigned*)(wl + 4352 + j * CP_ROW + 4 * lane) = pk2(qv[j][0] * __expf(G0[j] - mid0), qv[j][1] * __expf(G1[j] - mid1));
                *(unsigned*)(pql + (size_t)j * ld) = pk2(qv[j][0] * __expf(G0[j]), qv[j][1] * __expf(G1[j]));
                const float t0 = k0 * __expf(e0 - G0[j]), t1 = k1 * __expf(e1 - G1[j]);
                if (j & 1) { ket0[j >> 1] |= f2bf(t0) << 16; ket1[j >> 1] |= f2bf(t1) << 16; vt0[j >> 1] |= f2bf(vv[j][0]) << 16; vt1[j >> 1] |= f2bf(vv[j][1]) << 16; }
                else { ket0[j >> 1] = f2bf(t0); ket1[j >> 1] = f2bf(t1); vt0[j >> 1] = f2bf(vv[j][0]); vt1[j >> 1] = f2bf(vv[j][1]); } }
            { bf16* d = pk + blk_off(ld, 2 * lane, 0); *(v4u*)d = (v4u){ket0[0], ket0[1], ket0[2], ket0[3]}; *(v4u*)(d + 8) = (v4u){ket0[4], ket0[5], ket0[6], ket0[7]};
              *(v4u*)(d + 16) = (v4u){ket1[0], ket1[1], ket1[2], ket1[3]}; *(v4u*)(d + 24) = (v4u){ket1[4], ket1[5], ket1[6], ket1[7]}; }
            { bf16* d = pv + blk_off(ld, 2 * lane, 0); *(v4u*)d = (v4u){vt0[0], vt0[1], vt0[2], vt0[3]}; *(v4u*)(d + 8) = (v4u){vt0[4], vt0[5], vt0[6], vt0[7]};
              *(v4u*)(d + 16) = (v4u){vt1[0], vt1[1], vt1[2], vt1[3]}; *(v4u*)(d + 24) = (v4u){vt1[4], vt1[5], vt1[6], vt1[7]}; }
            { float* dd = WSP(float, WS_DEC) + (size_t)blk * 128 + 2 * lane; dd[0] = __expf(e0); dd[1] = __expf(e1); }
        } else {
            unsigned ket0[8], ket1[8], vt0[8], vt1[8];
#pragma unroll
            for (int j = 0; j < 16; ++j) {
                *(LAS unsigned*)(wl + j * CP_ROW + 4 * lane) = pk2(kv[j][0], kv[j][1]);
                *(LAS unsigned*)(wl + 4352 + j * CP_ROW + 4 * lane) = pk2(qv[j][0], qv[j][1]);
                const float eq = __expf(Gt[j]), ek = __expf(Gt[15] - Gt[j]);
                *(unsigned*)(pql + (size_t)j * ld) = pk2(qv[j][0] * eq, qv[j][1] * eq);
                const float t0 = kv[j][0] * ek, t1 = kv[j][1] * ek;
                if (j & 1) { ket0[j >> 1] |= f2bf(t0) << 16; ket1[j >> 1] |= f2bf(t1) << 16; vt0[j >> 1] |= f2bf(vv[j][0]) << 16; vt1[j >> 1] |= f2bf(vv[j][1]) << 16; }
                else { ket0[j >> 1] = f2bf(t0); ket1[j >> 1] = f2bf(t1); vt0[j >> 1] = f2bf(vv[j][0]); vt1[j >> 1] = f2bf(vv[j][1]); } }
            { bf16* d = pk + blk_off(ld, 2 * lane, 0); *(v4u*)d = (v4u){ket0[0], ket0[1], ket0[2], ket0[3]}; *(v4u*)(d + 8) = (v4u){ket0[4], ket0[5], ket0[6], ket0[7]};
              *(v4u*)(d + 16) = (v4u){ket1[0], ket1[1], ket1[2], ket1[3]}; *(v4u*)(d + 24) = (v4u){ket1[4], ket1[5], ket1[6], ket1[7]}; }
            if (br == 2) { bf16* d = pv + blk_off(ld, 2 * lane, 0); *(v4u*)d = (v4u){vt0[0], vt0[1], vt0[2], vt0[3]}; *(v4u*)(d + 8) = (v4u){vt0[4], vt0[5], vt0[6], vt0[7]};
              *(v4u*)(d + 16) = (v4u){vt1[0], vt1[1], vt1[2], vt1[3]}; *(v4u*)(d + 24) = (v4u){vt1[4], vt1[5], vt1[6], vt1[7]}; }
            if (br == 0 && lane == 0) WSP(float, WS_DG)[blk] = __expf(Gt[15]);
        }
        if (lane < 16) { float gsel = Gt[0], bsel = bet[0];
#pragma unroll
            for (int j = 1; j < 16; ++j) { gsel = (lane == j) ? Gt[j] : gsel; bsel = (lane == j) ? bet[j] : bsel; }
            Gs[lane] = gsel; Bs[lane] = bsel; }
        asm volatile("s_waitcnt lgkmcnt(0)" ::: "memory");
        f32x4 cq = (f32x4){0.f, 0.f, 0.f, 0.f}, ck = (f32x4){0.f, 0.f, 0.f, 0.f};
#pragma unroll
        for (int ks = 0; ks < 4; ++ks) { const bf16x8 ka = *(const LAS bf16x8*)(wl + lr * CP_ROW + (32 * ks + 8 * g) * 2), qb = *(const LAS bf16x8*)(wl + 4352 + lr * CP_ROW + (32 * ks + 8 * g) * 2);
            cq = __builtin_amdgcn_mfma_f32_16x16x32_bf16(ka, qb, cq, 0, 0, 0);
            if (br == 0) ck = __builtin_amdgcn_mfma_f32_16x16x32_bf16(ka, ka, ck, 0, 0, 0); }
        {   const float Gi = Gs[lr], bi = Bs[lr]; float aq[4], ak[4];
#pragma unroll
            for (int r = 0; r < 4; ++r) { const int j = 4 * g + r; const float dcy = (br == 1) ? 1.0f : __expf(fminf(Gi - Gs[j], 0.f));
                aq[r] = (lr >= j) ? cq[r] * dcy : 0.f; ak[r] = (lr > j) ? ck[r] * dcy * bi : 0.f; }
            *(unsigned long long*)(WSP(bf16, WS_AQK) + ((size_t)br * 4096 + blk) * 256 + lr * 16 + 4 * g) = (unsigned long long)pk2(aq[0], aq[1]) | ((unsigned long long)pk2(aq[2], aq[3]) << 32);
            if (br == 0) *(LAS f32x4*)(akk + lr * 16 + 4 * g) = (f32x4){ak[0], ak[1], ak[2], ak[3]}; }
        if (br == 0) {
            asm volatile("s_waitcnt lgkmcnt(0)" ::: "memory");
            float X[16][4];
#pragma unroll
            for (int i = 0; i < 16; ++i) { const float eb = bet[i] * __expf(Gt[i]);
                float x0 = bet[i] * vv[i][0], x1 = bet[i] * vv[i][1], x2 = eb * kv[i][0], x3 = eb * kv[i][1];
#pragma unroll
                for (int j = 0; j < i; ++j) { const float a = akk[i * 16 + j]; x0 -= a * X[j][0]; x1 -= a * X[j][1]; x2 -= a * X[j][2]; x3 -= a * X[j][3]; }
                X[i][0] = x0; X[i][1] = x1; X[i][2] = x2; X[i][3] = x3;
                *(unsigned*)(WSP(bf16, WS_XAC) + (m0 + i) * 512 + h * 128 + 2 * lane) = pk2(-x2, -x3); }
            unsigned u0[8], u1[8];
#pragma unroll
            for (int j = 0; j < 8; ++j) { u0[j] = pk2(X[2 * j][0], X[2 * j + 1][0]); u1[j] = pk2(X[2 * j][1], X[2 * j + 1][1]); }
            bf16* d = pv + blk_off(ld, 2 * lane, 0); *(v4u*)d = (v4u){u0[0], u0[1], u0[2], u0[3]}; *(v4u*)(d + 8) = (v4u){u0[4], u0[5], u0[6], u0[7]};
            *(v4u*)(d + 16) = (v4u){u1[0], u1[1], u1[2], u1[3]}; *(v4u*)(d + 24) = (v4u){u1[4], u1[5], u1[6], u1[7]};
        }
        asm volatile("s_waitcnt lgkmcnt(0)" ::: "memory");
    }
}

__device__ __forceinline__ void p3b_chunkprep(Frame& F, int l) { p3b_chunkprep_br<0>(F, l); p3b_chunkprep_br<1>(F, l); p3b_chunkprep_br<2>(F, l); }
constexpr int ST_ROW = 272, ST_BUF = 32 * ST_ROW;
struct ScFrag { unsigned long long ket, v0, v1, aq; v4u w[4], q[4]; f32x4 dec; float ds; };
struct ScPtr { const bf16 *pq, *pk, *pv, *pw, *paq; const float *pdec, *pdg; float* O; int v0; float gam16; };
template <int TYPE>
__device__ __forceinline__ void sc_load(ScFrag& f, const ScPtr& P, int c, int w, int g, int lr) {
    constexpr int ld = (TYPE == 0) ? 512 : NU; const size_t mc = (size_t)c * 16;
    f.ket = *(const unsigned long long*)(P.pk + mc * ld + blk_off(ld, 16 * w + lr, 4 * g));
    f.v0 = *(const unsigned long long*)(P.pv + mc * ld + blk_off(ld, P.v0 + lr, 4 * g)); f.v1 = *(const unsigned long long*)(P.pv + mc * ld + blk_off(ld, P.v0 + 16 + lr, 4 * g));
    if (TYPE == 0) {
#pragma unroll
        for (int ks = 0; ks < 4; ++ks) f.w[ks] = *(const v4u*)(P.pw + (mc + lr) * 512 + 32 * ks + 8 * g);
        f.ds = P.pdg[(size_t)c * 4]; }
    if (TYPE == 1) f.dec = *(const f32x4*)(P.pdec + (size_t)c * 512 + 16 * w + 4 * g);
    if (w < 2) {
#pragma unroll
        for (int ks = 0; ks < 4; ++ks) f.q[ks] = *(const v4u*)(P.pq + (mc + lr) * ld + 32 * ks + 8 * g);
        f.aq = *(const unsigned long long*)(P.paq + (size_t)c * 1024 + lr * 16 + 4 * g); }
}
template <int TYPE>
__device__ __forceinline__ void sc_step(const ScFrag& f, const ScPtr& P, LAS unsigned char* lds, int c, int w, int g, int lr, size_t orow, f32x4& S0, f32x4& S1) {
    const LAS unsigned char* Sc = lds + (c & 1) * ST_BUF; LAS unsigned char* Sn = lds + ((c & 1) ^ 1) * ST_BUF;
    bf16x8 sf[2][4];
#pragma unroll
    for (int vt = 0; vt < 2; ++vt)
#pragma unroll
        for (int ks = 0; ks < 4; ++ks) sf[vt][ks] = *(const LAS bf16x8*)(Sc + (16 * vt + lr) * ST_ROW + (32 * ks + 8 * g) * 2);
    bf16x8 vfr[2];
    if (TYPE == 0) {
#pragma unroll
        for (int vt = 0; vt < 2; ++vt) { const unsigned long long uu = vt ? f.v1 : f.v0;
            f32x4 acc = (f32x4){bflo((unsigned)uu), bfhi((unsigned)uu), bflo((unsigned)(uu >> 32)), bfhi((unsigned)(uu >> 32))};
#pragma unroll
            for (int ks = 0; ks < 4; ++ks) acc = __builtin_amdgcn_mfma_f32_16x16x32_bf16(__builtin_bit_cast(bf16x8, f.w[ks]), sf[vt][ks], acc, 0, 0, 0);
            vfr[vt] = __builtin_bit_cast(bf16x8, (v4u){cvtpk(acc[0], acc[1]), cvtpk(acc[2], acc[3]), 0u, 0u}); }
    } else {
        vfr[0] = __builtin_bit_cast(bf16x8, (v4u){(unsigned)f.v0, (unsigned)(f.v0 >> 32), 0u, 0u}); vfr[1] = __builtin_bit_cast(bf16x8, (v4u){(unsigned)f.v1, (unsigned)(f.v1 >> 32), 0u, 0u});
    }
    if (w < 2) { f32x4 acc = (f32x4){0.f, 0.f, 0.f, 0.f};
#pragma unroll
        for (int ks = 0; ks < 4; ++ks) acc = __builtin_amdgcn_mfma_f32_16x16x32_bf16(w ? sf[1][ks] : sf[0][ks], __builtin_bit_cast(bf16x8, f.q[ks]), acc, 0, 0, 0);
        acc = __builtin_amdgcn_mfma_f32_16x16x32_bf16(w ? vfr[1] : vfr[0], __builtin_bit_cast(bf16x8, (v4u){(unsigned)f.aq, (unsigned)(f.aq >> 32), 0u, 0u}), acc, 0, 0, 0);
        *(f32x4*)(P.O + orow + (size_t)c * 16 * 512 + (size_t)lr * 512 + 16 * w + 4 * g) = acc; }
    const bf16x8 kfr = __builtin_bit_cast(bf16x8, (v4u){(unsigned)f.ket, (unsigned)(f.ket >> 32), 0u, 0u});
    if (TYPE == 0) { S0 = S0 * f.ds; S1 = S1 * f.ds; } else if (TYPE == 1) { S0 = S0 * f.dec; S1 = S1 * f.dec; } else { S0 = S0 * P.gam16; S1 = S1 * P.gam16; }
    S0 = __builtin_amdgcn_mfma_f32_16x16x32_bf16(kfr, vfr[0], S0, 0, 0, 0);
    S1 = __builtin_amdgcn_mfma_f32_16x16x32_bf16(kfr, vfr[1], S1, 0, 0, 0);
    *(LAS unsigned long long*)(Sn + lr * ST_ROW + (16 * w + 4 * g) * 2) = (unsigned long long)cvtpk(S0[0], S0[1]) | ((unsigned long long)cvtpk(S0[2], S0[3]) << 32);
    *(LAS unsigned long long*)(Sn + (16 + lr) * ST_ROW + (16 * w + 4 * g) * 2) = (unsigned long long)cvtpk(S1[0], S1[1]) | ((unsigned long long)cvtpk(S1[2], S1[3]) << 32);
    asm volatile("s_waitcnt lgkmcnt(0)" ::: "memory"); __builtin_amdgcn_s_barrier(); asm volatile("" ::: "memory");
}
template <int TYPE>
__device__ __forceinline__ void seqc_unit(Frame& F, int l, int b, int h, int vs) {
    LAS unsigned char* lds = F.lds; const int lane = F.lane, w = F.wave, g = lane >> 4, lr = lane & 15;
    bf16* U = WSP(bf16, WS_U);
    ScPtr P; float* Sout; constexpr int br = TYPE;
    const size_t mb = (size_t)b * SEQ, so = ((size_t)(l * 8 + b) * 4 + h) * 16384;
    if (TYPE == 0) { P.pq = WSP(bf16, WS_GQ) + mb * 512 + h * 128; P.pk = WSP(bf16, WS_GK) + mb * 512 + h * 128; P.pv = WSP(bf16, WS_GV) + mb * 512 + h * 128; P.O = WSP(float, WS_OG); Sout = F.out + O_PGS + so; }
    else if (TYPE == 1) { P.pq = U + mb * NU + U_HQ + h * 128; P.pk = U + mb * NU + U_HF + h * 128; P.pv = U + mb * NU + U_HI + h * 128; P.O = WSP(float, WS_OH); Sout = F.out + O_PHS + so; }
    else { P.pq = U + mb * NU + U_RQ + h * 128; P.pk = U + mb * NU + U_RK + h * 128; P.pv = U + mb * NU + U_RV + h * 128; P.O = WSP(float, WS_OR); Sout = F.out + O_PRS + so; }
    P.pw = WSP(bf16, WS_XAC) + mb * 512 + h * 128;
    P.paq = WSP(bf16, WS_AQK) + ((size_t)br * 4096 + (size_t)b * 512 + h) * 256;
    P.pdec = WSP(float, WS_DEC) + ((size_t)b * 512 + h) * 128;
    P.pdg = WSP(float, WS_DG) + (size_t)b * 512 + h;
    P.gam16 = exp2f(16.0f * log2f(1.0f - exp2f(-5.0f - (float)h)));
    P.v0 = vs * 32;
    const size_t orow = mb * 512 + h * 128 + P.v0;
    for (int i = F.tid; i < ST_BUF / 4; i += NTHR) ((LAS unsigned*)lds)[i] = 0u;
    f32x4 S0 = (f32x4){0.f, 0.f, 0.f, 0.f}, S1 = S0;
    ScFrag fa, fb, fc;
    fa.ket = fa.v0 = fa.v1 = fa.aq = 0ull; fa.dec = (f32x4){1.f, 1.f, 1.f, 1.f}; fa.ds = 1.f;
#pragma unroll
    for (int ks = 0; ks < 4; ++ks) { fa.w[ks] = (v4u){0u, 0u, 0u, 0u}; fa.q[ks] = (v4u){0u, 0u, 0u, 0u}; }
    fb = fa; fc = fa;
    sc_load<TYPE>(fa, P, 0, w, g, lr); sc_load<TYPE>(fb, P, 1, w, g, lr);
    __syncthreads();
#pragma unroll 1
    for (int c = 0; c < 128; c += 3) {
        if (c + 2 < 128) sc_load<TYPE>(fc, P, c + 2, w, g, lr);
        sc_step<TYPE>(fa, P, lds, c, w, g, lr, orow, S0, S1);
        if (c + 1 < 128) { if (c + 3 < 128) sc_load<TYPE>(fa, P, c + 3, w, g, lr);
            sc_step<TYPE>(fb, P, lds, c + 1, w, g, lr, orow, S0, S1); }
        if (c + 2 < 128) { if (c + 4 < 128) sc_load<TYPE>(fb, P, c + 4, w, g, lr);
            sc_step<TYPE>(fc, P, lds, c + 2, w, g, lr, orow, S0, S1); }
    }
#pragma unroll
    for (int r = 0; r < 4; ++r) { Sout[(size_t)(16 * w + 4 * g + r) * 128 + P.v0 + lr] = S0[r]; Sout[(size_t)(16 * w + 4 * g + r) * 128 + P.v0 + 16 + lr] = S1[r]; }
    __syncthreads();
}

__device__ __forceinline__ void p4_mixers(Frame& F, int l) {
    constexpr int N_SEQP = 128, Q_GDN = 0, Q_HGRN = 128, Q_RET = 256, Q_LRU = 384, Q_XP = 512, Q_SS = 640, Q_XS = Q_SS + 3 * 512, Q_END = Q_XS + 512;
    const bf16* U = WSP(bf16, WS_U);
    for (;;) {
        F.tid = threadIdx.x; asm volatile("" : "+v"(F.tid)); F.lane = F.tid & 63; F.wave = __builtin_amdgcn_readfirstlane(F.tid >> 6);
        if (F.tid == 0) F.MISC[16] = __hip_atomic_fetch_add((unsigned*)(F.ctl + CW_QUEUE + 64 * l), 1u, __ATOMIC_RELAXED, __HIP_MEMORY_SCOPE_AGENT);
        __syncthreads();
        const int idx = (int)F.MISC[16];
        __syncthreads();
        if (idx >= Q_END) break;
        if (idx < Q_LRU) {
            const int type = idx / N_SEQP, j = idx % N_SEQP, b = j >> 4, h = (j >> 2) & 3, vs = j & 3;
            if (type == 0) { if (EN(22)) seqc_unit<0>(F, l, b, h, vs); } else if (type == 1) { if (EN(23)) seqc_unit<1>(F, l, b, h, vs); } else { if (EN(24)) seqc_unit<2>(F, l, b, h, vs); }
        } else if (idx < Q_XP) { const int j = idx - Q_LRU; if (EN(19)) lru_scan_unit(F, l, j >> 4, j & 15); }
        else if (idx < Q_SS) { const int j = idx - Q_XP; if (EN(20)) cross_prompt_unit(F, j >> 4, (j >> 2) & 3, j & 3); }
        else if (idx < Q_XS) {
            const int j = idx - Q_SS, type = j / 512, s = (j % 512) >> 2, h = j & 3; const size_t m0 = (size_t)MPR + s;
            SeqArgs a; a.T = 1; a.vs0 = 0; a.vs1 = 4; a.gamma = 0.f; a.beta = nullptr; a.eg = nullptr;
            const size_t so = ((size_t)(l * DECB + s) * 4 + h) * 16384;
            if (type == 0) { a.A = WSP(bf16, WS_GK) + m0 * 512 + h * 128; a.Q = WSP(bf16, WS_GQ) + m0 * 512 + h * 128; a.V = WSP(bf16, WS_GV) + m0 * 512 + h * 128; a.lda = a.ldq = a.ldv = 512;
                a.beta = WSP(float, WS_BETA) + m0 * 4 + h; a.eg = WSP(float, WS_EG) + m0 * 4 + h; a.S0 = INP(I_SGDNS) + so; a.Sout = F.out + O_SGS + so; a.O = WSP(float, WS_OG) + m0 * 512 + h * 128; if (EN(16)) seq_unit<0>(F, a); }
            else if (type == 1) { a.A = U + m0 * NU + U_HF + h * 128; a.Q = U + m0 * NU + U_HQ + h * 128; a.V = U + m0 * NU + U_HI + h * 128; a.lda = a.ldq = a.ldv = NU;
                a.S0 = INP(I_SHGRNS) + so; a.Sout = F.out + O_SHS + so; a.O = WSP(float, WS_OH) + m0 * 512 + h * 128; if (EN(17)) seq_unit<1>(F, a); }
            else { a.A = U + m0 * NU + U_RK + h * 128; a.Q = U + m0 * NU + U_RQ + h * 128; a.V = U + m0 * NU + U_RV + h * 128; a.lda = a.ldq = a.ldv = NU; a.gamma = 1.0f - exp2f(-5.0f - (float)h);
                a.S0 = INP(I_SRETS) + so; a.Sout = F.out + O_SRS + so; a.O = WSP(float, WS_OR) + m0 * 512 + h * 128; if (EN(18)) seq_unit<2>(F, a); }
        } else { const int j = idx - Q_XS; if (EN(21)) cross_sample_unit(F, l, j >> 2, j & 3); }
    }
}
__device__ __forceinline__ void p5_postpass(Frame& F, int l) {
    const int gw = F.vcu * NWAVES + F.wave, NGW = F.G * NWAVES, lane = F.lane, c8 = lane * 8;
    const bf16* U = WSP(bf16, WS_U); bf16* Y = WSP(bf16, WS_Y);
#pragma clang loop unroll(disable)
    for (int m = gw; m < MROWS; m += NGW) {
        const bf16* urow = U + (size_t)m * NU;
        {   float o[8], z[8], w[8], y[8]; ld8f(WSP(float, WS_OG) + (size_t)m * 512 + c8, o); ld8bf(urow + U_GZ + c8, z); ld8f(INP(I_GNW) + l * 512 + c8, w);
            float ss = 0.f;
#pragma unroll
            for (int e = 0; e < 8; ++e) ss += o[e] * o[e];
            const float rstd = rsqrtf(row16_sum(ss) * (1.0f / 128.0f) + NORM_EPS);
#pragma unroll
            for (int e = 0; e < 8; ++e) y[e] = o[e] * rstd * w[e] * siluf(z[e]);
            *(v4u*)(Y + ((size_t)1 * MP + m) * 512 + c8) = pack8(y); }
        {   float o[8], z[8], w[8], y[8]; ld8f(WSP(float, WS_OH) + (size_t)m * 512 + c8, o); ld8bf(urow + U_HG + c8, z); ld8f(INP(I_HNW) + l * 512 + c8, w);
            float ss = 0.f;
#pragma unroll
            for (int e = 0; e < 8; ++e) ss += o[e] * o[e];
            const float rstd = rsqrtf(row16_sum(ss) * (1.0f / 128.0f) + NORM_EPS);
#pragma unroll
            for (int e = 0; e < 8; ++e) y[e] = o[e] * rstd * w[e] * sigm(z[e]);
            *(v4u*)(Y + ((size_t)2 * MP + m) * 512 + c8) = pack8(y); }
        {   float o[8], z[8], w[8], bb[8], y[8]; ld8f(WSP(float, WS_OR) + (size_t)m * 512 + c8, o); ld8bf(urow + U_RG + c8, z); ld8f(INP(I_RGW) + l * 512 + c8, w); ld8f(INP(I_RGB) + l * 512 + c8, bb);
            float s1 = 0.f;
#pragma unroll
            for (int e = 0; e < 8; ++e) s1 += o[e];
            const float mu = row16_sum(s1) * (1.0f / 128.0f); float s2 = 0.f;
#pragma unroll
            for (int e = 0; e < 8; ++e) { o[e] -= mu; s2 += o[e] * o[e]; }
            const float rstd = rsqrtf(row16_sum(s2) * (1.0f / 128.0f) + NORM_EPS);
#pragma unroll
            for (int e = 0; e < 8; ++e) y[e] = (o[e] * rstd * w[e] + bb[e]) * siluf(z[e]);
            *(v4u*)(Y + ((size_t)3 * MP + m) * 512 + c8) = pack8(y); }
        if (m >= MPR) {
            const int s = m - MPR; float a[8], b[8], h0[8], h[8];
            ld8f(WSP(float, WS_LA) + (size_t)m * 512 + c8, a); ld8f(WSP(float, WS_LB) + (size_t)m * 512 + c8, b); ld8f(INP(I_SLRUH) + ((size_t)l * DECB + s) * 512 + c8, h0);
#pragma unroll
            for (int e = 0; e < 8; ++e) h[e] = a[e] * h0[e] + b[e];
            st8f(F.out + O_SLH + ((size_t)l * DECB + s) * 512 + c8, h);
            *(v4u*)(Y + (size_t)m * 512 + c8) = pack8(h); }
    }
}
__device__ __forceinline__ void psum_pass(Frame& F) {
    const int gw = F.vcu * NWAVES + F.wave, NGW = F.G * NWAVES, lane = F.lane;
    const bf16* P = WSP(bf16, WS_R2); bf16* Ms = WSP(bf16, WS_Y);
#pragma clang loop unroll(disable)
    for (int m = gw; m < MROWS; m += NGW) {
#pragma unroll
        for (int hh = 0; hh < 2; ++hh) { float a[8] = {0.f, 0.f, 0.f, 0.f, 0.f, 0.f, 0.f, 0.f};
#pragma unroll
            for (int n = 0; n < 5; ++n) { float v[8]; ld8bf(P + (size_t)m * 5120 + n * 1024 + hh * 512 + lane * 8, v);
#pragma unroll
                for (int e = 0; e < 8; ++e) a[e] += v[e]; }
            *(v4u*)(Ms + (size_t)m * 1024 + hh * 512 + lane * 8) = pack8(a); }
    }
}
__device__ __forceinline__ void ln_pass(Frame& F, const float* gam, const float* bet) {
    const int gw = F.vcu * NWAVES + F.wave, NGW = F.G * NWAVES, lane = F.lane;
#pragma clang loop unroll(disable)
    for (int m = gw; m < MROWS; m += NGW) {
        const f32x4* zr = (const f32x4*)(WSP(float, WS_Z) + (size_t)m * DM) + lane;
        f32x4 v[4]; float s = 0.f;
#pragma unroll
        for (int j = 0; j < 4; ++j) { v[j] = zr[64 * j]; s += (v[j].x + v[j].y) + (v[j].z + v[j].w); }
        const float mean = wave_sum(s) * (1.f / DM); float s2 = 0.f;
#pragma unroll
        for (int j = 0; j < 4; ++j) { v[j] = v[j] - mean; s2 += (v[j].x * v[j].x + v[j].y * v[j].y) + (v[j].z * v[j].z + v[j].w * v[j].w); }
        const float rstd = rsqrtf(wave_sum(s2) * (1.f / DM) + LN_EPS);
        f32x4* xo = (f32x4*)(F.out + (size_t)m * DM) + lane; unsigned long long* xb = (unsigned long long*)(WSP(bf16, WS_XB) + (size_t)m * DM) + lane;
#pragma unroll
        for (int j = 0; j < 4; ++j) { const f32x4 gv = *((const f32x4*)gam + lane + 64 * j), bv = *((const f32x4*)bet + lane + 64 * j); const f32x4 y = v[j] * rstd * gv + bv;
            xo[64 * j] = y; xb[64 * j] = (unsigned long long)pk2(y.x, y.y) | ((unsigned long long)pk2(y.z, y.w) << 32); }
    }
}

struct Args { const float* in[N_INPUTS]; float* out; unsigned char* ws; };
#ifndef MAXPHASE
#define MAXPHASE 1000
#endif
#define GRID_BAR() do { asm volatile("" : "+s"(bar.x), "+s"(bar.bar)); xcd_barrier(bar); asm volatile("" : "+s"(F.ws), "+s"(F.out), "+s"(F.in)); F.tid = threadIdx.x; asm volatile("" : "+v"(F.tid)); F.lane = F.tid & 63; F.wave = __builtin_amdgcn_readfirstlane(F.tid >> 6); } while (0)
template <int L>
__device__ __forceinline__ void run_layer(Frame& F, XcdBarrier& bar) {
    constexpr int l = L; LAS unsigned char* glds = F.lds;
        unsigned char* wl = F.ws + WS_W + (size_t)l * WL_SIZE;
        if (EN(1)) {   pg8::Gemm g{WSP(bf16, WS_XB), (const bf16*)(wl + WL_WIN), MP, NU, DM, 0, 0}; pg8::StaticOrder S; S.init(MP, NU, F.G, (int)blockIdx.x);
            pg8::EpiBf16 E{WSP(bf16, WS_U), NU};
            pg8::gemm_phase<pg8::EpiBf16, pg8::StaticOrder, true, true>(glds, g, S, E); }
        if (EN(2)) {   pg8::Gemm g{WSP(bf16, WS_MB), (const bf16*)(wl + WL_WKV), 2048, 1024, DM, 0, 0}; pg8::StaticOrder S; S.init(2048, 1024, F.G, (int)blockIdx.x);
            pg8::EpiMemKV E{F.out + O_PMK + (size_t)l * 2048 * 512, F.out + O_PMV + (size_t)l * 2048 * 512};
            pg8::gemm_phase<pg8::EpiMemKV, pg8::StaticOrder, true, true>(glds, g, S, E); }
        GRID_BAR();
        if (EN(3)) p2_prepass(F, l);
        GRID_BAR();
        if (EN(4)) {   pg8::Gemm g{WSP(bf16, WS_XAC), (const bf16*)(wl + WL_WLRU), MP, 1024, 512, 0, 0}; pg8::StaticOrder S; S.init(MP, 1024, F.G, (int)blockIdx.x);
            pg8::EpiLru E{INP(I_LBA) + l * 512, INP(I_LBI) + l * 512, INP(I_LLAM) + l * 512, WSP(bf16, WS_XAC), WSP(float, WS_LA), WSP(float, WS_LB)};
            pg8::gemm_phase<pg8::EpiLru, pg8::StaticOrder, true, true>(glds, g, S, E); }
        GRID_BAR();
        if (EN(14)) p3b_chunkprep(F, l);
        GRID_BAR();
        if (EN(5)) p4_mixers(F, l);
        GRID_BAR();
        if (EN(6)) p5_postpass(F, l);
        GRID_BAR();
        if (EN(7)) {   pg8::Gemm g{WSP(bf16, WS_Y), (const bf16*)(wl + WL_WB), MP, 5120, 512, 4, (size_t)MP * 512 * 2}; pg8::StaticOrder S; S.init(MP, 5120, F.G, (int)blockIdx.x);
            pg8::EpiBf16 E{WSP(bf16, WS_U), 5120};
            pg8::gemm_phase<pg8::EpiBf16, pg8::StaticOrder, true, true>(glds, g, S, E); }
        GRID_BAR();
        if (EN(8)) {   pg8::Gemm g{WSP(bf16, WS_XB), (const bf16*)(wl + WL_WG), MP, 5120, DM, 0, 0}; pg8::StaticOrder S; S.init(MP, 5120, F.G, (int)blockIdx.x);
            pg8::EpiGate E{INP(I_BMG) + (size_t)l * 5120, WSP(bf16, WS_U), WSP(bf16, WS_R2)};
            pg8::gemm_phase<pg8::EpiGate, pg8::StaticOrder, true, true>(glds, g, S, E); }
        GRID_BAR();
        psum_pass(F);
        GRID_BAR();
        if (EN(9)) {   pg8::Gemm g{WSP(bf16, WS_Y), (const bf16*)(wl + WL_WO5), MP, 1024, 1024, 0, 0}; pg8::StaticOrder S; S.init(MP, 1024, F.G, (int)blockIdx.x);
            pg8::EpiRes E{F.out, WSP(float, WS_Z), MROWS, ALPHA};
            pg8::gemm_phase<pg8::EpiRes, pg8::StaticOrder, true, true>(glds, g, S, E); }
        GRID_BAR();
        if (EN(10)) ln_pass(F, INP(I_LN1G) + l * DM, INP(I_LN1B) + l * DM);
        GRID_BAR();
        if (EN(11)) {   pg8::Gemm g{WSP(bf16, WS_XB), (const bf16*)(wl + WL_WUP), MP, 5632, DM, 0, 0}; pg8::StaticOrder S; S.init(MP, 5632, F.G, (int)blockIdx.x);
            pg8::EpiSwiglu E{WSP(bf16, WS_U)};
            pg8::gemm_phase<pg8::EpiSwiglu, pg8::StaticOrder, true, true>(glds, g, S, E); }
        GRID_BAR();
        if (EN(12)) {   pg8::Gemm g{WSP(bf16, WS_U), (const bf16*)(wl + WL_WDN), MP, 1024, DFF, 0, 0}; pg8::StaticOrder S; S.init(MP, 1024, F.G, (int)blockIdx.x);
            pg8::EpiRes E{F.out, WSP(float, WS_Z), MROWS, ALPHA};
            pg8::gemm_phase<pg8::EpiRes, pg8::StaticOrder, true, true>(glds, g, S, E); }
        GRID_BAR();
        if (EN(13)) ln_pass(F, INP(I_LN2G) + l * DM, INP(I_LN2B) + l * DM);
        if (l + 1 < DEPTH) GRID_BAR();
}

__global__ void __launch_bounds__(NTHR, 2) mega_fwd(Args args) {
    extern __shared__ __attribute__((aligned(16))) unsigned char lds[];
    Frame F;
    F.lds = (LAS unsigned char*)lds; F.MISC = (volatile LAS unsigned*)(F.lds + MISC_OFF);
    F.tid = threadIdx.x; F.lane = F.tid & 63; F.wave = __builtin_amdgcn_readfirstlane(F.tid >> 6);
    F.G = gridDim.x; { const int bx = blockIdx.x; F.vcu = (F.G % 8 == 0) ? (bx % 8) * (F.G / 8) + bx / 8 : bx; }
    F.in = (kin_t)__builtin_amdgcn_kernarg_segment_ptr(); F.out = args.out; F.ws = args.ws; F.ctl = (gu32*)(args.ws + WS_CTL);
    for (int u = F.tid; u < (LDS_BYTES - LDSCTL_OFF) / 4; u += NTHR) ((LAS unsigned*)(F.lds + LDSCTL_OFF))[u] = 0u;
    __syncthreads();
    XcdBarrier bar = xcd_barrier_post((unsigned*)(F.ctl + CW_BAR), F.MISC + 8);

    LAS unsigned char* glds = F.lds;

    if (EN(0)) p0_prologue(F);
    GRID_BAR();
    run_layer<0>(F, bar);
    run_layer<1>(F, bar);
}

extern "C" void kernel_launch(void* const* d_in, const int* in_sizes, int n_in, void* d_out, int out_size, void* d_ws, size_t ws_size, hipStream_t stream) {
    static int grid = 0;
    if (grid == 0) {
        if (n_in != N_INPUTS || (size_t)out_size != O_END || ws_size < WS_END2) { fprintf(stderr, "kernel_launch: expected %d inputs, %zu outputs, >= %zu bytes of workspace; got %d, %d, %zu\n", (int)N_INPUTS, (size_t)O_END, (size_t)WS_END2, n_in, out_size, ws_size); grid = -1; return; }
        int dev = 0, cus = 0, per_cu = 0;
        if (hipGetDevice(&dev) != hipSuccess || hipDeviceGetAttribute(&cus, hipDeviceAttributeMultiprocessorCount, dev) != hipSuccess) { fprintf(stderr, "kernel_launch: device query failed\n"); grid = -1; return; }
        if (hipFuncSetAttribute((const void*)mega_fwd, hipFuncAttributeMaxDynamicSharedMemorySize, LDS_BYTES) != hipSuccess) { fprintf(stderr, "kernel_launch: hipFuncSetAttribute failed\n"); grid = -1; return; }
        if (hipOccupancyMaxActiveBlocksPerMultiprocessor(&per_cu, (const void*)mega_fwd, NTHR, LDS_BYTES) != hipSuccess || per_cu < 1) fprintf(stderr, "kernel_launch: note: occupancy query says %d blocks per CU\n", per_cu);
        (void)hipGetLastError();
        grid = cus;
    }
    if (grid < 0) return;
    if (hipMemsetAsync((char*)d_ws + WS_CTL, 0, CTL_ZERO_BYTES, stream) != hipSuccess) { fprintf(stderr, "kernel_launch: hipMemsetAsync failed\n"); return; }
    Args a{};
    for (int i = 0; i < N_INPUTS; ++i) a.in[i] = (const float*)d_in[i];
    a.out = (float*)d_out; a.ws = (unsigned char*)d_ws;
    hipLaunchKernelGGL(mega_fwd, dim3(grid), dim3(NTHR), LDS_BYTES, stream, a);
    const hipError_t le = hipPeekAtLastError();
    if (le != hipSuccess) fprintf(stderr, "kernel_launch: launch failed: %s\n", hipGetErrorName(le));
}
```

```cpp
#include <hip/hip_runtime.h>
#include <cstdio>
#include <cstdint>
namespace pg8 {
#define PG8_LAS __attribute__((address_space(3)))
typedef unsigned short bf16_t;
typedef short bf16x8 __attribute__((ext_vector_type(8)));
typedef float f32x4 __attribute__((ext_vector_type(4)));
typedef unsigned u32x4 __attribute__((ext_vector_type(4)));
constexpr int BM = 256, BK = 64, HALF = 128, HTB = HALF * BK * 2  , STAGE_BYTES = 8 * HTB, NXCD = 8, WGM = 8;

__host__ __device__ __forceinline__ int lds_byte(int r, int c) { const int st = (r >> 4) * 2 + (c >> 5), rr = r & 15, cc = c & 31, ob = rr * 64 + cc * 2; return st * 1024 + (ob ^ (((ob >> 9) & 1) << 5)); }
__host__ __device__ __forceinline__ void stage_rc(int b, int& R, int& C) { const int st = b / 1024, sb = b % 1024, swz = sb ^ (((sb >> 9) & 1) << 5); R = (st >> 1) * 16 + swz / 64; C = (st & 1) * 32 + (swz % 64) / 2; }
__host__ __device__ __forceinline__ int perm32(int rho) { const int n = rho >> 4, i = rho & 15; return 8 * (i >> 2) + 4 * n + (i & 3); }

struct Unit { int pm, pn; };
struct Gemm { const bf16_t* A; const bf16_t* Bt; int M, N, K; int a_div; size_t a_stride; };

struct StaticOrder {
    int nM, nN, nwg, G, c;
    __host__ __device__ void init(int M, int N, int G_, int c_) { nM = M / BM; nN = N / BM; nwg = nM * nN; G = G_; c = c_; }
    __host__ __device__ bool next(int i, Unit& u) const {
        const long L = (long)i * G + c; if (L >= nwg) return false;
        int wgid = (int)L; { const int q = nwg / NXCD, r = nwg % NXCD, xcd = wgid % NXCD, off = wgid / NXCD; wgid = (xcd < r ? xcd * (q + 1) : r * (q + 1) + (xcd - r) * q) + off; }
        const int nig = WGM * nN, gid = wgid / nig, fm = gid * WGM, gsz = (nM - fm) < WGM ? (nM - fm) : WGM;
        u.pm = fm + ((wgid % nig) % gsz); u.pn = (wgid % nig) / gsz; return true;
    }
    __device__ __forceinline__ void a_ready(const Unit&) const {}
    __device__ __forceinline__ void done(const Unit&) const {}
};
typedef __bf16 hbf2_t __attribute__((ext_vector_type(2))); typedef float hf2_t __attribute__((ext_vector_type(2)));
__device__ __forceinline__ unsigned cvt_pk_bf16(float lo, float hi) { const hf2_t v = {lo, hi}; const hbf2_t r = __builtin_convertvector(v, hbf2_t); return __builtin_bit_cast(unsigned, r); }
__device__ __forceinline__ float sigm(float x) { return 1.0f / (1.0f + __expf(-x)); }
struct EpiBf16 {
    static constexpr bool PERM = true, AFTER_DRAIN = false;
    bf16_t* O; int ldc;
    __device__ __forceinline__ void operator()(const f32x4 (&acc)[2][2][4][2], const Unit& u, int wr, int wc, int fr, int fq) const {
        const int row0 = u.pm * BM + wr * 64 + fr, col0 = u.pn * BM + wc * 32 + 8 * fq;
#pragma unroll
        for (int ai = 0; ai < 2; ++ai)
#pragma unroll
            for (int m = 0; m < 4; ++m) { bf16_t* rowp = O + (size_t)(row0 + ai * HALF + m * 16) * ldc + col0;
#pragma unroll
                for (int bj = 0; bj < 2; ++bj) { const f32x4 v0 = acc[ai][bj][m][0], v1 = acc[ai][bj][m][1];
                    u32x4 w; w.x = cvt_pk_bf16(v0[0], v0[1]); w.y = cvt_pk_bf16(v0[2], v0[3]); w.z = cvt_pk_bf16(v1[0], v1[1]); w.w = cvt_pk_bf16(v1[2], v1[3]);
                    *(u32x4*)(rowp + bj * HALF) = w; } }
    }
};
struct EpiMemKV {
    static constexpr bool PERM = false, AFTER_DRAIN = false;
    float* Kout; float* Vout;
    __device__ __forceinline__ void operator()(const f32x4 (&acc)[2][2][4][2], const Unit& u, int wr, int wc, int fr, int fq) const {
        const int row0 = u.pm * BM + wr * 64 + fr; int colt = u.pn * BM; float* base = colt < 512 ? Kout : Vout; colt &= 511;
        const int col0 = colt + wc * 32 + 4 * fq;
#pragma unroll
        for (int ai = 0; ai < 2; ++ai)
#pragma unroll
            for (int m = 0; m < 4; ++m) { float* rowp = base + (size_t)(row0 + ai * HALF + m * 16) * 512 + col0;
#pragma unroll
                for (int bj = 0; bj < 2; ++bj)
#pragma unroll
                    for (int n = 0; n < 2; ++n) *(f32x4*)(rowp + bj * HALF + n * 16) = acc[ai][bj][m][n]; }
    }
};
struct EpiLru {
    static constexpr bool PERM = false, AFTER_DRAIN = false;
    const float* ba; const float* bi; const float* lam; const bf16_t* XAC; float* LA; float* LB;
    __device__ __forceinline__ void operator()(const f32x4 (&acc)[2][2][4][2], const Unit& u, int wr, int wc, int fr, int fq) const {
        const int row0 = u.pm * BM + wr * 64 + fr, ch0 = u.pn * HALF + wc * 32 + 4 * fq;
        f32x4 bav[2], biv[2], spv[2];
#pragma unroll
        for (int n = 0; n < 2; ++n) { bav[n] = *(const f32x4*)(ba + ch0 + 16 * n); biv[n] = *(const f32x4*)(bi + ch0 + 16 * n);
            const f32x4 lv = *(const f32x4*)(lam + ch0 + 16 * n);
#pragma unroll
            for (int j = 0; j < 4; ++j) { const float z = -lv[j]; spv[n][j] = (z > 20.f) ? z : log1pf(__expf(z)); } }
#pragma unroll
        for (int ai = 0; ai < 2; ++ai)
#pragma unroll
            for (int m = 0; m < 4; ++m) { const size_t off = (size_t)(row0 + ai * HALF + m * 16) * 512 + ch0;
#pragma unroll
                for (int n = 0; n < 2; ++n) {
                    const f32x4 r = acc[ai][0][m][n] + bav[n], g = acc[ai][1][m][n] + biv[n];
                    const unsigned long long xw = *(const unsigned long long*)(XAC + off + 16 * n);
                    float xv[4]; xv[0] = __uint_as_float((unsigned)(xw & 0xffffu) << 16); xv[1] = __uint_as_float((unsigned)xw & 0xffff0000u);
                    xv[2] = __uint_as_float((unsigned)((xw >> 32) & 0xffffu) << 16); xv[3] = __uint_as_float((unsigned)(xw >> 32) & 0xffff0000u);
                    f32x4 av, bv;
#pragma unroll
                    for (int j = 0; j < 4; ++j) { const float la = -8.0f * sigm(r[j]) * spv[n][j]; av[j] = __expf(la); bv[j] = sqrtf(-expm1f(2.0f * la)) * (sigm(g[j]) * xv[j]); }
                    *(f32x4*)(LA + off + 16 * n) = av; *(f32x4*)(LB + off + 16 * n) = bv; } }
    }
};
struct EpiGate {
    static constexpr bool PERM = true, AFTER_DRAIN = false;
    const float* bias; const bf16_t* T; bf16_t* P;
    __device__ __forceinline__ void operator()(const f32x4 (&acc)[2][2][4][2], const Unit& u, int wr, int wc, int fr, int fq) const {
        const int row0 = u.pm * BM + wr * 64 + fr, col0 = u.pn * BM + wc * 32 + 8 * fq;
        f32x4 bv[2][2];
#pragma unroll
        for (int bj = 0; bj < 2; ++bj)
#pragma unroll
            for (int n = 0; n < 2; ++n) bv[bj][n] = *(const f32x4*)(bias + col0 + bj * HALF + 4 * n);
#pragma unroll
        for (int ai = 0; ai < 2; ++ai)
#pragma unroll
            for (int m = 0; m < 4; ++m) { const size_t off = (size_t)(row0 + ai * HALF + m * 16) * 5120 + col0;
#pragma unroll
                for (int bj = 0; bj < 2; ++bj) { const u32x4 t = *(const u32x4*)(T + off + bj * HALF);
                    const f32x4 v0 = acc[ai][bj][m][0] + bv[bj][0], v1 = acc[ai][bj][m][1] + bv[bj][1];
                    u32x4 w;
                    w.x = cvt_pk_bf16(sigm(v0[0]) * __uint_as_float(t.x << 16), sigm(v0[1]) * __uint_as_float(t.x & 0xffff0000u));
                    w.y = cvt_pk_bf16(sigm(v0[2]) * __uint_as_float(t.y << 16), sigm(v0[3]) * __uint_as_float(t.y & 0xffff0000u));
                    w.z = cvt_pk_bf16(sigm(v1[0]) * __uint_as_float(t.z << 16), sigm(v1[1]) * __uint_as_float(t.z & 0xffff0000u));
                    w.w = cvt_pk_bf16(sigm(v1[2]) * __uint_as_float(t.w << 16), sigm(v1[3]) * __uint_as_float(t.w & 0xffff0000u));
                    *(u32x4*)(P + off + bj * HALF) = w; }
                asm volatile("" ::: "memory"); }
    }
};
struct EpiRes {
    static constexpr bool PERM = false, AFTER_DRAIN = false;
    const float* X; float* Z; int nvalid; float alpha;
    __device__ __forceinline__ void operator()(const f32x4 (&acc)[2][2][4][2], const Unit& u, int wr, int wc, int fr, int fq) const {
        const int row0 = u.pm * BM + wr * 64 + fr, col0 = u.pn * BM + wc * 32 + 4 * fq;
#pragma unroll
        for (int ai = 0; ai < 2; ++ai)
#pragma unroll
            for (int m = 0; m < 4; ++m) { const int row = row0 + ai * HALF + m * 16; const size_t off = (size_t)row * 1024 + col0; const bool rv = row < nvalid;
#pragma unroll
                for (int bj = 0; bj < 2; ++bj)
#pragma unroll
                    for (int n = 0; n < 2; ++n) { f32x4 x = (f32x4){0.f, 0.f, 0.f, 0.f}; if (rv) x = *(const f32x4*)(X + off + bj * HALF + n * 16);
                        *(f32x4*)(Z + off + bj * HALF + n * 16) = x * alpha + acc[ai][bj][m][n]; }
                asm volatile("" ::: "memory"); }
    }
};
struct EpiSwiglu {
    static constexpr bool PERM = true, AFTER_DRAIN = false;
    bf16_t* H;
    __device__ __forceinline__ void operator()(const f32x4 (&acc)[2][2][4][2], const Unit& u, int wr, int wc, int fr, int fq) const {
        const int row0 = u.pm * BM + wr * 64 + fr, col0 = u.pn * HALF + wc * 32 + 8 * fq;
#pragma unroll
        for (int ai = 0; ai < 2; ++ai)
#pragma unroll
            for (int m = 0; m < 4; ++m) { bf16_t* rowp = H + (size_t)(row0 + ai * HALF + m * 16) * 2816 + col0;
                const f32x4 g0 = acc[ai][0][m][0], g1 = acc[ai][0][m][1], v0 = acc[ai][1][m][0], v1 = acc[ai][1][m][1];
                u32x4 w;
                w.x = cvt_pk_bf16(g0[0] * sigm(g0[0]) * v0[0], g0[1] * sigm(g0[1]) * v0[1]);
                w.y = cvt_pk_bf16(g0[2] * sigm(g0[2]) * v0[2], g0[3] * sigm(g0[3]) * v0[3]);
                w.z = cvt_pk_bf16(g1[0] * sigm(g1[0]) * v1[0], g1[1] * sigm(g1[1]) * v1[1]);
                w.w = cvt_pk_bf16(g1[2] * sigm(g1[2]) * v1[2], g1[3] * sigm(g1[3]) * v1[3]);
                *(u32x4*)rowp = w; }
    }
};

template <class Epi, class Sched, bool ALIGN_EPI = false, bool SP2 = false>
__device__ __forceinline__ void gemm_phase(PG8_LAS unsigned char* lds, const Gemm g, const Sched& S, const Epi& E) {
    int tid_ = threadIdx.x; asm volatile("" : "+v"(tid_));
    const int tid = tid_, wid = __builtin_amdgcn_readfirstlane(tid >> 6), lane = tid & 63, wr = wid >> 2, wc = wid & 3, fr = lane & 15, fq = lane >> 4;
    const int K = g.K, nt = K / BK;
    unsigned voffA[2], voffB[2];
#pragma unroll
    for (int i = 0; i < 2; ++i) { int R, C; stage_rc(tid * 16 + i * 8192, R, C); const int Rb = Epi::PERM ? ((R & ~31) + perm32(R & 31)) : R;
        voffA[i] = (unsigned)(R * K + C) * 2u; voffB[i] = (unsigned)(Rb * K + C) * 2u; }
    const size_t kstep = (size_t)(BK * 2);
    const size_t hstep = (size_t)HALF * K * 2;
    const size_t tstep = 2 * hstep;
    const unsigned ldsw = (unsigned)wid * 1024u;
    const int aoff = lds_byte(wr * 64 + fr, fq * 8), boff = lds_byte(wc * 32 + fr, fq * 8);
#define PG8_SA(b, h) (((b) * 2 + (h)) * HTB)
#define PG8_SB(b, h) ((4 + (b) * 2 + (h)) * HTB)
#define PG8_STAGE(bufoff, gbase, voff) do { _Pragma("unroll") for (int _i = 0; _i < 2; ++_i) \
        __builtin_amdgcn_global_load_lds((const unsigned*)((const char*)(gbase) + (voff)[_i]), (PG8_LAS unsigned*)(lds + (bufoff) + ldsw + _i * 8192), 16, 0, 0); } while (0)
#define PG8_LDA(dst, b, h) do { _Pragma("unroll") for (int m = 0; m < 4; ++m) _Pragma("unroll") for (int k = 0; k < 2; ++k) dst[m][k] = *(const PG8_LAS bf16x8*)(lds + PG8_SA(b, h) + aoff + m * 2048 + k * 1024); } while (0)
#define PG8_LDB(dst, b, h) do { _Pragma("unroll") for (int n = 0; n < 2; ++n) _Pragma("unroll") for (int k = 0; k < 2; ++k) dst[n][k] = *(const PG8_LAS bf16x8*)(lds + PG8_SB(b, h) + boff + n * 2048 + k * 1024); } while (0)
#define PG8_MMA(ai, bj, At, Bt) do { __builtin_amdgcn_s_setprio(1); _Pragma("unroll") for (int m = 0; m < 4; ++m) _Pragma("unroll") for (int n = 0; n < 2; ++n) _Pragma("unroll") for (int k = 0; k < 2; ++k) \
        acc[ai][bj][m][n] = __builtin_amdgcn_mfma_f32_16x16x32_bf16(Bt[n][k], At[m][k], acc[ai][bj][m][n], 0, 0, 0); __builtin_amdgcn_s_setprio(0); } while (0)
#define PG8_WAIT_V(n) asm volatile("s_waitcnt vmcnt(" #n ")" ::: "memory")
#define PG8_WAIT_L(n) asm volatile("s_waitcnt lgkmcnt(" #n ")" ::: "memory")
#define PG8_BAR __builtin_amdgcn_s_barrier()
#define PG8_SCHED __builtin_amdgcn_sched_barrier(0)
    Unit cur, nxt; int ui = 0;
    if (!S.next(0, cur)) return;
    f32x4 acc[2][2][4][2];
#pragma unroll
    for (int a = 0; a < 2; ++a)
#pragma unroll
        for (int b = 0; b < 2; ++b)
#pragma unroll
            for (int m = 0; m < 4; ++m)
#pragma unroll
                for (int n = 0; n < 2; ++n) acc[a][b][m][n] = (f32x4){0.f, 0.f, 0.f, 0.f};
    bf16x8 At[4][2], B0[2][2], B1[2][2];
    const char* cA = (const char*)g.A + (size_t)cur.pm * tstep + (g.a_div ? (size_t)(cur.pn / g.a_div) * g.a_stride : (size_t)0); const char* cB = (const char*)g.Bt + (size_t)cur.pn * tstep;
    S.a_ready(cur);
    if constexpr (SP2) {
        PG8_STAGE(PG8_SB(0, 0), cB, voffB); PG8_STAGE(PG8_SB(0, 1), cB + hstep, voffB); PG8_STAGE(PG8_SA(0, 0), cA, voffA); PG8_STAGE(PG8_SA(0, 1), cA + hstep, voffA);
        if (wr == 1) PG8_BAR;
        PG8_WAIT_V(2); PG8_BAR;
        PG8_STAGE(PG8_SB(1, 0), cB + kstep, voffB); PG8_STAGE(PG8_SA(1, 0), cA + kstep, voffA); PG8_STAGE(PG8_SB(1, 1), cB + hstep + kstep, voffB);
        PG8_WAIT_V(6); PG8_BAR;
    } else {
        PG8_STAGE(PG8_SB(0, 0), cB, voffB); PG8_STAGE(PG8_SA(0, 0), cA, voffA); PG8_STAGE(PG8_SB(0, 1), cB + hstep, voffB); PG8_STAGE(PG8_SA(0, 1), cA + hstep, voffA);
        if (wr == 1) PG8_BAR;
        PG8_WAIT_V(4); PG8_BAR;
        PG8_STAGE(PG8_SB(1, 0), cB + kstep, voffB); PG8_STAGE(PG8_SA(1, 0), cA + kstep, voffA); PG8_STAGE(PG8_SB(1, 1), cB + hstep + kstep, voffB);
        PG8_WAIT_V(6); PG8_BAR;
    }
    for (;;) {
        const bool has_next = S.next(ui + 1, nxt);
        const char* nA = has_next ? (const char*)g.A + (size_t)nxt.pm * tstep + (g.a_div ? (size_t)(nxt.pn / g.a_div) * g.a_stride : (size_t)0) : cA; const char* nB = has_next ? (const char*)g.Bt + (size_t)nxt.pn * tstep : cB;
        for (int t = 0; t < nt; t += 2) {
            const bool last = (t == nt - 2);
            const char* a1 = cA + (size_t)(t + 1) * kstep;
            const char* a2 = last ? nA : cA + (size_t)(t + 2) * kstep; const char* b2 = last ? nB : cB + (size_t)(t + 2) * kstep;
            const char* a3 = a2 + kstep; const char* b3 = b2 + kstep;
            if (last && has_next) S.a_ready(nxt);
            if constexpr (SP2) {
            PG8_LDB(B0, 0, 0); PG8_LDB(B1, 0, 1); PG8_SCHED; PG8_LDA(At, 0, 0); PG8_STAGE(PG8_SA(1, 1), a1 + hstep, voffA);
            PG8_WAIT_V(8); PG8_WAIT_L(0); PG8_BAR; PG8_MMA(0, 0, At, B0); PG8_MMA(0, 1, At, B1); PG8_BAR; PG8_SCHED;
            PG8_LDA(At, 0, 1); PG8_STAGE(PG8_SB(0, 0), b2, voffB); PG8_STAGE(PG8_SB(0, 1), b2 + hstep, voffB); PG8_STAGE(PG8_SA(0, 0), a2, voffA);
            PG8_WAIT_V(8); PG8_WAIT_L(0); PG8_BAR; PG8_MMA(1, 0, At, B0); PG8_MMA(1, 1, At, B1); PG8_BAR; PG8_SCHED;
            PG8_LDB(B0, 1, 0); PG8_LDB(B1, 1, 1); PG8_SCHED; PG8_LDA(At, 1, 0); PG8_STAGE(PG8_SA(0, 1), a2 + hstep, voffA);
            PG8_WAIT_V(8); PG8_WAIT_L(0); PG8_BAR; PG8_MMA(0, 0, At, B0); PG8_MMA(0, 1, At, B1); PG8_BAR; PG8_SCHED;
            PG8_LDA(At, 1, 1); PG8_STAGE(PG8_SB(1, 0), b3, voffB); PG8_STAGE(PG8_SB(1, 1), b3 + hstep, voffB); PG8_STAGE(PG8_SA(1, 0), a3, voffA);
            PG8_WAIT_V(8); PG8_WAIT_L(0); PG8_BAR; PG8_MMA(1, 0, At, B0); PG8_MMA(1, 1, At, B1); PG8_BAR; PG8_SCHED;
            } else {
            PG8_LDB(B0, 0, 0); PG8_SCHED; PG8_LDA(At, 0, 0); PG8_STAGE(PG8_SA(1, 1), a1 + hstep, voffA);
            PG8_WAIT_L(8); PG8_BAR; PG8_WAIT_L(0); PG8_MMA(0, 0, At, B0); PG8_BAR; PG8_SCHED;
            PG8_LDB(B1, 0, 1); PG8_STAGE(PG8_SB(0, 0), b2, voffB);
            PG8_BAR; PG8_WAIT_L(0); PG8_MMA(0, 1, At, B1); PG8_BAR;
            PG8_LDA(At, 0, 1); PG8_STAGE(PG8_SA(0, 0), a2, voffA);
            PG8_BAR; PG8_WAIT_L(0); PG8_MMA(1, 0, At, B0); PG8_BAR; PG8_SCHED;
            PG8_STAGE(PG8_SB(0, 1), b2 + hstep, voffB);
            PG8_WAIT_V(6); PG8_BAR; PG8_MMA(1, 1, At, B1); PG8_BAR;
            PG8_LDB(B0, 1, 0); PG8_SCHED; PG8_LDA(At, 1, 0); PG8_STAGE(PG8_SA(0, 1), a2 + hstep, voffA);
            PG8_WAIT_L(8); PG8_BAR; PG8_WAIT_L(0); PG8_MMA(0, 0, At, B0); PG8_BAR; PG8_SCHED;
            PG8_LDB(B1, 1, 1); PG8_STAGE(PG8_SB(1, 0), b3, voffB);
            PG8_BAR; PG8_WAIT_L(0); PG8_MMA(0, 1, At, B1); PG8_BAR;
            PG8_LDA(At, 1, 1); PG8_STAGE(PG8_SA(1, 0), a3, voffA);
            PG8_BAR; PG8_WAIT_L(0); PG8_MMA(1, 0, At, B0); PG8_BAR; PG8_SCHED;
            PG8_STAGE(PG8_SB(1, 1), b3 + hstep, voffB);
            PG8_WAIT_V(6); PG8_BAR; PG8_MMA(1, 1, At, B1); PG8_BAR;
            }
        }
        if constexpr (ALIGN_EPI) { if (wr == 0) PG8_BAR; }
        if constexpr (!Epi::AFTER_DRAIN) { E(acc, cur, wr, wc, fr, fq); S.done(cur); }
        if (!has_next) break;
#pragma unroll
        for (int a = 0; a < 2; ++a)
#pragma unroll
            for (int b = 0; b < 2; ++b)
#pragma unroll
                for (int m = 0; m < 4; ++m)
#pragma unroll
                    for (int n = 0; n < 2; ++n) acc[a][b][m][n] = (f32x4){0.f, 0.f, 0.f, 0.f};
        cur = nxt; cA = nA; cB = nB; ++ui;
        if constexpr (ALIGN_EPI) { if (wr == 1) PG8_BAR; }
    }
    PG8_WAIT_V(0);
    if constexpr (!ALIGN_EPI) { if (wr == 0) PG8_BAR; }
    PG8_BAR;
    if constexpr (Epi::AFTER_DRAIN) { E.fused(acc, cur, wr, wc, fr, fq, lds, wid, lane); S.done(cur); }
#undef PG8_SA
#undef PG8_SB
#undef PG8_STAGE
#undef PG8_LDA
#undef PG8_LDB
#undef PG8_MMA
#undef PG8_WAIT_V
#undef PG8_WAIT_L
#undef PG8_BAR
#undef PG8_SCHED
}
}
#define GAS __attribute__((address_space(1)))
#define LAS __attribute__((address_space(3)))
typedef unsigned short bf16;
typedef unsigned v4u __attribute__((ext_vector_type(4)));
typedef float f32x4 __attribute__((ext_vector_type(4)));
typedef short bf16x8 __attribute__((ext_vector_type(8)));
typedef GAS unsigned gu32;
typedef GAS unsigned long long gu64;
#define RLX_AGENT __ATOMIC_RELAXED, __HIP_MEMORY_SCOPE_AGENT
#define LDS_WAIT() asm volatile("s_waitcnt lgkmcnt(0)" ::: "memory")
#define VM_WAIT() asm volatile("s_waitcnt vmcnt(0)" ::: "memory")
__device__ __forceinline__ unsigned long long rt() { return __builtin_amdgcn_s_memrealtime(); }
__device__ __forceinline__ unsigned f2bf(float f) { unsigned u = __builtin_bit_cast(unsigned, f); return (u + 0x7fffu + ((u >> 16) & 1u)) >> 16; }
__device__ __forceinline__ unsigned pk2(float lo, float hi) { return f2bf(lo) | (f2bf(hi) << 16); }
typedef __bf16 hbf2_t __attribute__((ext_vector_type(2))); typedef float hf2_t __attribute__((ext_vector_type(2)));
__device__ __forceinline__ unsigned cvtpk(float lo, float hi) { const hf2_t v = {lo, hi}; const hbf2_t r = __builtin_convertvector(v, hbf2_t); return __builtin_bit_cast(unsigned, r); }
#define XB_TMO      128
#define XB_XCNT(j)  (256  + 64 * (j))
#define XB_XSUB(j)  (1280 + 64 * (j))
#define XB_XGEN(j)  (2304 + 64 * (j))
#define XB_TOP      3328
#define XB_TOPGEN   3392
#define XCD_BAR_WORDS 3456
#define XB_SPIN_CAP (1u << 18)

__device__ __forceinline__ unsigned xb_ld(unsigned* p)              { return __hip_atomic_load(p, __ATOMIC_RELAXED, __HIP_MEMORY_SCOPE_AGENT); }
__device__ __forceinline__ unsigned xb_add(unsigned* p, unsigned v) { return __hip_atomic_fetch_add(p, v, __ATOMIC_RELAXED, __HIP_MEMORY_SCOPE_AGENT); }
__device__ __forceinline__ unsigned xb_xcc_id() { return (unsigned)__builtin_amdgcn_s_getreg((3 << 11) | 20) & 0xFu; }
#define XB_SPIN(cond, bar) do { unsigned _sp = 0; while (cond) { __builtin_amdgcn_s_sleep(1); \
    if ((++_sp & 255u) == 0u) { if (xb_ld(&(bar)[XB_TMO])) break; if (_sp > XB_SPIN_CAP) { atomicAdd(&(bar)[XB_TMO], 1u); break; } } } } while (0)

struct XcdBarrier {
    unsigned* bar; unsigned x;
    volatile LAS unsigned* st;
};

__device__ __forceinline__ XcdBarrier xcd_barrier_post(unsigned* bar, volatile LAS unsigned* st) {
    XcdBarrier b; b.bar = bar; b.x = xb_xcc_id(); b.st = st;
    if (threadIdx.x == 0) (void)xb_add(&bar[XB_XCNT(b.x)], 1u);
    return b;
}
__device__ __forceinline__ void xcd_barrier_complete(unsigned* bar, unsigned x, unsigned& nloc, unsigned& nx) {
    const unsigned G = gridDim.x * gridDim.y * gridDim.z;
    unsigned sum, cnt, mine, sp = 0u;
    for (;;) {
        sum = 0u; cnt = 0u; mine = 0u;
#pragma unroll
        for (unsigned j = 0; j < 16; ++j) { const unsigned c = xb_ld(&bar[XB_XCNT(j)]); sum += c; cnt += (c > 0u) ? 1u : 0u; mine = (j == x) ? c : mine; }
        if (sum == G) break;
        __builtin_amdgcn_s_sleep(1);
        if ((++sp & 255u) == 0u) { if (xb_ld(&bar[XB_TMO])) break; if (sp > XB_SPIN_CAP) { atomicAdd(&bar[XB_TMO], 1u); break; } }
    }
    nloc = mine > 0u ? mine : 1u; nx = cnt > 0u ? cnt : 1u;
}

__device__ __forceinline__ void xcd_barrier(const XcdBarrier& b) {
    asm volatile("s_waitcnt vmcnt(0)" ::: "memory");
    __syncthreads();
    if (threadIdx.x == 0) {
        unsigned* bar = b.bar;
        __builtin_amdgcn_s_waitcnt(0);
        unsigned nloc = b.st[0], nx = b.st[1];
        if (nloc == 0u) { xcd_barrier_complete(bar, b.x, nloc, nx); b.st[0] = nloc; b.st[1] = nx; }
        const unsigned old = xb_add(&bar[XB_XSUB(b.x)], 1u);
        const unsigned gen = old / nloc;
        if (old + 1u == (gen + 1u) * nloc) {
            __builtin_amdgcn_fence(__ATOMIC_RELEASE, "agent");
            asm volatile("s_waitcnt vmcnt(0)" ::: "memory");
            const unsigned og = xb_add(&bar[XB_TOP], 1u);
            const unsigned tg = og / nx;
            if (og + 1u == (tg + 1u) * nx) xb_add(&bar[XB_TOPGEN], 1u);
            else XB_SPIN(xb_ld(&bar[XB_TOPGEN]) == tg, bar);
            __builtin_amdgcn_fence(__ATOMIC_ACQUIRE, "agent");
            xb_add(&bar[XB_XGEN(b.x)], 1u);
            asm volatile("s_waitcnt vmcnt(0)" ::: "memory");
        } else {
            XB_SPIN(xb_ld(&bar[XB_XGEN(b.x)]) == gen, bar);
            __builtin_amdgcn_fence(__ATOMIC_ACQUIRE, "agent");
            asm volatile("s_waitcnt vmcnt(0)" ::: "memory");
        }
    }
    __syncthreads();
}
constexpr int NWAVES = 8, NTHR = 512;
constexpr int DM = 1024, BATCH = 8, SEQ = 2048, DEPTH = 2, DECB = 128, WBR = 512, NH = 4, HD = 128, NMEM = 256, DFF = 2816;
constexpr int MPR = BATCH * SEQ;
constexpr int MROWS = MPR + DECB;
constexpr int MP = 16640;
constexpr int NIN = 7176, NU = 7168;
constexpr float LN_EPS = 1e-5f, NORM_EPS = 1e-6f, ALPHA = 1.41421356237309515f;
constexpr int U_XA = 0, U_GQ = 512, U_GK = 1024, U_GV = 1536, U_GZ = 2048, U_HQ = 2560, U_HF = 3072, U_HI = 3584, U_HG = 4096, U_RQ = 4608, U_RK = 5120, U_RV = 5632, U_RG = 6144, U_XQ = 6656;
enum { I_XP = 0, I_XS, I_MEM, I_SLRUH, I_SLRUC, I_SGDNC, I_SGDNS, I_SHGRNS, I_SRETS, I_CK, I_CV, I_WIN, I_LCW, I_LCB, I_LWA, I_LBA, I_LWI, I_LBI, I_LLAM,
       I_GCW, I_GALOG, I_GDT, I_GNW, I_HLB, I_HNW, I_RGW, I_RGB, I_WMK, I_WMV, I_WMG, I_BMG, I_WBR, I_WOUT, I_LN1G, I_LN1B, I_WUP, I_WDN, I_LN2G, I_LN2B, N_INPUTS };
constexpr size_t O_YP = 0, O_YS = O_YP + (size_t)MPR * DM, O_PLH = O_YS + (size_t)DECB * DM, O_PLC = O_PLH + 2 * 8 * 512, O_PGC = O_PLC + 2 * 8 * 3 * 512,
    O_PGS = O_PGC + 2 * 8 * 3 * 1536, O_PHS = O_PGS + 2 * 8 * 4 * 16384, O_PRS = O_PHS + 2 * 8 * 4 * 16384, O_PMK = O_PRS + 2 * 8 * 4 * 16384, O_PMV = O_PMK + (size_t)2 * 8 * 256 * 512,
    O_SLH = O_PMV + (size_t)2 * 8 * 256 * 512, O_SLC = O_SLH + 2 * 128 * 512, O_SGC = O_SLC + 2 * 128 * 3 * 512, O_SGS = O_SGC + (size_t)2 * 128 * 3 * 1536,
    O_SHS = O_SGS + (size_t)2 * 128 * 4 * 16384, O_SRS = O_SHS + (size_t)2 * 128 * 4 * 16384, O_END = O_SRS + (size_t)2 * 128 * 4 * 16384;
constexpr size_t WS_CTL = 0, CTL_ZERO_BYTES = 1u << 20;
constexpr size_t SZ_WIN = (size_t)NU * DM * 2, SZ_WKV = (size_t)1024 * DM * 2, SZ_WLRU = (size_t)1024 * 512 * 2, SZ_WG = (size_t)5120 * DM * 2, SZ_WB = (size_t)5 * 1024 * 512 * 2,
    SZ_WO5 = (size_t)1024 * 5120 * 2, SZ_WUP = (size_t)5632 * DM * 2, SZ_WDN = (size_t)1024 * DFF * 2;
constexpr size_t WL_WIN = 0, WL_WKV = WL_WIN + SZ_WIN, WL_WLRU = WL_WKV + SZ_WKV, WL_WG = WL_WLRU + SZ_WLRU, WL_WB = WL_WG + SZ_WG, WL_WO5 = WL_WB + SZ_WB, WL_WUP = WL_WO5 + SZ_WO5,
    WL_WDN = WL_WUP + SZ_WUP, WL_SIZE = WL_WDN + SZ_WDN;
constexpr size_t WS_W = CTL_ZERO_BYTES;
constexpr size_t WS_WBA = WS_W + 2 * WL_SIZE;
constexpr size_t WS_LBV = WS_WBA + 2 * 8 * 1024 * 4;
constexpr size_t WS_ROPE = WS_LBV + 2 * 512 * 4;
constexpr size_t WS_XB = WS_ROPE + (size_t)2 * 2049 * 64 * 4 + 512;
constexpr size_t WS_MB = WS_XB + (size_t)MP * DM * 2;
constexpr size_t WS_KB = WS_MB + (size_t)2048 * DM * 2;
constexpr size_t WS_VT = WS_KB + (size_t)8 * 4 * 256 * 128 * 2;
constexpr size_t WS_BETA = WS_VT + (size_t)8 * 4 * 256 * 128 * 2;
constexpr size_t WS_EG = WS_BETA + (size_t)MP * 4 * 4;
constexpr size_t WS_U = WS_EG + (size_t)MP * 4 * 4;
constexpr size_t WS_R2 = WS_U + (size_t)MP * NU * 2;
constexpr size_t SZ_B512 = (size_t)MP * 512 * 2, SZ_F512 = (size_t)MP * 512 * 4;
constexpr size_t WS_XAC = WS_R2, WS_GQ = WS_XAC + SZ_B512, WS_GK = WS_GQ + SZ_B512, WS_GV = WS_GK + SZ_B512, WS_OG = WS_GV + SZ_B512, WS_OH = WS_OG + SZ_F512, WS_OR = WS_OH + SZ_F512;
static_assert(WS_OR + SZ_F512 == WS_R2 + (size_t)MP * 5120 * 2, "R2 map");
constexpr size_t WS_Z = WS_R2 + (size_t)MP * 5120 * 2;
constexpr size_t WS_LA = WS_Z, WS_LB = WS_Z + SZ_F512;
constexpr size_t WS_Y = WS_Z + (size_t)MP * DM * 4;
constexpr size_t WS_END = WS_Y + (size_t)5 * SZ_B512;
static_assert(WS_XB % 256 == 0 && WS_U % 256 == 0 && WS_R2 % 256 == 0 && WS_Z % 256 == 0 && WS_Y % 256 == 0, "alignment");
constexpr int CW_TMO = 0, CW_CODE = 1, CW_BAR = 4096, CW_QUEUE = 16384;
constexpr int SCR_BYTES = 143360;
constexpr int LDSCTL_OFF = SCR_BYTES, MISC_OFF = LDSCTL_OFF + 320, LDS_BYTES = 147456;
#ifndef PHMASK
#define PHMASK 0xFFFFFFFFu
#endif
#define EN(k) (((PHMASK) >> (k)) & 1u)
__device__ __forceinline__ float bflo(unsigned w) { return __uint_as_float(w << 16); }
__device__ __forceinline__ float bfhi(unsigned w) { return __uint_as_float(w & 0xffff0000u); }
__device__ __forceinline__ float sigm(float x) { return 1.0f / (1.0f + __expf(-x)); }
__device__ __forceinline__ float siluf(float x) { return x * sigm(x); }
__device__ __forceinline__ float softplusf(float x) { return (x > 20.f) ? x : log1pf(__expf(x)); }
__device__ __forceinline__ void unpack8(const v4u w, float (&o)[8]) { o[0] = bflo(w.x); o[1] = bfhi(w.x); o[2] = bflo(w.y); o[3] = bfhi(w.y); o[4] = bflo(w.z); o[5] = bfhi(w.z); o[6] = bflo(w.w); o[7] = bfhi(w.w); }
__device__ __forceinline__ v4u pack8(const float (&o)[8]) { v4u w; w.x = cvtpk(o[0], o[1]); w.y = cvtpk(o[2], o[3]); w.z = cvtpk(o[4], o[5]); w.w = cvtpk(o[6], o[7]); return w; }
__device__ __forceinline__ void ld8bf(const bf16* p, float (&o)[8]) { const v4u w = *(const v4u*)p; unpack8(w, o); }
__device__ __forceinline__ void ld8f(const float* p, float (&o)[8]) { const f32x4 a = *(const f32x4*)p, b = *(const f32x4*)(p + 4); o[0] = a.x; o[1] = a.y; o[2] = a.z; o[3] = a.w; o[4] = b.x; o[5] = b.y; o[6] = b.z; o[7] = b.w; }
__device__ __forceinline__ void st8f(float* p, const float (&o)[8]) { *(f32x4*)p = (f32x4){o[0], o[1], o[2], o[3]}; *(f32x4*)(p + 4) = (f32x4){o[4], o[5], o[6], o[7]}; }
template <int CTRL> __device__ __forceinline__ float dppf(float x) { return __builtin_bit_cast(float, __builtin_amdgcn_update_dpp(0, __builtin_bit_cast(int, x), CTRL, 0xf, 0xf, true)); }
__device__ __forceinline__ float row16_sum(float x) {
    x += dppf<0xB1>(x);
    x += dppf<0x4E>(x);
    x += dppf<0x141>(x);
    x += dppf<0x140>(x);
    return x;
}
__device__ __forceinline__ float wave_sum(float v) {
#pragma unroll
    for (int o = 1; o < 64; o <<= 1) v += __shfl_xor(v, o);
    return v;
}

struct Args { const float* in[N_INPUTS]; float* out; unsigned char* ws; };
struct Frame {
    LAS unsigned char* lds;
    volatile LAS unsigned* MISC;
    gu32* ctl;
    int tid, lane, wave, vcu, G;
    const Args* ap; size_t z;
    float* out; unsigned char* ws;
};
#define WSP(T, off) ((T*)(F.ws + (off)))
#define INP(i) (F.ap->in[i] + F.z)

__device__ __forceinline__ void transpose_block(const float* src, int ld, bf16* dst, int ldt, LAS float* scr, int lane) {
#pragma unroll 8
    for (int i = 0; i < 32; ++i) { const int kk = 2 * i + (lane >> 5); scr[kk * 33 + (lane & 31)] = src[(size_t)kk * ld + (lane & 31)]; }
    LDS_WAIT(); asm volatile("" ::: "memory");
    const int c = lane & 7;
#pragma unroll
    for (int j = 0; j < 4; ++j) { const int n = (lane >> 3) + 8 * j; const LAS float* s = scr + (8 * c) * 33 + n;
        v4u o; o.x = pk2(s[0 * 33], s[1 * 33]); o.y = pk2(s[2 * 33], s[3 * 33]); o.z = pk2(s[4 * 33], s[5 * 33]); o.w = pk2(s[6 * 33], s[7 * 33]);
        *(GAS v4u*)(dst + (size_t)n * ldt + 8 * c) = o; }
    LDS_WAIT(); asm volatile("" ::: "memory");
}

__device__ __forceinline__ void p0_prologue(Frame& F) {
    LAS float* scr = (LAS float*)(F.lds + F.wave * 16384);
    const int gw = F.vcu * NWAVES + F.wave, NGW = F.G * NWAVES, lane = F.lane;
    constexpr int IT_IN = 16 * 224, IT_KV = 16 * 32, IT_G = 5 * 16 * 32, IT_B = 5 * 8 * 32, IT_O = 16 * 32, IT_UP = 16 * 176, IT_DN = 44 * 32, IT_LRU = 2 * 4 * 2 * 4;
    constexpr int IT_L = IT_IN + IT_KV + IT_G + IT_B + IT_O + IT_UP + IT_DN + IT_LRU;
#pragma clang loop unroll(disable)
    for (int it = gw; it < 2 * IT_L; it += NGW) {
        const int l = it / IT_L; int r = it % IT_L;
        unsigned char* wl = F.ws + WS_W + (size_t)l * WL_SIZE;
        if (r < IT_IN) { const int kb = r / 224, nb = r % 224, n0 = nb * 32, sc = n0 < 2560 ? n0 : n0 + 8;
            transpose_block(INP(I_WIN) + (size_t)l * DM * NIN + (size_t)(kb * 64) * NIN + sc, NIN, (bf16*)(wl + WL_WIN) + (size_t)n0 * DM + kb * 64, DM, scr, lane); continue; } r -= IT_IN;
        if (r < IT_KV) { const int kb = r / 32, nb = r % 32, n0 = nb * 32; const float* W = (n0 < 512 ? INP(I_WMK) : INP(I_WMV)) + (size_t)l * DM * 512;
            transpose_block(W + (size_t)(kb * 64) * 512 + (n0 & 511), 512, (bf16*)(wl + WL_WKV) + (size_t)n0 * DM + kb * 64, DM, scr, lane); continue; } r -= IT_KV;
        if (r < IT_G) { const int n = r / 512, q = r % 512, kb = q / 32, nb = q % 32;
            transpose_block(INP(I_WMG) + ((size_t)(l * 5 + n) * DM + kb * 64) * DM + nb * 32, DM, (bf16*)(wl + WL_WG) + (size_t)(n * 1024 + nb * 32) * DM + kb * 64, DM, scr, lane); continue; } r -= IT_G;
        if (r < IT_B) { const int n = r / 256, q = r % 256, kb = q / 32, nb = q % 32;
            transpose_block(INP(I_WBR) + ((size_t)(l * 5 + n) * 512 + kb * 64) * DM + nb * 32, DM, (bf16*)(wl + WL_WB) + ((size_t)n * 1024 + nb * 32) * 512 + kb * 64, 512, scr, lane); continue; } r -= IT_B;
        if (r < IT_O) { const int q = r, kb = q / 32, nb = q % 32;
            transpose_block(INP(I_WOUT) + ((size_t)l * DM + kb * 64) * DM + nb * 32, DM, (bf16*)(wl + WL_WO5) + (size_t)(nb * 32) * 1024 + kb * 64, 1024, scr, lane); continue; } r -= IT_O;
        if (r < IT_UP) { const int kb = r / 176, nb = r % 176, c0 = nb * 32, half = c0 >= DFF ? 1 : 0, j0 = c0 - half * DFF, drow = (j0 >> 7) * 256 + half * 128 + (j0 & 127);
            transpose_block(INP(I_WUP) + ((size_t)l * DM + kb * 64) * 5632 + c0, 5632, (bf16*)(wl + WL_WUP) + (size_t)drow * DM + kb * 64, DM, scr, lane); continue; } r -= IT_UP;
        if (r < IT_DN) { const int kb = r / 32, nb = r % 32;
            transpose_block(INP(I_WDN) + ((size_t)l * DFF + kb * 64) * DM + nb * 32, DM, (bf16*)(wl + WL_WDN) + (size_t)(nb * 32) * DFF + kb * 64, DFF, scr, lane); continue; } r -= IT_DN;
        { const int which = r / 32, q = r % 32, h = q / 8, kb = (q % 8) / 4, nb = q % 4;
            const float* W = (which ? INP(I_LWI) : INP(I_LWA)) + ((size_t)(l * 4 + h) * 128 + kb * 64) * 128 + nb * 32;
            transpose_block(W, 128, (bf16*)(wl + WL_WLRU) + (size_t)(h * 256 + which * 128 + nb * 32) * 512 + h * 128 + kb * 64, 512, scr, lane); }
    }
    const size_t gt = (size_t)F.vcu * NTHR + F.tid, GT = (size_t)F.G * NTHR;
#pragma clang loop unroll(disable)
    for (size_t i = gt; i < (size_t)2 * 1024 * 64; i += GT) { const int l = (int)(i / (1024 * 64)), q = (int)(i % (1024 * 64)), row = q / 64, c8 = q % 64, h = row / 256;
        if ((c8 >> 4) != h) *(v4u*)((bf16*)(F.ws + WS_W + (size_t)l * WL_SIZE + WL_WLRU) + (size_t)row * 512 + c8 * 8) = (v4u){0u, 0u, 0u, 0u}; }
#pragma clang loop unroll(disable)
    for (size_t i = gt; i < (size_t)MP * 128; i += GT) { const size_t row = i / 128; const int c = (int)(i % 128) * 8; float v[8] = {0.f, 0.f, 0.f, 0.f, 0.f, 0.f, 0.f, 0.f};
        if (row < MROWS) { ld8f(row < MPR ? INP(I_XP) + row * DM + c : INP(I_XS) + (row - MPR) * DM + c, v); st8f(F.out + row * DM + c, v); }
        *(v4u*)(WSP(bf16, WS_XB) + row * DM + c) = pack8(v); }
#pragma clang loop unroll(disable)
    for (size_t i = gt; i < (size_t)2048 * 128; i += GT) { float v[8]; ld8f(INP(I_MEM) + i * 8, v); *(v4u*)(WSP(bf16, WS_MB) + i * 8) = pack8(v); }
#pragma clang loop unroll(disable)
    for (size_t i = gt; i < (size_t)2 * 8 * 1024; i += GT) { const int l = (int)(i / 8192), c = (int)(i / 1024) % 8, k = (int)(i % 1024); WSP(float, WS_WBA)[i] = INP(I_WIN)[((size_t)l * DM + k) * NIN + 2560 + c]; }
#pragma clang loop unroll(disable)
    for (size_t i = gt; i < 512; i += GT) { const float r0 = INP(I_HLB)[i], r1 = INP(I_HLB)[512 + i], mx = fmaxf(r0, r1), e0 = expf(r0 - mx), e1 = expf(r1 - mx);
        WSP(float, WS_LBV)[i] = 0.f; WSP(float, WS_LBV)[512 + i] = e1 / (e0 + e1); }
#pragma clang loop unroll(disable)
    for (size_t i = gt; i < (size_t)2049 * 64; i += GT) { const int p = (int)(i / 64), j = (int)(i % 64); const double pos = p < 2048 ? (double)p : 16384.0;
        const double inv = exp2(-(double)j * (13.287712379549449 / 64.0)); const double ang = pos * inv;
        WSP(float, WS_ROPE)[i] = (float)cos(ang); WSP(float, WS_ROPE)[(size_t)2049 * 64 + i] = (float)sin(ang); }
}
__device__ __forceinline__ void p2_prepass(Frame& F, int l) {
    const int gw = F.vcu * NWAVES + F.wave, NGW = F.G * NWAVES, lane = F.lane, c8 = lane * 8;
    bf16* U = WSP(bf16, WS_U);
    const float* ropec = WSP(float, WS_ROPE); const float* ropes = ropec + 2049 * 64;
#pragma clang loop unroll(disable)
    for (int m = gw; m < MROWS; m += NGW) {
        const bool prompt = m < MPR; const int b = m >> 11, t = m & 2047, s = m - MPR;
        bf16* urow = U + (size_t)m * NU;
        {   const float* xr = F.out + (size_t)m * DM; const float* wb = WSP(float, WS_WBA) + (size_t)l * 8 * 1024;
            float d[8];
#pragma unroll
            for (int c = 0; c < 8; ++c) d[c] = 0.f;
#pragma unroll
            for (int j = 0; j < 4; ++j) { const f32x4 xv = *(const f32x4*)(xr + 4 * lane + 256 * j);
#pragma unroll
                for (int c = 0; c < 8; ++c) { const f32x4 wv = *(const f32x4*)(wb + c * 1024 + 4 * lane + 256 * j); d[c] += (xv.x * wv.x + xv.y * wv.y) + (xv.z * wv.z + xv.w * wv.w); } }
#pragma unroll
            for (int c = 0; c < 8; ++c) d[c] = wave_sum(d[c]);
            if (lane < 4) { const float db = lane == 0 ? d[0] : lane == 1 ? d[1] : lane == 2 ? d[2] : d[3], da = lane == 0 ? d[4] : lane == 1 ? d[5] : lane == 2 ? d[6] : d[7];
                const float g = -expf(INP(I_GALOG)[l * 4 + lane]) * softplusf(da + INP(I_GDT)[l * 4 + lane]);
                WSP(float, WS_BETA)[(size_t)m * 4 + lane] = sigm(db); WSP(float, WS_EG)[(size_t)m * 4 + lane] = g; } }
        {   float x0[8], x1[8], x2[8], x3[8];
            ld8bf(urow + U_XA + c8, x3);
            if (prompt) {
                if (t >= 1) ld8bf(urow - NU + U_XA + c8, x2); else { for (int e = 0; e < 8; ++e) x2[e] = 0.f; }
                if (t >= 2) ld8bf(urow - 2 * NU + U_XA + c8, x1); else { for (int e = 0; e < 8; ++e) x1[e] = 0.f; }
                if (t >= 3) ld8bf(urow - 3 * NU + U_XA + c8, x0); else { for (int e = 0; e < 8; ++e) x0[e] = 0.f; }
                if (t >= SEQ - 3) st8f(F.out + O_PLC + ((size_t)(l * 8 + b) * 3 + (t - (SEQ - 3))) * 512 + c8, x3);
            } else {
                const float* sb = INP(I_SLRUC) + ((size_t)(l * DECB + s) * 3) * 512 + c8;
                ld8f(sb, x0); ld8f(sb + 512, x1); ld8f(sb + 1024, x2);
                float* so = F.out + O_SLC + ((size_t)(l * DECB + s) * 3) * 512 + c8;
                st8f(so, x1); st8f(so + 512, x2); st8f(so + 1024, x3);
            }
            float w0[8], w1[8], w2[8], w3[8], bb[8], o[8];
            const float* cw = INP(I_LCW) + (size_t)l * 4 * 512 + c8;
            ld8f(cw, w0); ld8f(cw + 512, w1); ld8f(cw + 1024, w2); ld8f(cw + 1536, w3); ld8f(INP(I_LCB) + l * 512 + c8, bb);
#pragma unroll
            for (int e = 0; e < 8; ++e) o[e] = w0[e] * x0[e] + w1[e] * x1[e] + w2[e] * x2[e] + w3[e] * x3[e] + bb[e];
            *(v4u*)(WSP(bf16, WS_XAC) + (size_t)m * 512 + c8) = pack8(o); }
#pragma unroll 1
        for (int grp = 0; grp < 3; ++grp) {
            const int cu = U_GQ + grp * 512 + c8, cc = grp * 512 + c8;
            float x0[8], x1[8], x2[8], x3[8];
            ld8bf(urow + cu, x3);
            if (prompt) {
                if (t >= 1) ld8bf(urow - NU + cu, x2); else { for (int e = 0; e < 8; ++e) x2[e] = 0.f; }
                if (t >= 2) ld8bf(urow - 2 * NU + cu, x1); else { for (int e = 0; e < 8; ++e) x1[e] = 0.f; }
                if (t >= 3) ld8bf(urow - 3 * NU + cu, x0); else { for (int e = 0; e < 8; ++e) x0[e] = 0.f; }
                if (t >= SEQ - 3) st8f(F.out + O_PGC + ((size_t)(l * 8 + b) * 3 + (t - (SEQ - 3))) * 1536 + cc, x3);
            } else {
                const float* sb = INP(I_SGDNC) + ((size_t)(l * DECB + s) * 3) * 1536 + cc;
                ld8f(sb, x0); ld8f(sb + 1536, x1); ld8f(sb + 3072, x2);
                float* so = F.out + O_SGC + ((size_t)(l * DECB + s) * 3) * 1536 + cc;
                st8f(so, x1); st8f(so + 1536, x2); st8f(so + 3072, x3);
            }
            float w0[8], w1[8], w2[8], w3[8], o[8];
            const float* cw = INP(I_GCW) + (size_t)l * 4 * 1536 + cc;
            ld8f(cw, w0); ld8f(cw + 1536, w1); ld8f(cw + 3072, w2); ld8f(cw + 4608, w3);
            float ss = 0.f;
#pragma unroll
            for (int e = 0; e < 8; ++e) { const float v = w0[e] * x0[e] + w1[e] * x1[e] + w2[e] * x2[e] + w3[e] * x3[e]; o[e] = siluf(v); ss += o[e] * o[e]; }
            if (grp < 2) { ss = row16_sum(ss); const float sc = rsqrtf(ss + NORM_EPS) * (grp == 0 ? 0.08838834764831845f : 1.0f);
#pragma unroll
                for (int e = 0; e < 8; ++e) o[e] *= sc; }
            bf16* dst = grp == 0 ? WSP(bf16, WS_GQ) : grp == 1 ? WSP(bf16, WS_GK) : WSP(bf16, WS_GV);
            *(v4u*)(dst + (size_t)m * 512 + c8) = pack8(o);
        }
        {   float q[8], f[8], lb[8]; ld8bf(urow + U_HQ + c8, q); ld8bf(urow + U_HF + c8, f); ld8f(WSP(float, WS_LBV) + l * 512 + c8, lb);
#pragma unroll
            for (int e = 0; e < 8; ++e) { q[e] = siluf(q[e]); f[e] = lb[e] + (1.0f - lb[e]) * sigm(f[e]); }
            *(v4u*)(urow + U_HQ + c8) = pack8(q); *(v4u*)(urow + U_HF + c8) = pack8(f); }
        {   const int ti = prompt ? t : 2048, jj = (lane & 7) * 8; const bool hi = (lane & 8) != 0;
            float cs[8], sn[8]; ld8f(ropec + (size_t)ti * 64 + jj, cs); ld8f(ropes + (size_t)ti * 64 + jj, sn);
#pragma unroll 1
            for (int w = 0; w < 2; ++w) { const int cu = (w ? U_RK : U_RQ) + c8; const float sc = w ? 0.08838834764831845f : 1.0f;
                float x[8], o[8]; ld8bf(urow + cu, x);
#pragma unroll
                for (int e = 0; e < 8; ++e) { const float other = __shfl_xor(x[e], 8); o[e] = (hi ? (x[e] * cs[e] + other * sn[e]) : (x[e] * cs[e] - other * sn[e])) * sc; }
                *(v4u*)(urow + cu) = pack8(o); } }
    }
    {   const size_t gt = (size_t)F.vcu * NTHR + F.tid, GT = (size_t)F.G * NTHR;
        const float* mk = F.out + O_PMK + (size_t)l * 8 * 256 * 512; const float* mv = F.out + O_PMV + (size_t)l * 8 * 256 * 512;
#pragma clang loop unroll(disable)
        for (size_t i = gt; i < (size_t)8 * 4 * 256 * 16; i += GT) { const int d8 = (int)(i % 16), mm = (int)(i / 16) % 256, h = (int)(i / 4096) % 4, b = (int)(i / 16384);
            float v[8]; ld8f(mk + ((size_t)(b * 256 + mm) * 4 + h) * 128 + d8 * 8, v); *(v4u*)(WSP(bf16, WS_KB) + (((size_t)(b * 4 + h) * 256 + mm) * 128 + d8 * 8)) = pack8(v); }
#pragma clang loop unroll(disable)
        for (size_t i = gt; i < (size_t)8 * 4 * 128 * 32; i += GT) { const int m8 = (int)(i % 32), d = (int)(i / 32) % 128, h = (int)(i / 4096) % 4, b = (int)(i / 16384);
            float v[8];
#pragma unroll
            for (int e = 0; e < 8; ++e) v[e] = mv[((size_t)(b * 256 + m8 * 8 + e) * 4 + h) * 128 + d];
            *(v4u*)(WSP(bf16, WS_VT) + (((size_t)(b * 4 + h) * 128 + d) * 256 + m8 * 8)) = pack8(v); }
    }
}
constexpr int SQ_A = 0, SQ_Q = 16384, SQ_V = 32768, SQ_SC = 36864, SQ_BUF = 37376, SQ_O = 2 * SQ_BUF, SQ_OBYTES = 8192;
struct SeqArgs { const bf16* A; const bf16* Q; const bf16* V; int lda, ldq, ldv; const float* beta; const float* eg; float gamma; const float* S0; float* Sout; float* O; int T; int vs0, vs1; };
template <int TYPE>
__device__ __forceinline__ void seq_unit(Frame& F, const SeqArgs& a) {
    LAS unsigned char* lds = F.lds;
    const int tid = F.tid, lane = F.lane, kg = lane & 15, v = 4 * F.wave + (lane >> 4);
    const int nch = (a.T + 63) >> 6;
    for (int vs = a.vs0; vs < a.vs1; ++vs) {
        const int v0 = vs * 32;
        float S[8];
#pragma unroll
        for (int i = 0; i < 8; ++i) S[i] = a.S0 ? a.S0[(size_t)(8 * kg + i) * 128 + v0 + v] : 0.f;
        v4u ra0 = (v4u){0u,0u,0u,0u}, ra1 = ra0, rq0 = ra0, rq1 = ra0, rv = ra0; float rsb = 0.f, rse = 0.f;
#define SQ_GLOAD(c_) do { const int t0 = (c_) * 64; \
            { const int p = tid, row = p >> 4, cc = p & 15; const bool ok = t0 + row < a.T; \
              ra0 = ok ? *(const v4u*)(a.A + (size_t)(t0 + row) * a.lda + cc * 8) : (v4u){0u, 0u, 0u, 0u}; rq0 = ok ? *(const v4u*)(a.Q + (size_t)(t0 + row) * a.ldq + cc * 8) : (v4u){0u, 0u, 0u, 0u}; } \
            { const int p = tid + 512, row = p >> 4, cc = p & 15; const bool ok = t0 + row < a.T; \
              ra1 = ok ? *(const v4u*)(a.A + (size_t)(t0 + row) * a.lda + cc * 8) : (v4u){0u, 0u, 0u, 0u}; rq1 = ok ? *(const v4u*)(a.Q + (size_t)(t0 + row) * a.ldq + cc * 8) : (v4u){0u, 0u, 0u, 0u}; } \
            if (tid < 256) { const int row = tid >> 2, cc = tid & 3; rv = (t0 + row < a.T) ? *(const v4u*)(a.V + (size_t)(t0 + row) * a.ldv + v0 + cc * 8) : (v4u){0u, 0u, 0u, 0u}; } \
            if (TYPE == 0 && tid >= 256 && tid < 320) { const int row = tid - 256; if (t0 + row < a.T) { rsb = a.beta[(size_t)(t0 + row) * 4]; rse = __expf(a.eg[(size_t)(t0 + row) * 4]); } else { rsb = 0.f; rse = 1.f; } } } while (0)
#define SQ_LSTORE(buf_) do { LAS unsigned char* B_ = lds + (buf_) * SQ_BUF; \
            *(LAS v4u*)(B_ + SQ_A + tid * 16) = ra0; *(LAS v4u*)(B_ + SQ_A + (tid + 512) * 16) = ra1; \
            *(LAS v4u*)(B_ + SQ_Q + tid * 16) = rq0; *(LAS v4u*)(B_ + SQ_Q + (tid + 512) * 16) = rq1; \
            if (tid < 256) *(LAS v4u*)(B_ + SQ_V + tid * 16) = rv; \
            if (TYPE == 0 && tid >= 256 && tid < 320) { ((LAS float*)(B_ + SQ_SC))[(tid - 256) * 2] = rsb; ((LAS float*)(B_ + SQ_SC))[(tid - 256) * 2 + 1] = rse; } } while (0)
        SQ_GLOAD(0); SQ_LSTORE(0);
        __syncthreads();
        for (int c = 0; c < nch; ++c) {
            const int buf = c & 1;
            if (c + 1 < nch) SQ_GLOAD(c + 1);
            const LAS unsigned char* B = lds + buf * SQ_BUF;
            LAS float* Ob = (LAS float*)(lds + SQ_O + buf * SQ_OBYTES);
            const int n = (a.T - c * 64) < 64 ? (a.T - c * 64) : 64;
#pragma unroll 4
            for (int tt = 0; tt < n; ++tt) {
                float kk[8], qq[8];
                unpack8(*(const LAS v4u*)(B + SQ_A + tt * 256 + kg * 16), kk);
                unpack8(*(const LAS v4u*)(B + SQ_Q + tt * 256 + kg * 16), qq);
                const float vv = __uint_as_float((unsigned)(*(const LAS unsigned short*)(B + SQ_V + tt * 64 + v * 2)) << 16);
                if (TYPE == 0) {
                    const float be = ((const LAS float*)(B + SQ_SC))[tt * 2], eg = ((const LAS float*)(B + SQ_SC))[tt * 2 + 1];
                    float ks = (kk[0] * S[0] + kk[1] * S[1]) + (kk[2] * S[2] + kk[3] * S[3]) + ((kk[4] * S[4] + kk[5] * S[5]) + (kk[6] * S[6] + kk[7] * S[7]));
                    ks = row16_sum(ks);
                    const float uu = be * (vv - eg * ks);
#pragma unroll
                    for (int i = 0; i < 8; ++i) S[i] = eg * S[i] + kk[i] * uu;
                } else if (TYPE == 1) {
#pragma unroll
                    for (int i = 0; i < 8; ++i) S[i] = kk[i] * S[i] + (1.0f - kk[i]) * vv;
                } else {
#pragma unroll
                    for (int i = 0; i < 8; ++i) S[i] = a.gamma * S[i] + kk[i] * vv;
                }
                float o = (qq[0] * S[0] + qq[1] * S[1]) + (qq[2] * S[2] + qq[3] * S[3]) + ((qq[4] * S[4] + qq[5] * S[5]) + (qq[6] * S[6] + qq[7] * S[7]));
                o = row16_sum(o);
                if (kg == 0) Ob[tt * 32 + v] = o;
            }
            if (c + 1 < nch) SQ_LSTORE(buf ^ 1);
            __syncthreads();
            { const int row = tid >> 3, c4 = tid & 7; if (c * 64 + row < a.T) *(f32x4*)(a.O + (size_t)(c * 64 + row) * 512 + v0 + c4 * 4) = *(const LAS f32x4*)((const LAS unsigned char*)Ob + row * 128 + c4 * 16); }
        }
#pragma unroll
        for (int i = 0; i < 8; ++i) a.Sout[(size_t)(8 * kg + i) * 128 + v0 + v] = S[i];
        __syncthreads();
    }
}

__device__ __forceinline__ void lru_scan_unit(Frame& F, int l, int b, int cg) {
    const int tid = F.tid, seg = tid >> 5, ch = cg * 32 + (tid & 31);
    const float* LA = WSP(float, WS_LA) + ((size_t)(b * SEQ + seg * 128)) * 512 + ch; const float* LB = WSP(float, WS_LB) + ((size_t)(b * SEQ + seg * 128)) * 512 + ch;
    LAS float* car = (LAS float*)F.lds;
    float A = 1.f, Bc = 0.f;
#pragma unroll 8
    for (int t = 0; t < 128; ++t) { const float av = LA[(size_t)t * 512], bv = LB[(size_t)t * 512]; Bc = av * Bc + bv; A *= av; }
    car[(seg * 32 + (tid & 31)) * 2] = A; car[(seg * 32 + (tid & 31)) * 2 + 1] = Bc;
    __syncthreads();
    float h = 0.f;
    for (int s2 = 0; s2 < seg; ++s2) h = car[(s2 * 32 + (tid & 31)) * 2] * h + car[(s2 * 32 + (tid & 31)) * 2 + 1];
    bf16* Y = WSP(bf16, WS_Y) + ((size_t)(b * SEQ + seg * 128)) * 512 + ch;
#pragma unroll 8
    for (int t = 0; t < 128; ++t) { const float av = LA[(size_t)t * 512], bv = LB[(size_t)t * 512]; h = av * h + bv; Y[(size_t)t * 512] = (bf16)f2bf(h); }
    if (seg == 15) F.out[O_PLH + (size_t)(l * 8 + b) * 512 + ch] = h;
    __syncthreads();
}

constexpr int XK_STRIDE = 272, XV_STRIDE = 528, XV_OFF = 256 * XK_STRIDE;
static_assert(XV_OFF + 128 * XV_STRIDE <= SCR_BYTES, "cross-attention LDS");
__device__ __forceinline__ void cross_prompt_unit(Frame& F, int b, int h, int tb) {
    LAS unsigned char* lds = F.lds; const int tid = F.tid, lane = F.lane, g = lane >> 4, lr = lane & 15;
    const bf16* Kb = WSP(bf16, WS_KB) + (size_t)(b * 4 + h) * 256 * 128; const bf16* Vt = WSP(bf16, WS_VT) + (size_t)(b * 4 + h) * 128 * 256;
#pragma unroll
    for (int i = 0; i < 8; ++i) { const int p = tid + 512 * i, row = p >> 4, c = p & 15; *(LAS v4u*)(lds + row * XK_STRIDE + c * 16) = *(const v4u*)(Kb + (size_t)row * 128 + c * 8); }
#pragma unroll
    for (int i = 0; i < 8; ++i) { const int p = tid + 512 * i, row = p >> 5, c = p & 31; *(LAS v4u*)(lds + XV_OFF + row * XV_STRIDE + c * 16) = *(const v4u*)(Vt + (size_t)row * 256 + c * 8); }
    __syncthreads();
    const bf16* U = WSP(bf16, WS_U); bf16* Y4 = WSP(bf16, WS_Y) + (size_t)4 * MP * 512;
    typedef float f4 __attribute__((ext_vector_type(4)));
#pragma unroll 1
    for (int gi = 0; gi < 4; ++gi) {
        const int m0 = b * SEQ + tb * 512 + (F.wave + 8 * gi) * 16;
        bf16x8 qf[4];
#pragma unroll
        for (int ks = 0; ks < 4; ++ks) qf[ks] = *(const bf16x8*)(U + (size_t)(m0 + lr) * NU + U_XQ + h * 128 + 32 * ks + 8 * g);
        f4 st[16];
#pragma unroll
        for (int mt = 0; mt < 16; ++mt) { f4 acc = (f4){0.f, 0.f, 0.f, 0.f};
#pragma unroll
            for (int ks = 0; ks < 4; ++ks) { const bf16x8 af = *(const LAS bf16x8*)(lds + (16 * mt + lr) * XK_STRIDE + (32 * ks + 8 * g) * 2); acc = __builtin_amdgcn_mfma_f32_16x16x32_bf16(af, qf[ks], acc, 0, 0, 0); }
            st[mt] = acc; __builtin_amdgcn_sched_barrier(0); }
        float mx = -3.0e38f;
#pragma unroll
        for (int mt = 0; mt < 16; ++mt) mx = fmaxf(mx, fmaxf(fmaxf(st[mt][0], st[mt][1]), fmaxf(st[mt][2], st[mt][3])));
        mx = fmaxf(mx, __shfl_xor(mx, 16)); mx = fmaxf(mx, __shfl_xor(mx, 32));
        const float sc = 0.08838834764831845f; float sum = 0.f;
#pragma unroll
        for (int mt = 0; mt < 16; ++mt)
#pragma unroll
            for (int r = 0; r < 4; ++r) { const float p = __expf((st[mt][r] - mx) * sc); st[mt][r] = p; sum += p; }
        sum += __shfl_xor(sum, 16); sum += __shfl_xor(sum, 32);
        const float inv = 1.0f / sum;
        bf16x8 pf[8];
#pragma unroll
        for (int k2 = 0; k2 < 8; ++k2) { v4u w; w.x = pk2(st[2 * k2][0], st[2 * k2][1]); w.y = pk2(st[2 * k2][2], st[2 * k2][3]); w.z = pk2(st[2 * k2 + 1][0], st[2 * k2 + 1][1]); w.w = pk2(st[2 * k2 + 1][2], st[2 * k2 + 1][3]);
            pf[k2] = __builtin_bit_cast(bf16x8, w); }
#pragma unroll
        for (int dt = 0; dt < 8; ++dt) { f4 acc = (f4){0.f, 0.f, 0.f, 0.f};
#pragma unroll
            for (int k2 = 0; k2 < 8; ++k2) { const LAS unsigned char* vp = lds + XV_OFF + (16 * dt + lr) * XV_STRIDE + (32 * k2 + 4 * g) * 2;
                const unsigned long long lo = *(const LAS unsigned long long*)vp, hi = *(const LAS unsigned long long*)(vp + 32);
                v4u w; w.x = (unsigned)lo; w.y = (unsigned)(lo >> 32); w.z = (unsigned)hi; w.w = (unsigned)(hi >> 32);
                acc = __builtin_amdgcn_mfma_f32_16x16x32_bf16(__builtin_bit_cast(bf16x8, w), pf[k2], acc, 0, 0, 0); }
            unsigned long long o = (unsigned long long)pk2(acc[0] * inv, acc[1] * inv) | ((unsigned long long)pk2(acc[2] * inv, acc[3] * inv) << 32);
            *(unsigned long long*)(Y4 + (size_t)(m0 + lr) * 512 + h * 128 + 16 * dt + 4 * g) = o; __builtin_amdgcn_sched_barrier(0); }
    }
    __syncthreads();
}

constexpr int XS_KROW = 132, XS_SM = 256 * XS_KROW;
static_assert((XS_SM + 1024) * 4 <= SCR_BYTES, "sample cross-attention LDS");
__device__ __forceinline__ void cross_sample_unit(Frame& F, int l, int s, int h) {
    const int tid = F.tid; LAS float* kim = (LAS float*)F.lds; LAS float* sm = kim + XS_SM;
    const bf16* U = WSP(bf16, WS_U);
    const float* K = INP(I_CK) + (((size_t)(l * DECB + s) * 256) * 4 + h) * 128; const float* V = INP(I_CV) + (((size_t)(l * DECB + s) * 256) * 4 + h) * 128;
    { const int rr = tid >> 5, c4 = tid & 31;
#pragma unroll
      for (int p = 0; p < 16; ++p) { const int row = rr + 16 * p; *(LAS f32x4*)(kim + row * XS_KROW + 4 * c4) = *(const f32x4*)(K + (size_t)row * 512 + 4 * c4); } }
    if (tid < 128) sm[tid] = bflo((unsigned)U[(size_t)(MPR + s) * NU + U_XQ + h * 128 + tid]);
    __syncthreads();
    { const int mm = tid >> 1, hf = tid & 1; const LAS float* kr = kim + mm * XS_KROW + hf * 64; float d = 0.f;
#pragma unroll
      for (int j = 0; j < 16; ++j) { const f32x4 kv = *(const LAS f32x4*)(kr + 4 * j); const LAS float* q = sm + hf * 64 + 4 * j; d += (kv.x * q[0] + kv.y * q[1]) + (kv.z * q[2] + kv.w * q[3]); }
      d += __shfl_xor(d, 1);
      if (hf == 0) sm[128 + mm] = d * 0.08838834764831845f; }
    __syncthreads();
    float mx = -3.0e38f;
    for (int j = 0; j < 256; ++j) mx = fmaxf(mx, sm[128 + j]);
    float sum = 0.f;
    for (int j = 0; j < 256; ++j) sum += __expf(sm[128 + j] - mx);
    { const int d = tid & 127, q4 = tid >> 7; float o = 0.f;
#pragma unroll 16
      for (int j = 0; j < 64; ++j) { const int mm = q4 * 64 + j; o += __expf(sm[128 + mm] - mx) * V[(size_t)mm * 512 + d]; }
      sm[384 + q4 * 128 + d] = o; }
    __syncthreads();
    if (tid < 128) { const float o = (sm[384 + tid] + sm[512 + tid]) + (sm[640 + tid] + sm[768 + tid]);
        WSP(bf16, WS_Y)[(size_t)4 * MP * 512 + (size_t)(MPR + s) * 512 + h * 128 + tid] = (bf16)f2bf(o / sum); }
    __syncthreads();
}

__device__ __forceinline__ size_t blk_off(int ld, int r, int j) { return (size_t)(r >> 3) * ld + (r & 7) * 16 + j; }
constexpr int CP_ROW = 272, CP_WAVE = 10240;
constexpr size_t WS_AQK = WS_END;
constexpr size_t WS_DEC = WS_AQK + (size_t)3 * 4096 * 256 * 2;
constexpr size_t WS_DG = WS_DEC + (size_t)4096 * 128 * 4;
constexpr size_t WS_WN = WS_DG + 4096 * 4;
constexpr size_t WS_END2 = WS_WN + SZ_B512;
template <int BR>
__device__ __forceinline__ void p3b_chunkprep_br(Frame& F, int l) {
    constexpr int br = BR;
    const int gw = F.vcu * NWAVES + F.wave, NGW = F.G * NWAVES, lane = F.lane, g = lane >> 4, lr = lane & 15;
    LAS unsigned char* wl = F.lds + F.wave * CP_WAVE;
    LAS float* akk = (LAS float*)(wl + 8704); LAS float* Gs = (LAS float*)(wl + 9728); LAS float* Bs = (LAS float*)(wl + 9792);
    bf16* U = WSP(bf16, WS_U);
#pragma clang loop unroll(disable)
    for (int it = gw; it < 4096; it += NGW) {
        const int q = it, b = q >> 9, c = (q >> 2) & 127, h = q & 3;
        const size_t m0 = (size_t)b * SEQ + c * 16; const int blk = (b * 128 + c) * 4 + h;
        bf16 *pq, *pk, *pv; constexpr int ld = (BR == 0) ? 512 : NU;
        if (br == 0) { pq = WSP(bf16, WS_GQ) + m0 * 512 + h * 128; pk = WSP(bf16, WS_GK) + m0 * 512 + h * 128; pv = WSP(bf16, WS_GV) + m0 * 512 + h * 128; }
        else if (br == 1) { pq = U + m0 * NU + U_HQ + h * 128; pk = U + m0 * NU + U_HF + h * 128; pv = U + m0 * NU + U_HI + h * 128; }
        else { pq = U + m0 * NU + U_RQ + h * 128; pk = U + m0 * NU + U_RK + h * 128; pv = U + m0 * NU + U_RV + h * 128; }
        float qv[16][2], kv[16][2], vv[16][2];
        size_t lo2 = 2 * lane; asm volatile("" : "+v"(lo2)); bf16* pql = pq + lo2; const bf16* pkl = pk + lo2; const bf16* pvl = pv + lo2;
#pragma unroll
        for (int j = 0; j < 16; ++j) { const unsigned wq = *(const unsigned*)(pql + (size_t)j * ld), wk = *(const unsigned*)(pkl + (size_t)j * ld), wv = *(const unsigned*)(pvl + (size_t)j * ld);
            qv[j][0] = bflo(wq); qv[j][1] = bfhi(wq); kv[j][0] = bflo(wk); kv[j][1] = bfhi(wk); vv[j][0] = bflo(wv); vv[j][1] = bfhi(wv); }
        asm volatile("s_waitcnt vmcnt(0)" ::: "memory");
        float Gt[16];
        float bet[16];
        if (br == 0) { float acc = 0.f;
#pragma unroll
            for (int j = 0; j < 16; ++j) { float gj = WSP(float, WS_EG)[(m0 + j) * 4 + h], bj = WSP(float, WS_BETA)[(m0 + j) * 4 + h]; asm volatile("" : "+v"(gj), "+v"(bj));
                acc += gj; Gt[j] = acc; bet[j] = bj; } }
        else if (br == 2) { float lg = logf(1.0f - exp2f(-5.0f - (float)h)); asm volatile("" : "+v"(lg));
#pragma unroll
            for (int j = 0; j < 16; ++j) { Gt[j] = (float)(j + 1) * lg; bet[j] = 0.f; } }
        else {
#pragma unroll
            for (int j = 0; j < 16; ++j) { Gt[j] = 0.f; bet[j] = 0.f; } }
        if (br == 1) {
            float G0[16], G1[16]; float a0 = 0.f, a1 = 0.f;
#pragma unroll
            for (int j = 0; j < 16; ++j) { a0 += __logf(fmaxf(kv[j][0], 1e-30f)); a1 += __logf(fmaxf(kv[j][1], 1e-30f)); G0[j] = a0; G1[j] = a1; }
            const float mid0 = G0[7], mid1 = G1[7], e0 = G0[15], e1 = G1[15];
            unsigned ket0[8], ket1[8], vt0[8], vt1[8];
#pragma unroll
            for (int j = 0; j < 16; ++j) { const float k0 = 1.0f - kv[j][0], k1 = 1.0f - kv[j][1];
                *(LAS unsigned*)(wl + j * CP_ROW + 4 * lane) = pk2(k0 * __expf(mid0 - G0[j]), k1 * __expf(mid1 - G1[j]));
                *(LAS unsigned*)(wl + 4352 + j * CP_ROW + 4 * lane) = pk2(qv[j][0] * __expf(G0[j] - mid0), qv[j][1] * __expf(G1[j] - mid1));
                *(unsigned*)(pql + (size_t)j * ld) = pk2(qv[j][0] * __expf(G0[j]), qv[j][1] * __expf(G1[j]));
                const float t0 = k0 * __expf(e0 - G0[j]), t1 = k1 * __expf(e1 - G1[j]);
                if (j & 1) { ket0[j >> 1] |= f2bf(t0) << 16; ket1[j >> 1] |= f2bf(t1) << 16; vt0[j >> 1] |= f2bf(vv[j][0]) << 16; vt1[j >> 1] |= f2bf(vv[j][1]) << 16; }
                else { ket0[j >> 1] = f2bf(t0); ket1[j >> 1] = f2bf(t1); vt0[j >> 1] = f2bf(vv[j][0]); vt1[j >> 1] = f2bf(vv[j][1]); } }
            { bf16* d = pk + blk_off(ld, 2 * lane, 0); *(v4u*)d = (v4u){ket0[0], ket0[1], ket0[2], ket0[3]}; *(v4u*)(d + 8) = (v4u){ket0[4], ket0[5], ket0[6], ket0[7]};
              *(v4u*)(d + 16) = (v4u){ket1[0], ket1[1], ket1[2], ket1[3]}; *(v4u*)(d + 24) = (v4u){ket1[4], ket1[5], ket1[6], ket1[7]}; }
            { bf16* d = pv + blk_off(ld, 2 * lane, 0); *(v4u*)d = (v4u){vt0[0], vt0[1], vt0[2], vt0[3]}; *(v4u*)(d + 8) = (v4u){vt0[4], vt0[5], vt0[6], vt0[7]};
              *(v4u*)(d + 16) = (v4u){vt1[0], vt1[1], vt1[2], vt1[3]}; *(v4u*)(d + 24) = (v4u){vt1[4], vt1[5], vt1[6], vt1[7]}; }
            { float* dd = WSP(float, WS_DEC) + (size_t)blk * 128 + 2 * lane; dd[0] = __expf(e0); dd[1] = __expf(e1); }
        } else {
            unsigned ket0[8], ket1[8], vt0[8], vt1[8];
#pragma unroll
            for (int j = 0; j < 16; ++j) {
                *(LAS unsigned*)(wl + j * CP_ROW + 4 * lane) = pk2(kv[j][0], kv[j][1]);
                *(LAS unsigned*)(wl + 4352 + j * CP_ROW + 4 * lane) = pk2(qv[j][0], qv[j][1]);
                const float eq = __expf(Gt[j]), ek = __expf(Gt[15] - Gt[j]);
                *(unsigned*)(pql + (size_t)j * ld) = pk2(qv[j][0] * eq, qv[j][1] * eq);
                const float t0 = kv[j][0] * ek, t1 = kv[j][1] * ek;
                if (j & 1) { ket0[j >> 1] |= f2bf(t0) << 16; ket1[j >> 1] |= f2bf(t1) << 16; vt0[j >> 1] |= f2bf(vv[j][0]) << 16; vt1[j >> 1] |= f2bf(vv[j][1]) << 16; }
                else { ket0[j >> 1] = f2bf(t0); ket1[j >> 1] = f2bf(t1); vt0[j >> 1] = f2bf(vv[j][0]); vt1[j >> 1] = f2bf(vv[j][1]); } }
            { bf16* d = pk + blk_off(ld, 2 * lane, 0); *(v4u*)d = (v4u){ket0[0], ket0[1], ket0[2], ket0[3]}; *(v4u*)(d + 8) = (v4u){ket0[4], ket0[5], ket0[6], ket0[7]};
              *(v4u*)(d + 16) = (v4u){ket1[0], ket1[1], ket1[2], ket1[3]}; *(v4u*)(d + 24) = (v4u){ket1[4], ket1[5], ket1[6], ket1[7]}; }
            if (br == 2) { bf16* d = pv + blk_off(ld, 2 * lane, 0); *(v4u*)d = (v4u){vt0[0], vt0[1], vt0[2], vt0[3]}; *(v4u*)(d + 8) = (v4u){vt0[4], vt0[5], vt0[6], vt0[7]};
              *(v4u*)(d + 16) = (v4u){vt1[0], vt1[1], vt1[2], vt1[3]}; *(v4u*)(d + 24) = (v4u){vt1[4], vt1[5], vt1[6], vt1[7]}; }
            if (br == 0 && lane == 0) WSP(float, WS_DG)[blk] = __expf(Gt[15]);
        }
        if (lane < 16) { float gsel = Gt[0], bsel = bet[0];
#pragma unroll
            for (int j = 1; j < 16; ++j) { gsel = (lane == j) ? Gt[j] : gsel; bsel = (lane == j) ? bet[j] : bsel; }
            Gs[lane] = gsel; Bs[lane] = bsel; }
        asm volatile("s_waitcnt lgkmcnt(0)" ::: "memory");
        f32x4 cq = (f32x4){0.f, 0.f, 0.f, 0.f}, ck = (f32x4){0.f, 0.f, 0.f, 0.f};
#pragma unroll
        for (int ks = 0; ks < 4; ++ks) { const bf16x8 ka = *(const LAS bf16x8*)(wl + lr * CP_ROW + (32 * ks + 8 * g) * 2), qb = *(const LAS bf16x8*)(wl + 4352 + lr * CP_ROW + (32 * ks + 8 * g) * 2);
            cq = __builtin_amdgcn_mfma_f32_16x16x32_bf16(ka, qb, cq, 0, 0, 0);
            if (br == 0) ck = __builtin_amdgcn_mfma_f32_16x16x32_bf16(ka, ka, ck, 0, 0, 0); }
        {   const float Gi = Gs[lr], bi = Bs[lr]; float aq[4], ak[4];
#pragma unroll
            for (int r = 0; r < 4; ++r) { const int j = 4 * g + r; const float dcy = (br == 1) ? 1.0f : __expf(fminf(Gi - Gs[j], 0.f));
                aq[r] = (lr >= j) ? cq[r] * dcy : 0.f; ak[r] = (lr > j) ? ck[r] * dcy * bi : 0.f; }
            *(unsigned long long*)(WSP(bf16, WS_AQK) + ((size_t)br * 4096 + blk) * 256 + lr * 16 + 4 * g) = (unsigned long long)pk2(aq[0], aq[1]) | ((unsigned long long)pk2(aq[2], aq[3]) << 32);
            if (br == 0) *(LAS f32x4*)(akk + lr * 16 + 4 * g) = (f32x4){ak[0], ak[1], ak[2], ak[3]}; }
        if (br == 0) {
            asm volatile("s_waitcnt lgkmcnt(0)" ::: "memory");
            float X[16][4];
#pragma unroll
            for (int i = 0; i < 16; ++i) { const float eb = bet[i] * __expf(Gt[i]);
                float x0 = bet[i] * vv[i][0], x1 = bet[i] * vv[i][1], x2 = eb * kv[i][0], x3 = eb * kv[i][1];
#pragma unroll
                for (int j = 0; j < i; ++j) { const float a = akk[i * 16 + j]; x0 -= a * X[j][0]; x1 -= a * X[j][1]; x2 -= a * X[j][2]; x3 -= a * X[j][3]; }
                X[i][0] = x0; X[i][1] = x1; X[i][2] = x2; X[i][3] = x3;
                *(unsigned*)(WSP(bf16, WS_WN) + (m0 + i) * 512 + h * 128 + 2 * lane) = pk2(-x2, -x3); }
            unsigned u0[8], u1[8];
#pragma unroll
            for (int j = 0; j < 8; ++j) { u0[j] = pk2(X[2 * j][0], X[2 * j + 1][0]); u1[j] = pk2(X[2 * j][1], X[2 * j + 1][1]); }
            bf16* d = pv + blk_off(ld, 2 * lane, 0); *(v4u*)d = (v4u){u0[0], u0[1], u0[2], u0[3]}; *(v4u*)(d + 8) = (v4u){u0[4], u0[5], u0[6], u0[7]};
            *(v4u*)(d + 16) = (v4u){u1[0], u1[1], u1[2], u1[3]}; *(v4u*)(d + 24) = (v4u){u1[4], u1[5], u1[6], u1[7]};
        }
        asm volatile("s_waitcnt lgkmcnt(0)" ::: "memory");
    }
}

__device__ __forceinline__ void p3b_chunkprep(Frame& F, int l) { p3b_chunkprep_br<0>(F, l); p3b_chunkprep_br<1>(F, l); p3b_chunkprep_br<2>(F, l); }
constexpr int ST_ROW = 272, ST_BUF = 32 * ST_ROW;
constexpr int IM_W = 0, IM_Q = 4352, IM_KET = 8704, IM_VT = 12800, IM_AQ = 13824, IM_DEC = 14336, IM_BYTES = 14848, IM_OFF = 2 * ST_BUF;
struct ScPtr { const bf16 *pq, *pk, *pv, *pw, *paq; const float *pdec, *pdg; float* O; int vs; float gam16; };
struct ScStage { v4u a, b; };
template <int TYPE>
__device__ __forceinline__ void sc_issue(ScStage& R, const ScPtr& P, int c, int tid) {
    constexpr int ld = (TYPE == 0) ? 512 : NU; const size_t mc = (size_t)c * 16; const int r = (tid & 255) >> 4, p = tid & 15;
    R.a = (v4u){0u, 0u, 0u, 0u}; R.b = (v4u){0u, 0u, 0u, 0u};
    if (tid >= 256) R.a = *(const v4u*)(P.pq + (mc + r) * ld + p * 8);
    else if (TYPE == 0) R.a = *(const v4u*)(P.pw + (mc + r) * 512 + p * 8);
    if (tid < 256) R.b = *(const v4u*)(P.pk + (mc + r) * ld + p * 8);
    else if (tid < 320) R.b = *(const v4u*)(P.pv + (mc + 4 * P.vs + ((tid - 256) >> 4)) * ld + p * 8);
    else if (tid < 352) R.b = *(const v4u*)(P.paq + (size_t)c * 1024 + (tid - 320) * 8);
    else if (tid < 384) { if (TYPE == 1) R.b = *(const v4u*)(P.pdec + (size_t)c * 512 + (tid - 352) * 4); else if (TYPE == 0) R.b.x = __float_as_uint(P.pdg[(size_t)c * 4]); }
}
template <int TYPE>
__device__ __forceinline__ void sc_write(const ScStage& R, LAS unsigned char* img, int tid) {
    const int r = (tid & 255) >> 4, p = tid & 15;
    if (tid >= 256) *(LAS v4u*)(img + IM_Q + r * 272 + p * 16) = R.a;
    else if (TYPE == 0) *(LAS v4u*)(img + IM_W + r * 272 + p * 16) = R.a;
    if (tid < 256) *(LAS v4u*)(img + IM_KET + tid * 16) = R.b;
    else if (tid < 320) *(LAS v4u*)(img + IM_VT + (tid - 256) * 16) = R.b;
    else if (tid < 352) *(LAS v4u*)(img + IM_AQ + (tid - 320) * 16) = R.b;
    else if (tid < 384) *(LAS v4u*)(img + IM_DEC + (tid - 352) * 16) = R.b;
}
template <int TYPE>
__device__ __forceinline__ void sc_step(const ScPtr& P, LAS unsigned char* lds, int c, int w, int g, int lr, size_t orow, f32x4& S0, f32x4& S1) {
    const LAS unsigned char* Sc = lds + (c & 1) * ST_BUF; LAS unsigned char* Sn = lds + ((c & 1) ^ 1) * ST_BUF;
    const LAS unsigned char* img = lds + IM_OFF + (c & 1) * IM_BYTES;
    bf16x8 sf[2][4];
#pragma unroll
    for (int vt = 0; vt < 2; ++vt)
#pragma unroll
        for (int ks = 0; ks < 4; ++ks) sf[vt][ks] = *(const LAS bf16x8*)(Sc + (16 * vt + lr) * ST_ROW + (32 * ks + 8 * g) * 2);
    const unsigned long long v0 = *(const LAS unsigned long long*)(img + IM_VT + lr * 32 + 8 * g), v1 = *(const LAS unsigned long long*)(img + IM_VT + (16 + lr) * 32 + 8 * g);
    const unsigned long long ket = *(const LAS unsigned long long*)(img + IM_KET + (16 * w + lr) * 32 + 8 * g);
    bf16x8 vfr[2];
    if (TYPE == 0) {
        bf16x8 wf[4];
#pragma unroll
        for (int ks = 0; ks < 4; ++ks) wf[ks] = *(const LAS bf16x8*)(img + IM_W + lr * 272 + (32 * ks + 8 * g) * 2);
#pragma unroll
        for (int vt = 0; vt < 2; ++vt) { const unsigned long long uu = vt ? v1 : v0;
            f32x4 acc = (f32x4){bflo((unsigned)uu), bfhi((unsigned)uu), bflo((unsigned)(uu >> 32)), bfhi((unsigned)(uu >> 32))};
#pragma unroll
            for (int ks = 0; ks < 4; ++ks) acc = __builtin_amdgcn_mfma_f32_16x16x32_bf16(wf[ks], sf[vt][ks], acc, 0, 0, 0);
            vfr[vt] = __builtin_bit_cast(bf16x8, (v4u){cvtpk(acc[0], acc[1]), cvtpk(acc[2], acc[3]), 0u, 0u}); }
    } else {
        vfr[0] = __builtin_bit_cast(bf16x8, (v4u){(unsigned)v0, (unsigned)(v0 >> 32), 0u, 0u}); vfr[1] = __builtin_bit_cast(bf16x8, (v4u){(unsigned)v1, (unsigned)(v1 >> 32), 0u, 0u});
    }
    if (w < 2) { f32x4 acc = (f32x4){0.f, 0.f, 0.f, 0.f};
        const unsigned long long aq = *(const LAS unsigned long long*)(img + IM_AQ + lr * 32 + 8 * g);
#pragma unroll
        for (int ks = 0; ks < 4; ++ks) { const bf16x8 qf = *(const LAS bf16x8*)(img + IM_Q + lr * 272 + (32 * ks + 8 * g) * 2); acc = __builtin_amdgcn_mfma_f32_16x16x32_bf16(w ? sf[1][ks] : sf[0][ks], qf, acc, 0, 0, 0); }
        acc = __builtin_amdgcn_mfma_f32_16x16x32_bf16(w ? vfr[1] : vfr[0], __builtin_bit_cast(bf16x8, (v4u){(unsigned)aq, (unsigned)(aq >> 32), 0u, 0u}), acc, 0, 0, 0);
        *(f32x4*)(P.O + orow + (size_t)c * 16 * 512 + (size_t)lr * 512 + 16 * w + 4 * g) = acc; }
    const bf16x8 kfr = __builtin_bit_cast(bf16x8, (v4u){(unsigned)ket, (unsigned)(ket >> 32), 0u, 0u});
    if (TYPE == 0) { const float ds = *(const LAS float*)(img + IM_DEC); S0 = S0 * ds; S1 = S1 * ds; }
    else if (TYPE == 1) { const f32x4 dec = *(const LAS f32x4*)(img + IM_DEC + (16 * w + 4 * g) * 4); S0 = S0 * dec; S1 = S1 * dec; }
    else { S0 = S0 * P.gam16; S1 = S1 * P.gam16; }
    S0 = __builtin_amdgcn_mfma_f32_16x16x32_bf16(kfr, vfr[0], S0, 0, 0, 0);
    S1 = __builtin_amdgcn_mfma_f32_16x16x32_bf16(kfr, vfr[1], S1, 0, 0, 0);
    *(LAS unsigned long long*)(Sn + lr * ST_ROW + (16 * w + 4 * g) * 2) = (unsigned long long)cvtpk(S0[0], S0[1]) | ((unsigned long long)cvtpk(S0[2], S0[3]) << 32);
    *(LAS unsigned long long*)(Sn + (16 + lr) * ST_ROW + (16 * w + 4 * g) * 2) = (unsigned long long)cvtpk(S1[0], S1[1]) | ((unsigned long long)cvtpk(S1[2], S1[3]) << 32);
}
#define SC_BARRIER() do { asm volatile("s_waitcnt lgkmcnt(0)" ::: "memory"); __builtin_amdgcn_s_barrier(); asm volatile("" ::: "memory"); } while (0)
template <int TYPE>
__device__ __forceinline__ void seqc_unit(Frame& F, int l, int b, int h, int vs) {
    LAS unsigned char* lds = F.lds; const int tid = F.tid, lane = F.lane, w = F.wave, g = lane >> 4, lr = lane & 15;
    bf16* U = WSP(bf16, WS_U);
    ScPtr P; float* Sout; constexpr int br = TYPE;
    const size_t mb = (size_t)b * SEQ, so = ((size_t)(l * 8 + b) * 4 + h) * 16384;
    if (TYPE == 0) { P.pq = WSP(bf16, WS_GQ) + mb * 512 + h * 128; P.pk = WSP(bf16, WS_GK) + mb * 512 + h * 128; P.pv = WSP(bf16, WS_GV) + mb * 512 + h * 128; P.O = WSP(float, WS_OG); Sout = F.out + O_PGS + so; }
    else if (TYPE == 1) { P.pq = U + mb * NU + U_HQ + h * 128; P.pk = U + mb * NU + U_HF + h * 128; P.pv = U + mb * NU + U_HI + h * 128; P.O = WSP(float, WS_OH); Sout = F.out + O_PHS + so; }
    else { P.pq = U + mb * NU + U_RQ + h * 128; P.pk = U + mb * NU + U_RK + h * 128; P.pv = U + mb * NU + U_RV + h * 128; P.O = WSP(float, WS_OR); Sout = F.out + O_PRS + so; }
    P.pw = WSP(bf16, WS_WN) + mb * 512 + h * 128;
    P.paq = WSP(bf16, WS_AQK) + ((size_t)br * 4096 + (size_t)b * 512 + h) * 256;
    P.pdec = WSP(float, WS_DEC) + ((size_t)b * 512 + h) * 128;
    P.pdg = WSP(float, WS_DG) + (size_t)b * 512 + h;
    P.gam16 = exp2f(16.0f * log2f(1.0f - exp2f(-5.0f - (float)h)));
    P.vs = vs;
    const int v0 = vs * 32;
    const size_t orow = mb * 512 + h * 128 + v0;
    for (int i = tid; i < ST_BUF / 4; i += NTHR) ((LAS unsigned*)lds)[i] = 0u;
    f32x4 S0 = (f32x4){0.f, 0.f, 0.f, 0.f}, S1 = S0;
    ScStage RA, RB;
    sc_issue<TYPE>(RA, P, 0, tid); sc_write<TYPE>(RA, lds + IM_OFF, tid);
    sc_issue<TYPE>(RB, P, 1, tid);
    __syncthreads();
#pragma unroll 1
    for (int c = 0; c < 128; c += 2) {
        sc_issue<TYPE>(RA, P, c + 2 < 128 ? c + 2 : 127, tid);
        sc_step<TYPE>(P, lds, c, w, g, lr, orow, S0, S1);
        sc_write<TYPE>(RB, lds + IM_OFF + IM_BYTES, tid);
        SC_BARRIER();
        sc_issue<TYPE>(RB, P, c + 3 < 128 ? c + 3 : 127, tid);
        sc_step<TYPE>(P, lds, c + 1, w, g, lr, orow, S0, S1);
        sc_write<TYPE>(RA, lds + IM_OFF, tid);
        SC_BARRIER();
    }
#pragma unroll
    for (int r = 0; r < 4; ++r) { Sout[(size_t)(16 * w + 4 * g + r) * 128 + v0 + lr] = S0[r]; Sout[(size_t)(16 * w + 4 * g + r) * 128 + v0 + 16 + lr] = S1[r]; }
    __syncthreads();
}

template <int TYPE>
__device__ __forceinline__ void sstep_unit(Frame& F, const bf16* A, const bf16* Q, const bf16* V, float beta, float eg, float gamma, const float* S0, float* Sout, float* O) {
    LAS float* sm = (LAS float*)F.lds;
    const int tid = F.tid, rg = tid >> 5, c4 = tid & 31;
    f32x4 st[8];
#pragma unroll
    for (int p = 0; p < 8; ++p) st[p] = *(const f32x4*)(S0 + (size_t)(rg + 16 * p) * 128 + 4 * c4);
    if (tid < 128) { sm[tid] = bflo((unsigned)A[tid]); sm[128 + tid] = bflo((unsigned)Q[tid]); sm[256 + tid] = bflo((unsigned)V[tid]); }
    __syncthreads();
    float kk[8], qq[8];
#pragma unroll
    for (int p = 0; p < 8; ++p) { kk[p] = sm[rg + 16 * p]; qq[p] = sm[128 + rg + 16 * p]; }
    const f32x4 vv = *(const LAS f32x4*)(sm + 256 + 4 * c4);
    if (TYPE == 0) {
        f32x4 part = (f32x4){0.f, 0.f, 0.f, 0.f};
#pragma unroll
        for (int p = 0; p < 8; ++p) part += st[p] * kk[p];
        *(LAS f32x4*)(sm + 512 + rg * 128 + 4 * c4) = part;
        __syncthreads();
        f32x4 ks = (f32x4){0.f, 0.f, 0.f, 0.f};
#pragma unroll
        for (int r = 0; r < 16; ++r) ks += *(const LAS f32x4*)(sm + 512 + r * 128 + 4 * c4);
        __syncthreads();
        const f32x4 uu = (vv - ks * eg) * beta;
#pragma unroll
        for (int p = 0; p < 8; ++p) st[p] = st[p] * eg + uu * kk[p];
    } else if (TYPE == 1) {
#pragma unroll
        for (int p = 0; p < 8; ++p) st[p] = st[p] * kk[p] + vv * (1.0f - kk[p]);
    } else {
#pragma unroll
        for (int p = 0; p < 8; ++p) st[p] = st[p] * gamma + vv * kk[p];
    }
    f32x4 op = (f32x4){0.f, 0.f, 0.f, 0.f};
#pragma unroll
    for (int p = 0; p < 8; ++p) { op += st[p] * qq[p]; *(f32x4*)(Sout + (size_t)(rg + 16 * p) * 128 + 4 * c4) = st[p]; }
    *(LAS f32x4*)(sm + 512 + rg * 128 + 4 * c4) = op;
    __syncthreads();
    if (tid < 128) { float o = 0.f;
#pragma unroll
        for (int r = 0; r < 16; ++r) o += sm[512 + r * 128 + tid];
        O[tid] = o; }
    __syncthreads();
}

__device__ __forceinline__ void p4_mixers(Frame& F, int l) {
    constexpr int N_SEQP = 128, Q_GDN = 0, Q_HGRN = 128, Q_RET = 256, Q_LRU = 384, Q_XP = 512, Q_SS = 640, Q_XS = Q_SS + 3 * 512, Q_END = Q_XS + 512;
    const bf16* U = WSP(bf16, WS_U);
    for (;;) {
        F.tid = threadIdx.x; asm volatile("" : "+v"(F.tid)); F.lane = F.tid & 63; F.wave = __builtin_amdgcn_readfirstlane(F.tid >> 6);
        if (F.tid == 0) F.MISC[16] = __hip_atomic_fetch_add((unsigned*)(F.ctl + CW_QUEUE + 64 * l), 1u, __ATOMIC_RELAXED, __HIP_MEMORY_SCOPE_AGENT);
        __syncthreads();
        const int idx = (int)F.MISC[16];
        __syncthreads();
        if (idx >= Q_END) break;
        if (idx < Q_LRU) {
            const int type = idx / N_SEQP, j = idx % N_SEQP, b = j >> 4, h = (j >> 2) & 3, vs = j & 3;
            if (type == 0) { if (EN(22)) seqc_unit<0>(F, l, b, h, vs); } else if (type == 1) { if (EN(23)) seqc_unit<1>(F, l, b, h, vs); } else { if (EN(24)) seqc_unit<2>(F, l, b, h, vs); }
        } else if (idx < Q_XP) { const int j = idx - Q_LRU; if (EN(19)) lru_scan_unit(F, l, j >> 4, j & 15); }
        else if (idx < Q_SS) { const int j = idx - Q_XP; if (EN(20)) cross_prompt_unit(F, j >> 4, (j >> 2) & 3, j & 3); }
        else if (idx < Q_XS) {
            const int j = idx - Q_SS, type = j / 512, s = (j % 512) >> 2, h = j & 3; const size_t m0 = (size_t)MPR + s;
            const size_t so = ((size_t)(l * DECB + s) * 4 + h) * 16384;
            if (type == 0) sstep_unit<0>(F, WSP(bf16, WS_GK) + m0 * 512 + h * 128, WSP(bf16, WS_GQ) + m0 * 512 + h * 128, WSP(bf16, WS_GV) + m0 * 512 + h * 128, WSP(float, WS_BETA)[m0 * 4 + h], __expf(WSP(float, WS_EG)[m0 * 4 + h]), 0.f,
                                         INP(I_SGDNS) + so, F.out + O_SGS + so, WSP(float, WS_OG) + m0 * 512 + h * 128);
            else if (type == 1) sstep_unit<1>(F, U + m0 * NU + U_HF + h * 128, U + m0 * NU + U_HQ + h * 128, U + m0 * NU + U_HI + h * 128, 0.f, 0.f, 0.f, INP(I_SHGRNS) + so, F.out + O_SHS + so, WSP(float, WS_OH) + m0 * 512 + h * 128);
            else sstep_unit<2>(F, U + m0 * NU + U_RK + h * 128, U + m0 * NU + U_RQ + h * 128, U + m0 * NU + U_RV + h * 128, 0.f, 0.f, 1.0f - exp2f(-5.0f - (float)h), INP(I_SRETS) + so, F.out + O_SRS + so, WSP(float, WS_OR) + m0 * 512 + h * 128);
        } else { const int j = idx - Q_XS; if (EN(21)) cross_sample_unit(F, l, j >> 2, j & 3); }
    }
}
__device__ __forceinline__ void p5_postpass(Frame& F, int l) {
    const int gw = F.vcu * NWAVES + F.wave, NGW = F.G * NWAVES, lane = F.lane, c8 = lane * 8;
    const bf16* U = WSP(bf16, WS_U); bf16* Y = WSP(bf16, WS_Y);
#pragma clang loop unroll(disable)
    for (int m = gw; m < MROWS; m += NGW) {
        const bf16* urow = U + (size_t)m * NU;
        {   float o[8], z[8], w[8], y[8]; ld8f(WSP(float, WS_OG) + (size_t)m * 512 + c8, o); ld8bf(urow + U_GZ + c8, z); ld8f(INP(I_GNW) + l * 512 + c8, w);
            float ss = 0.f;
#pragma unroll
            for (int e = 0; e < 8; ++e) ss += o[e] * o[e];
            const float rstd = rsqrtf(row16_sum(ss) * (1.0f / 128.0f) + NORM_EPS);
#pragma unroll
            for (int e = 0; e < 8; ++e) y[e] = o[e] * rstd * w[e] * siluf(z[e]);
            *(v4u*)(Y + ((size_t)1 * MP + m) * 512 + c8) = pack8(y); }
        {   float o[8], z[8], w[8], y[8]; ld8f(WSP(float, WS_OH) + (size_t)m * 512 + c8, o); ld8bf(urow + U_HG + c8, z); ld8f(INP(I_HNW) + l * 512 + c8, w);
            float ss = 0.f;
#pragma unroll
            for (int e = 0; e < 8; ++e) ss += o[e] * o[e];
            const float rstd = rsqrtf(row16_sum(ss) * (1.0f / 128.0f) + NORM_EPS);
#pragma unroll
            for (int e = 0; e < 8; ++e) y[e] = o[e] * rstd * w[e] * sigm(z[e]);
            *(v4u*)(Y + ((size_t)2 * MP + m) * 512 + c8) = pack8(y); }
        {   float o[8], z[8], w[8], bb[8], y[8]; ld8f(WSP(float, WS_OR) + (size_t)m * 512 + c8, o); ld8bf(urow + U_RG + c8, z); ld8f(INP(I_RGW) + l * 512 + c8, w); ld8f(INP(I_RGB) + l * 512 + c8, bb);
            float s1 = 0.f;
#pragma unroll
            for (int e = 0; e < 8; ++e) s1 += o[e];
            const float mu = row16_sum(s1) * (1.0f / 128.0f); float s2 = 0.f;
#pragma unroll
            for (int e = 0; e < 8; ++e) { o[e] -= mu; s2 += o[e] * o[e]; }
            const float rstd = rsqrtf(row16_sum(s2) * (1.0f / 128.0f) + NORM_EPS);
#pragma unroll
            for (int e = 0; e < 8; ++e) y[e] = (o[e] * rstd * w[e] + bb[e]) * siluf(z[e]);
            *(v4u*)(Y + ((size_t)3 * MP + m) * 512 + c8) = pack8(y); }
        if (m >= MPR) {
            const int s = m - MPR; float a[8], b[8], h0[8], h[8];
            ld8f(WSP(float, WS_LA) + (size_t)m * 512 + c8, a); ld8f(WSP(float, WS_LB) + (size_t)m * 512 + c8, b); ld8f(INP(I_SLRUH) + ((size_t)l * DECB + s) * 512 + c8, h0);
#pragma unroll
            for (int e = 0; e < 8; ++e) h[e] = a[e] * h0[e] + b[e];
            st8f(F.out + O_SLH + ((size_t)l * DECB + s) * 512 + c8, h);
            *(v4u*)(Y + (size_t)m * 512 + c8) = pack8(h); }
    }
}
__device__ __forceinline__ void psum_pass(Frame& F) {
    const int gw = F.vcu * NWAVES + F.wave, NGW = F.G * NWAVES, lane = F.lane;
    const bf16* P = WSP(bf16, WS_R2); bf16* Ms = WSP(bf16, WS_Y);
#pragma clang loop unroll(disable)
    for (int m = gw; m < MROWS; m += NGW) {
#pragma unroll
        for (int hh = 0; hh < 2; ++hh) { float a[8] = {0.f, 0.f, 0.f, 0.f, 0.f, 0.f, 0.f, 0.f};
#pragma unroll
            for (int n = 0; n < 5; ++n) { float v[8]; ld8bf(P + (size_t)m * 5120 + n * 1024 + hh * 512 + lane * 8, v);
#pragma unroll
                for (int e = 0; e < 8; ++e) a[e] += v[e]; }
            *(v4u*)(Ms + (size_t)m * 1024 + hh * 512 + lane * 8) = pack8(a); }
    }
}
__device__ __forceinline__ void ln_pass(Frame& F, const float* gam, const float* bet) {
    const int gw = F.vcu * NWAVES + F.wave, NGW = F.G * NWAVES, lane = F.lane;
#pragma clang loop unroll(disable)
    for (int m = gw; m < MROWS; m += NGW) {
        const f32x4* zr = (const f32x4*)(WSP(float, WS_Z) + (size_t)m * DM) + lane;
        f32x4 v[4]; float s = 0.f;
#pragma unroll
        for (int j = 0; j < 4; ++j) { v[j] = zr[64 * j]; s += (v[j].x + v[j].y) + (v[j].z + v[j].w); }
        const float mean = wave_sum(s) * (1.f / DM); float s2 = 0.f;
#pragma unroll
        for (int j = 0; j < 4; ++j) { v[j] = v[j] - mean; s2 += (v[j].x * v[j].x + v[j].y * v[j].y) + (v[j].z * v[j].z + v[j].w * v[j].w); }
        const float rstd = rsqrtf(wave_sum(s2) * (1.f / DM) + LN_EPS);
        f32x4* xo = (f32x4*)(F.out + (size_t)m * DM) + lane; unsigned long long* xb = (unsigned long long*)(WSP(bf16, WS_XB) + (size_t)m * DM) + lane;
#pragma unroll
        for (int j = 0; j < 4; ++j) { const f32x4 gv = *((const f32x4*)gam + lane + 64 * j), bv = *((const f32x4*)bet + lane + 64 * j); const f32x4 y = v[j] * rstd * gv + bv;
            xo[64 * j] = y; xb[64 * j] = (unsigned long long)pk2(y.x, y.y) | ((unsigned long long)pk2(y.z, y.w) << 32); }
    }
}

#ifndef MAXPHASE
#define MAXPHASE 1000
#endif
#define GRID_BAR() do { asm volatile("" : "+s"(bar.x), "+s"(bar.bar)); xcd_barrier(bar); asm volatile("" : "+s"(F.z)); F.ws = F.ap->ws + F.z; F.out = F.ap->out + F.z;   F.tid = threadIdx.x; asm volatile("" : "+v"(F.tid)); F.lane = F.tid & 63; F.wave = __builtin_amdgcn_readfirstlane(F.tid >> 6); } while (0)
template <int L>
__device__ __forceinline__ void run_layer(Frame& F, XcdBarrier& bar) {
    constexpr int l = L; LAS unsigned char* glds = F.lds;
        unsigned char* wl = F.ws + WS_W + (size_t)l * WL_SIZE;
        if (EN(1)) {   pg8::Gemm g{WSP(bf16, WS_XB), (const bf16*)(wl + WL_WIN), MP, NU, DM, 0, 0}; pg8::StaticOrder S; S.init(MP, NU, F.G, (int)blockIdx.x);
            pg8::EpiBf16 E{WSP(bf16, WS_U), NU};
            pg8::gemm_phase<pg8::EpiBf16, pg8::StaticOrder, true, true>(glds, g, S, E); }
        if (EN(2)) {   pg8::Gemm g{WSP(bf16, WS_MB), (const bf16*)(wl + WL_WKV), 2048, 1024, DM, 0, 0}; pg8::StaticOrder S; S.init(2048, 1024, F.G, (int)blockIdx.x);
            pg8::EpiMemKV E{F.out + O_PMK + (size_t)l * 2048 * 512, F.out + O_PMV + (size_t)l * 2048 * 512};
            pg8::gemm_phase<pg8::EpiMemKV, pg8::StaticOrder, true, true>(glds, g, S, E); }
        GRID_BAR();
        if (EN(3)) p2_prepass(F, l);
        GRID_BAR();
        if (EN(4)) {   pg8::Gemm g{WSP(bf16, WS_XAC), (const bf16*)(wl + WL_WLRU), MP, 1024, 512, 0, 0}; pg8::StaticOrder S; S.init(MP, 1024, F.G, (int)blockIdx.x);
            pg8::EpiLru E{INP(I_LBA) + l * 512, INP(I_LBI) + l * 512, INP(I_LLAM) + l * 512, WSP(bf16, WS_XAC), WSP(float, WS_LA), WSP(float, WS_LB)};
            pg8::gemm_phase<pg8::EpiLru, pg8::StaticOrder, true, true>(glds, g, S, E); }
        if (EN(14)) p3b_chunkprep(F, l);
        GRID_BAR();
        if (EN(5)) p4_mixers(F, l);
        GRID_BAR();
        if (EN(6)) p5_postpass(F, l);
        GRID_BAR();
        if (EN(7)) {   pg8::Gemm g{WSP(bf16, WS_Y), (const bf16*)(wl + WL_WB), MP, 5120, 512, 4, (size_t)MP * 512 * 2}; pg8::StaticOrder S; S.init(MP, 5120, F.G, (int)blockIdx.x);
            pg8::EpiBf16 E{WSP(bf16, WS_U), 5120};
            pg8::gemm_phase<pg8::EpiBf16, pg8::StaticOrder, true, true>(glds, g, S, E); }
        GRID_BAR();
        if (EN(8)) {   pg8::Gemm g{WSP(bf16, WS_XB), (const bf16*)(wl + WL_WG), MP, 5120, DM, 0, 0}; pg8::StaticOrder S; S.init(MP, 5120, F.G, (int)blockIdx.x);
            pg8::EpiGate E{INP(I_BMG) + (size_t)l * 5120, WSP(bf16, WS_U), WSP(bf16, WS_R2)};
            pg8::gemm_phase<pg8::EpiGate, pg8::StaticOrder, true, true>(glds, g, S, E); }
        GRID_BAR();
        psum_pass(F);
        GRID_BAR();
        if (EN(9)) {   pg8::Gemm g{WSP(bf16, WS_Y), (const bf16*)(wl + WL_WO5), MP, 1024, 1024, 0, 0}; pg8::StaticOrder S; S.init(MP, 1024, F.G, (int)blockIdx.x);
            pg8::EpiRes E{F.out, WSP(float, WS_Z), MROWS, ALPHA};
            pg8::gemm_phase<pg8::EpiRes, pg8::StaticOrder, true, true>(glds, g, S, E); }
        GRID_BAR();
        if (EN(10)) ln_pass(F, INP(I_LN1G) + l * DM, INP(I_LN1B) + l * DM);
        GRID_BAR();
        if (EN(11)) {   pg8::Gemm g{WSP(bf16, WS_XB), (const bf16*)(wl + WL_WUP), MP, 5632, DM, 0, 0}; pg8::StaticOrder S; S.init(MP, 5632, F.G, (int)blockIdx.x);
            pg8::EpiSwiglu E{WSP(bf16, WS_U)};
            pg8::gemm_phase<pg8::EpiSwiglu, pg8::StaticOrder, true, true>(glds, g, S, E); }
        GRID_BAR();
        if (EN(12)) {   pg8::Gemm g{WSP(bf16, WS_U), (const bf16*)(wl + WL_WDN), MP, 1024, DFF, 0, 0}; pg8::StaticOrder S; S.init(MP, 1024, F.G, (int)blockIdx.x);
            pg8::EpiRes E{F.out, WSP(float, WS_Z), MROWS, ALPHA};
            pg8::gemm_phase<pg8::EpiRes, pg8::StaticOrder, true, true>(glds, g, S, E); }
        GRID_BAR();
        if (EN(13)) ln_pass(F, INP(I_LN2G) + l * DM, INP(I_LN2B) + l * DM);
        if (l + 1 < DEPTH) GRID_BAR();
}

__global__ void __launch_bounds__(NTHR, 2) mega_fwd(Args args) {
    extern __shared__ __attribute__((aligned(16))) unsigned char lds[];
    Frame F;
    F.lds = (LAS unsigned char*)lds; F.MISC = (volatile LAS unsigned*)(F.lds + MISC_OFF);
    F.tid = threadIdx.x; F.lane = F.tid & 63; F.wave = __builtin_amdgcn_readfirstlane(F.tid >> 6);
    F.G = gridDim.x; { const int bx = blockIdx.x; F.vcu = (F.G % 8 == 0) ? (bx % 8) * (F.G / 8) + bx / 8 : bx; }
    F.ap = &args; F.z = 0; F.out = args.out; F.ws = args.ws; F.ctl = (gu32*)(args.ws + WS_CTL);
    for (int u = F.tid; u < (LDS_BYTES - LDSCTL_OFF) / 4; u += NTHR) ((LAS unsigned*)(F.lds + LDSCTL_OFF))[u] = 0u;
    __syncthreads();
    XcdBarrier bar = xcd_barrier_post((unsigned*)(F.ctl + CW_BAR), F.MISC + 8);

    LAS unsigned char* glds = F.lds;

    if (EN(0)) p0_prologue(F);
    GRID_BAR();
    run_layer<0>(F, bar);
    run_layer<1>(F, bar);
}

extern "C" void kernel_launch(void* const* d_in, const int* in_sizes, int n_in, void* d_out, int out_size, void* d_ws, size_t ws_size, hipStream_t stream) {
    static int grid = 0;
    if (grid == 0) {
        if (n_in != N_INPUTS || (size_t)out_size != O_END || ws_size < WS_END2) { fprintf(stderr, "kernel_launch: expected %d inputs, %zu outputs, >= %zu bytes of workspace; got %d, %d, %zu\n", (int)N_INPUTS, (size_t)O_END, (size_t)WS_END2, n_in, out_size, ws_size); grid = -1; return; }
        int dev = 0, cus = 0, per_cu = 0;
        if (hipGetDevice(&dev) != hipSuccess || hipDeviceGetAttribute(&cus, hipDeviceAttributeMultiprocessorCount, dev) != hipSuccess) { fprintf(stderr, "kernel_launch: device query failed\n"); grid = -1; return; }
        if (hipFuncSetAttribute((const void*)mega_fwd, hipFuncAttributeMaxDynamicSharedMemorySize, LDS_BYTES) != hipSuccess) { fprintf(stderr, "kernel_launch: hipFuncSetAttribute failed\n"); grid = -1; return; }
        if (hipOccupancyMaxActiveBlocksPerMultiprocessor(&per_cu, (const void*)mega_fwd, NTHR, LDS_BYTES) != hipSuccess || per_cu < 1) fprintf(stderr, "kernel_launch: note: occupancy query says %d blocks per CU\n", per_cu);
        (void)hipGetLastError();
        grid = cus;
    }
    if (grid < 0) return;
    if (hipMemsetAsync((char*)d_ws + WS_CTL, 0, CTL_ZERO_BYTES, stream) != hipSuccess) { fprintf(stderr, "kernel_launch: hipMemsetAsync failed\n"); return; }
    Args a{};
    for (int i = 0; i < N_INPUTS; ++i) a.in[i] = (const float*)d_in[i];
    a.out = (float*)d_out; a.ws = (unsigned char*)d_ws;
    hipLaunchKernelGGL(mega_fwd, dim3(grid), dim3(NTHR), LDS_BYTES, stream, a);
    const hipError_t le = hipPeekAtLastError();
    if (le != hipSuccess) fprintf(stderr, "kernel_launch: launch failed: %s\n", hipGetErrorName(le));
}
```
